# Optimizing an MI355X kernel written in HIP

```python
import jax, jax.numpy as jnp
from jax import lax
import numpy as np

D_MODEL = 1024
BATCH = 4
SEQ = 4096
DEPTH = 4

GRID_W = 64
CTX_LEN = 256
N_MIXERS = 3
RETENTION, FOURIER, NEIGHBOURHOOD = 0, 1, 2
N_MOD = 6
EPS = 1e-6
NEG_INF = -1e30

RET_HEADS = 4
RET_DK = D_MODEL // RET_HEADS
RET_DV = 2 * RET_DK
RET_CHUNK = 128
RET_BASE_SHIFT = 5
ROPE_BASE = 10000.0

FN_GROUPS = 4

NA_HEADS = 16
NA_HD = D_MODEL // NA_HEADS
NA_KH = 8
NA_KW = 16

N_EXPERTS = 16
N_GROUPS = 4
EXPERTS_PER_GROUP = N_EXPERTS // N_GROUPS
TOP_K = 2
D_EXPERT = D_MODEL
MOE_BLOCK = 128

kernel_name = 'hybrid_retention_fnet_natten_moe_dit'


def _rmsnorm(x, g):
    xf = x.astype(jnp.float32)
    y = xf * lax.rsqrt(jnp.mean(xf * xf, axis=-1, keepdims=True) + EPS)
    return (y * g.astype(jnp.float32)).astype(x.dtype)


def _modulate(h, shift, scale):
    return h * (1.0 + scale) + shift


def _axial_rope(x):
    L, dh = x.shape[1], x.shape[-1]
    half = dh // 2
    nf = half // 2
    t = jnp.arange(L)
    row = (t // GRID_W).astype(jnp.float32)
    col = (t % GRID_W).astype(jnp.float32)
    inv = ROPE_BASE ** (-jnp.arange(nf, dtype=jnp.float32) / nf)

    def rot(seg, pos):
        ang = pos[:, None] * inv[None, :]
        cos = jnp.cos(ang)[None, :, None, :]
        sin = jnp.sin(ang)[None, :, None, :]
        a, b = seg[..., :nf], seg[..., nf:]
        return jnp.concatenate([a * cos - b * sin, a * sin + b * cos], axis=-1)

    xf = x.astype(jnp.float32)
    return jnp.concatenate([rot(xf[..., :half], row), rot(xf[..., half:], col)], axis=-1).astype(x.dtype)


def _to_bhld(a):
    return jnp.transpose(a, (0, 2, 1, 3)).astype(jnp.float32)


def _retention_scan(q, k, v, log_g, s0):
    B, H, L, _ = q.shape
    dv = v.shape[-1]
    C = RET_CHUNK
    n = L // C
    pos = jnp.arange(C, dtype=jnp.float32)
    diff = pos[:, None] - pos[None, :]
    dmat = jnp.where(diff >= 0, jnp.exp(jnp.maximum(diff, 0.0)[None] * log_g[:, None, None]), 0.0)
    q_dec = jnp.exp((pos + 1.0)[None, :] * log_g[:, None])
    k_dec = jnp.exp((C - 1.0 - pos)[None, :] * log_g[:, None])
    c_dec = jnp.exp(C * log_g)

    def chunks(a):
        return jnp.moveaxis(a.reshape(B, H, n, C, a.shape[-1]), 2, 0)

    def step(s, inp):
        qi, ki, vi = inp
        att = jnp.einsum('bhik,bhjk->bhij', qi, ki) * dmat
        o = (jnp.einsum('bhij,bhjv->bhiv', att, vi)
             + jnp.einsum('bhik,bhkv->bhiv', qi * q_dec[None, :, :, None], s))
        s = s * c_dec[None, :, None, None] + jnp.einsum('bhjk,bhjv->bhkv', ki * k_dec[None, :, :, None], vi)
        return s, o

    s_fin, o = lax.scan(step, s0, (chunks(q), chunks(k), chunks(v)))
    return jnp.moveaxis(o, 0, 2).reshape(B, H, L, dv), s_fin


def _retention_bidir(q, k, v, log_g, s0_f, s0_b):
    o_f, s_f = _retention_scan(q, k, v, log_g[0], s0_f)
    o_b, s_b = _retention_scan(q[:, :, ::-1], k[:, :, ::-1], v[:, :, ::-1], log_g[1], s0_b)
    return o_f + o_b[:, :, ::-1], s_f, s_b


def _retention_final_states(k, v, log_g):
    L = k.shape[2]
    t = jnp.arange(L, dtype=jnp.float32)
    w_f = jnp.exp((L - 1.0 - t)[None, :] * log_g[0][:, None])
    w_b = jnp.exp(t[None, :] * log_g[1][:, None])
    s_f = jnp.einsum('bhtk,ht,bhtv->bhkv', k, w_f, v)
    s_b = jnp.einsum('bhtk,ht,bhtv->bhkv', k, w_b, v)
    return s_f, s_b


def _retention_out(o, g, gn_w, w_out):
    B, H, L, dv = o.shape
    o = jnp.transpose(o, (0, 2, 1, 3))
    mu = jnp.mean(o, axis=-1, keepdims=True)
    var = jnp.mean(jnp.square(o - mu), axis=-1, keepdims=True)
    o = ((o - mu) * lax.rsqrt(var + EPS)).reshape(B, L, H * dv) * gn_w.astype(jnp.float32)
    return (o.astype(g.dtype) * jax.nn.silu(g)) @ w_out


def _retention_mixer(hx, hc, w_in, decay_logit, gn_w, w_out, need_ctx):
    D = D_MODEL
    B, T, _ = hx.shape
    Lc = hc.shape[1]
    log_g = jax.nn.log_sigmoid(decay_logit.astype(jnp.float32))
    k_scale = RET_DK ** -0.5
    qx, kx, vx, gx = jnp.split(hx @ w_in, [D, 2 * D, 4 * D], axis=-1)
    qx = _to_bhld(_axial_rope(qx.reshape(B, T, RET_HEADS, RET_DK)))
    kx = _to_bhld(_axial_rope(kx.reshape(B, T, RET_HEADS, RET_DK))) * k_scale
    vx = _to_bhld(vx.reshape(B, T, RET_HEADS, RET_DV))
    if need_ctx:
        qc, kc, vc, gc = jnp.split(hc @ w_in, [D, 2 * D, 4 * D], axis=-1)
        qc = _to_bhld(qc.reshape(B, Lc, RET_HEADS, RET_DK))
        kc = _to_bhld(kc.reshape(B, Lc, RET_HEADS, RET_DK)) * k_scale
        vc = _to_bhld(vc.reshape(B, Lc, RET_HEADS, RET_DV))
        zeros = jnp.zeros((B, RET_HEADS, RET_DK, RET_DV), jnp.float32)
        oc, s_f, s_b = _retention_bidir(qc, kc, vc, log_g, zeros, zeros)
        yc = _retention_out(oc, gc, gn_w, w_out)
    else:
        kc, vc = jnp.split(hc @ w_in[:, D:4 * D], [D], axis=-1)
        kc = _to_bhld(kc.reshape(B, Lc, RET_HEADS, RET_DK)) * k_scale
        vc = _to_bhld(vc.reshape(B, Lc, RET_HEADS, RET_DV))
        s_f, s_b = _retention_final_states(kc, vc, log_g)
        yc = None
    ox, _, _ = _retention_bidir(qx, kx, vx, log_g, s_f, s_b)
    return _retention_out(ox, gx, gn_w, w_out), yc


def _fourier_mix(h, w_out):
    B, L, D = h.shape
    hg = h.astype(jnp.float32).reshape(B, L, FN_GROUPS, D // FN_GROUPS)
    f = jnp.fft.fft2(hg, axes=(1, 3), norm='ortho').real
    return f.reshape(B, L, D).astype(h.dtype) @ w_out


def _na_mixer(hx, hc, w_qkv, rpb, w_out, need_ctx):
    B, T, D = hx.shape
    Lc = hc.shape[1]
    rows = T // GRID_W
    KH = min(NA_KH, rows)
    KW = NA_KW
    QB = KW
    NCB = GRID_W // QB
    BW = 2 * KW
    NK = KH * BW
    scale = NA_HD ** -0.5

    def heads(a):
        return a.reshape(a.shape[0], a.shape[1], NA_HEADS, NA_HD)

    qx, kx, vx = [heads(a) for a in jnp.split(hx @ w_qkv, 3, axis=-1)]
    if need_ctx:
        qc, kc, vc = [heads(a) for a in jnp.split(hc @ w_qkv, 3, axis=-1)]
    else:
        kc, vc = [heads(a) for a in jnp.split(hc @ w_qkv[:, D:], 2, axis=-1)]

    cb = np.clip(np.arange(NCB) * QB - KW // 2, 0, GRID_W - BW)
    qcol = np.arange(NCB)[:, None] * QB + np.arange(QB)[None, :]
    cstart = np.clip(qcol - KW // 2, 0, GRID_W - KW)
    kcol = np.tile(cb[:, None] + np.arange(BW)[None, :], (1, KH))
    krow = np.repeat(np.arange(KH), BW)
    valid = (kcol[:, None, :] >= cstart[:, :, None]) & (kcol[:, None, :] < cstart[:, :, None] + KW)
    dc_idx = np.clip(kcol[:, None, :] - qcol[:, :, None], -(KW - 1), KW - 1) + (KW - 1)

    def row_block(r):
        rs = jnp.clip(r - KH // 2, 0, rows - KH)
        idx = ((rs + krow)[None, :] * GRID_W + kcol).reshape(-1)
        kb = jnp.take(kx, idx, axis=1).reshape(B, NCB, NK, NA_HEADS, NA_HD)
        vb = jnp.take(vx, idx, axis=1).reshape(B, NCB, NK, NA_HEADS, NA_HD)
        qb = lax.dynamic_slice_in_dim(qx, r * GRID_W, GRID_W, axis=1).reshape(B, NCB, QB, NA_HEADS, NA_HD)
        dr_idx = rs + krow - r + (NA_KH - 1)
        bias = rpb[:, dr_idx[None, None, :], dc_idx].astype(jnp.float32)
        s_win = jnp.einsum('bjqhd,bjkhd->bhjqk', qb, kb).astype(jnp.float32) * scale + bias
        s_win = jnp.where(valid, s_win, NEG_INF)
        s_ctx = jnp.einsum('bjqhd,bchd->bhjqc', qb, kc).astype(jnp.float32) * scale
        p = jax.nn.softmax(jnp.concatenate([s_win, s_ctx], axis=-1), axis=-1).astype(vx.dtype)
        o = (jnp.einsum('bhjqk,bjkhd->bjqhd', p[..., :NK], vb)
             + jnp.einsum('bhjqc,bchd->bjqhd', p[..., NK:], vc))
        return o.reshape(B, GRID_W, D)

    o = lax.map(row_block, jnp.arange(rows))
    yx = jnp.moveaxis(o, 0, 1).reshape(B, T, D) @ w_out
    if need_ctx:
        s = jnp.einsum('bqhd,bkhd->bhqk', qc, kc).astype(jnp.float32) * scale
        p = jax.nn.softmax(s, axis=-1).astype(vc.dtype)
        yc = jnp.einsum('bhqk,bkhd->bqhd', p, vc).reshape(B, Lc, D) @ w_out
    else:
        yc = None
    return yx, yc


def _moe(tokens, router_w, router_bias, w_gate, w_up, w_down):
    N, D = tokens.shape
    rows = jnp.arange(N)
    scores = jax.nn.sigmoid((tokens @ router_w).astype(jnp.float32))
    sel = scores + router_bias.astype(jnp.float32)
    grp = sel.reshape(N, N_GROUPS, EXPERTS_PER_GROUP)
    grp_score = jnp.sum(lax.top_k(grp, 2)[0], axis=-1)
    g_idx = jnp.argmax(grp_score, axis=-1)
    _, local = lax.top_k(grp[rows, g_idx], TOP_K)
    experts = g_idx[:, None] * EXPERTS_PER_GROUP + local
    w = scores[rows[:, None], experts]
    w = w / jnp.sum(w, axis=-1, keepdims=True)

    S = N * TOP_K
    flat_e = experts.reshape(-1)
    flat_tok = jnp.repeat(rows, TOP_K)
    flat_w = w.reshape(-1)
    order = jnp.argsort(flat_e, stable=True)
    se, stok, sw = flat_e[order], flat_tok[order], flat_w[order]
    counts = jnp.bincount(flat_e, length=N_EXPERTS)
    starts = jnp.cumsum(counts) - counts
    padded = (counts + MOE_BLOCK - 1) // MOE_BLOCK * MOE_BLOCK
    pend = jnp.cumsum(padded)
    pstart = pend - padded
    dest = pstart[se] + jnp.arange(S) - starts[se]
    n_blocks = (S + N_EXPERTS * (MOE_BLOCK - 1) + MOE_BLOCK - 1) // MOE_BLOCK
    P = n_blocks * MOE_BLOCK
    row_tok = jnp.full((P,), N, jnp.int32).at[dest].set(stok.astype(jnp.int32))
    row_w = jnp.zeros((P,), jnp.float32).at[dest].set(sw)
    block_e = jnp.minimum(jnp.searchsorted(pend, jnp.arange(n_blocks) * MOE_BLOCK, side='right'), N_EXPERTS - 1)
    xpad = jnp.concatenate([tokens, jnp.zeros((1, D), tokens.dtype)], axis=0)
    xb = xpad[row_tok].reshape(n_blocks, MOE_BLOCK, D)

    def expert_block(args):
        xblk, e = args
        h = jax.nn.silu(xblk @ w_gate[e]) * (xblk @ w_up[e])
        return h @ w_down[e]

    yb = lax.map(expert_block, (xb, block_e)).reshape(P, D)
    y = yb * row_w[:, None].astype(yb.dtype)
    return jax.ops.segment_sum(y, row_tok, num_segments=N + 1)[:N]


def setup_inputs(seed: int = 0) -> dict:
    key = jax.random.key(seed)
    ks = jax.random.split(key, 22)
    f32 = jnp.float32
    D = D_MODEL
    n_ret = len(range(RETENTION, DEPTH, N_MIXERS))
    n_fn = len(range(FOURIER, DEPTH, N_MIXERS))
    n_na = len(range(NEIGHBOURHOOD, DEPTH, N_MIXERS))

    def nrm(k, shape, s):
        return jax.random.normal(k, shape, f32) * s

    base_logit = jnp.log(2.0 ** (RET_BASE_SHIFT + jnp.arange(RET_HEADS, dtype=f32)) - 1.0)
    return {
        'x': nrm(ks[0], (BATCH, SEQ, D), 1.0),
        'c': nrm(ks[1], (BATCH, D), 1.0),
        'ctx': nrm(ks[2], (BATCH, CTX_LEN, D), 1.0),
        'c_ctx': nrm(ks[3], (D,), 1.0),
        'w_mod': nrm(ks[4], (DEPTH, D, N_MOD * D), 0.5 * D ** -0.5),
        'b_mod': nrm(ks[5], (DEPTH, N_MOD * D), 0.02),
        'norm_mix': 1.0 + nrm(ks[6], (DEPTH, D), 0.02),
        'norm_ffn': 1.0 + nrm(ks[7], (DEPTH, D), 0.02),
        'norm_final': 1.0 + nrm(ks[8], (D,), 0.02),
        'ret_w_in': nrm(ks[9], (n_ret, D, 6 * D), D ** -0.5),
        'ret_decay': base_logit + nrm(ks[10], (n_ret, 2, RET_HEADS), 0.1),
        'ret_gn': 1.0 + nrm(ks[11], (n_ret, RET_HEADS * RET_DV), 0.02),
        'ret_w_out': nrm(ks[12], (n_ret, RET_HEADS * RET_DV, D), (RET_HEADS * RET_DV) ** -0.5),
        'fn_w_out': nrm(ks[13], (n_fn, D, D), D ** -0.5),
        'na_w_qkv': nrm(ks[14], (n_na, D, 3 * D), D ** -0.5),
        'na_rpb': nrm(ks[15], (n_na, NA_HEADS, 2 * NA_KH - 1, 2 * NA_KW - 1), 0.1),
        'na_w_out': nrm(ks[16], (n_na, D, D), D ** -0.5),
        'router_w': nrm(ks[17], (D, N_EXPERTS), D ** -0.5),
        'router_bias': nrm(ks[18], (N_EXPERTS,), 0.01),
        'moe_w_gate': nrm(ks[19], (DEPTH, N_EXPERTS, D, D_EXPERT), D ** -0.5),
        'moe_w_up': nrm(ks[20], (DEPTH, N_EXPERTS, D, D_EXPERT), D ** -0.5),
        'moe_w_down': nrm(ks[21], (DEPTH, N_EXPERTS, D_EXPERT, D), D_EXPERT ** -0.5),
    }


def reference(x, c, ctx, c_ctx, w_mod, b_mod, norm_mix, norm_ffn, norm_final,
              ret_w_in, ret_decay, ret_gn, ret_w_out, fn_w_out,
              na_w_qkv, na_rpb, na_w_out,
              router_w, router_bias, moe_w_gate, moe_w_up, moe_w_down):
    B, T, D = x.shape
    Lc = ctx.shape[1]
    c_act = jax.nn.silu(c)
    cc_act = jax.nn.silu(c_ctx)
    for i in range(DEPTH):
        kind, j = i % N_MIXERS, i // N_MIXERS
        need_ctx = i < DEPTH - 1
        mx = jnp.split(c_act @ w_mod[i] + b_mod[i], N_MOD, axis=-1)
        mc = jnp.split(cc_act @ w_mod[i] + b_mod[i], N_MOD, axis=-1)
        hx = _modulate(_rmsnorm(x, norm_mix[i]), mx[0][:, None], mx[1][:, None])
        if kind == FOURIER:
            yx = _fourier_mix(hx, fn_w_out[j])
            if need_ctx:
                hc = _modulate(_rmsnorm(ctx, norm_mix[i]), mc[0], mc[1])
                yc = _fourier_mix(hc, fn_w_out[j])
        else:
            hc = _modulate(_rmsnorm(ctx, norm_mix[i]), mc[0], mc[1])
            if kind == RETENTION:
                yx, yc = _retention_mixer(hx, hc, ret_w_in[j], ret_decay[j], ret_gn[j], ret_w_out[j], need_ctx)
            else:
                yx, yc = _na_mixer(hx, hc, na_w_qkv[j], na_rpb[j], na_w_out[j], need_ctx)
        x = x + mx[2][:, None] * yx
        fx = _modulate(_rmsnorm(x, norm_ffn[i]), mx[3][:, None], mx[4][:, None]).reshape(B * T, D)
        if need_ctx:
            ctx = ctx + mc[2] * yc
            fc = _modulate(_rmsnorm(ctx, norm_ffn[i]), mc[3], mc[4]).reshape(B * Lc, D)
            f = _moe(jnp.concatenate([fx, fc], axis=0), router_w, router_bias,
                     moe_w_gate[i], moe_w_up[i], moe_w_down[i])
            x = x + mx[5][:, None] * f[:B * T].reshape(B, T, D)
            ctx = ctx + mc[5] * f[B * T:].reshape(B, Lc, D)
        else:
            f = _moe(fx, router_w, router_bias, moe_w_gate[i], moe_w_up[i], moe_w_down[i])
            x = x + mx[5][:, None] * f.reshape(B, T, D)
    return _rmsnorm(x, norm_final)
```

```cpp
#include <hip/hip_runtime.h>
#include <cstdio>
#include <cstdint>
#include <type_traits>

#define LAS __attribute__((address_space(3)))
#define GAS __attribute__((address_space(1)))
typedef unsigned short bf16;
typedef short bf16x8 __attribute__((ext_vector_type(8)));
typedef short s16x4 __attribute__((ext_vector_type(4)));
typedef float f32x4 __attribute__((ext_vector_type(4)));
typedef float f32x2 __attribute__((ext_vector_type(2)));
typedef unsigned u32x4 __attribute__((ext_vector_type(4)));
typedef unsigned u32x2 __attribute__((ext_vector_type(2)));

#ifndef FP8_INPROJ
#define FP8_INPROJ 1
#endif
#ifndef FP8_OUTPROJ
#define FP8_OUTPROJ 1
#endif
#ifndef FP8_RETSTORE
#define FP8_RETSTORE 1
#endif
#ifndef FP8_YB
#define FP8_YB 1
#endif
#ifndef FP8_OUT2
#define FP8_OUT2 1
#endif
constexpr size_t CTX_SIDE = 20u << 20;
#ifndef FP8_F2
#define FP8_F2 1
#endif
#ifndef MK_PER_PHASE
#define MK_PER_PHASE 0
#endif

constexpr int D = 1024, NB = 4, SEQ = 4096, LCTX = 256, NLAT = NB * SEQ, NCTX = NB * LCTX, NTOK = NLAT + NCTX;
constexpr int NLAYER = 4, NMOD = 6, NEXP = 16;
constexpr float EPS = 1e-6f;
constexpr int RH = 4, RDK = 256, RDV = 512, RCH = 128;
constexpr int NAH = 16, NAHD = 64;
constexpr int PMAX = 2 * NTOK + NEXP * 256;

constexpr size_t MiB = 1u << 20;
constexpr size_t WS_CTL = 0, CTL_ZERO_BYTES = 64 * 1024;
constexpr size_t WS_MOD = 1 * MiB;
constexpr size_t WS_ROPE = 2 * MiB;
constexpr size_t WS_A1 = WS_ROPE + 64 * 1024;
constexpr size_t WS_ALC = WS_A1 + 512 * 256 * 2;
constexpr size_t WS_A1N = WS_ALC + 256 * 512 * 2;
constexpr size_t WS_BLKCNT = 3 * MiB;
constexpr size_t WS_MOETAB = WS_BLKCNT + 64 * 1024;
constexpr size_t WS_ROUTE = 4 * MiB;
constexpr size_t WS_DEST = 5 * MiB;
constexpr size_t WS_W = 8 * MiB;
constexpr size_t WE_RIN = 0, WE_ROUT = WE_RIN + 2ull * 6144 * 1024, WE_FN = WE_ROUT + 2ull * 1024 * 2048, WE_NQKV = WE_FN + 1024ull * 1024,
                 WE_NOUT = WE_NQKV + 3072ull * 1024, WE_MG = WE_NOUT + 1024ull * 1024, WE_MU = WE_MG + 64ull * 1024 * 1024, WE_MD = WE_MU + 64ull * 1024 * 1024,
                 WE_END = WE_MD + 64ull * 1024 * 1024;
static_assert(WE_END * 2 <= 426 * MiB, "weights");
constexpr size_t WS_AL = 434 * MiB;
constexpr size_t WS_XALL = 498 * MiB;
constexpr size_t WS_ACT = 566 * MiB;
constexpr size_t WS_S = 600 * MiB;
constexpr size_t WS_RQ = WS_S, WS_RK = WS_S + 34 * MiB, WS_RV = WS_S + 68 * MiB, WS_RG = WS_S + 136 * MiB, WS_ROF = WS_S + 204 * MiB, WS_ROB = WS_S + 272 * MiB;
constexpr size_t WS_G2 = WS_S, WS_G2C = WS_S + 64 * MiB, WS_FF = WS_S + 68 * MiB;
constexpr size_t WS_NQ = WS_S, WS_NK = WS_S + 34 * MiB, WS_NV = WS_S + 68 * MiB, WS_NO = WS_S + 102 * MiB;
constexpr size_t WS_XP = WS_S, WS_H = WS_S + 76 * MiB, WS_YB = WS_S + 152 * MiB;
constexpr size_t WS_ROG = 940 * MiB;
constexpr size_t WS_END = 1008 * MiB;
static_assert((size_t)PMAX * 2048 <= 76 * MiB, "moe rows");

constexpr int LDS_BYTES = 159 * 1024;
constexpr int MISC_OFF = 158 * 1024;

__device__ __forceinline__ unsigned f2bf(float f) { unsigned u = __builtin_bit_cast(unsigned, f); return (u + 0x7fffu + ((u >> 16) & 1u)) >> 16; }
__device__ __forceinline__ unsigned pk2(float lo, float hi) { return f2bf(lo) | (f2bf(hi) << 16); }
__device__ __forceinline__ float bf2f(unsigned short b) { return __builtin_bit_cast(float, ((unsigned)b) << 16); }
__device__ __forceinline__ float bflo(unsigned u) { return __builtin_bit_cast(float, u << 16); }
__device__ __forceinline__ float bfhi(unsigned u) { return __builtin_bit_cast(float, u & 0xffff0000u); }
__device__ __forceinline__ float silu_f(float v) { return v * __builtin_amdgcn_rcpf(1.f + __expf(-v)); }
__device__ __forceinline__ float shx(float v, int o, int lane) { return __builtin_bit_cast(float, __builtin_amdgcn_ds_bpermute((lane ^ o) << 2, __builtin_bit_cast(int, v))); }
__device__ __forceinline__ float wave_sum(float v, int lane) {
#pragma unroll
    for (int o = 1; o < 64; o <<= 1) v += shx(v, o, lane);
    return v;
}
__device__ __forceinline__ int tid_of(int wave_sgpr) { int l; asm volatile("v_mbcnt_lo_u32_b32 %0, -1, 0\n\tv_mbcnt_hi_u32_b32 %0, -1, %0" : "=v"(l)); return wave_sgpr * 64 + l; }
#define LDS_WAIT() asm volatile("s_waitcnt lgkmcnt(0)" ::: "memory")
#define VM_WAIT() asm volatile("s_waitcnt vmcnt(0)" ::: "memory")

#define XB_TMO      128
#define XB_XCNT(j)  (256  + 64 * (j))
#define XB_XSUB(j)  (1280 + 64 * (j))
#define XB_XGEN(j)  (2304 + 64 * (j))
#define XB_TOP      3328
#define XB_TOPGEN   3392
#define XCD_BAR_WORDS 3456
#define XB_SPIN_CAP (1u << 18)
__device__ __forceinline__ unsigned xb_ld(unsigned* p)              { return __hip_atomic_load(p, __ATOMIC_RELAXED, __HIP_MEMORY_SCOPE_AGENT); }
__device__ __forceinline__ unsigned xb_add(unsigned* p, unsigned v) { return __hip_atomic_fetch_add(p, v, __ATOMIC_RELAXED, __HIP_MEMORY_SCOPE_AGENT); }
__device__ __forceinline__ unsigned xb_xcc_id() { return (unsigned)__builtin_amdgcn_s_getreg((3 << 11) | 20) & 0xFu; }
#define XB_SPIN(cond, bar) do { unsigned _sp = 0; while (cond) { __builtin_amdgcn_s_sleep(1); \
    if ((++_sp & 255u) == 0u) { if (xb_ld(&(bar)[XB_TMO])) break; if (_sp > XB_SPIN_CAP) { atomicAdd(&(bar)[XB_TMO], 1u); break; } } } } while (0)
struct XcdBarrier { unsigned* bar; unsigned x; volatile LAS unsigned* st; };
__device__ __forceinline__ XcdBarrier xcd_barrier_post(unsigned* bar, volatile LAS unsigned* st) {
    XcdBarrier b; b.bar = bar; b.x = xb_xcc_id(); b.st = st;
    if (threadIdx.x == 0) (void)xb_add(&bar[XB_XCNT(b.x)], 1u);
    return b;
}
__device__ __forceinline__ void xcd_barrier_complete(unsigned* bar, unsigned x, unsigned& nloc, unsigned& nx) {
    const unsigned G = gridDim.x * gridDim.y * gridDim.z;
    unsigned sum, cnt, mine, sp = 0u;
    for (;;) {
        sum = 0u; cnt = 0u; mine = 0u;
#pragma unroll
        for (unsigned j = 0; j < 16; ++j) { const unsigned c = xb_ld(&bar[XB_XCNT(j)]); sum += c; cnt += (c > 0u) ? 1u : 0u; mine = (j == x) ? c : mine; }
        if (sum == G) break;
        __builtin_amdgcn_s_sleep(1);
        if ((++sp & 255u) == 0u) { if (xb_ld(&bar[XB_TMO])) break; if (sp > XB_SPIN_CAP) { atomicAdd(&bar[XB_TMO], 1u); break; } }
    }
    nloc = mine > 0u ? mine : 1u; nx = cnt > 0u ? cnt : 1u;
}
__device__ __forceinline__ void xcd_barrier(const XcdBarrier& b, const int wave_sgpr) {
    asm volatile("s_waitcnt vmcnt(0)" ::: "memory");
    __syncthreads();
    if (tid_of(wave_sgpr) == 0) {
        unsigned* bar = b.bar;
        __builtin_amdgcn_s_waitcnt(0);
        unsigned nloc = b.st[0], nx = b.st[1];
        if (nloc == 0u) { xcd_barrier_complete(bar, b.x, nloc, nx); b.st[0] = nloc; b.st[1] = nx; }
        const unsigned old = xb_add(&bar[XB_XSUB(b.x)], 1u);
        const unsigned gen = old / nloc;
        if (old + 1u == (gen + 1u) * nloc) {
            __builtin_amdgcn_fence(__ATOMIC_RELEASE, "agent");
            asm volatile("s_waitcnt vmcnt(0)" ::: "memory");
            const unsigned og = xb_add(&bar[XB_TOP], 1u);
            const unsigned tg = og / nx;
            if (og + 1u == (tg + 1u) * nx) {
#pragma unroll
                for (unsigned jx = 0; jx < 16; ++jx) (void)xb_add(&bar[XB_XGEN(jx)], 1u);
            } else XB_SPIN(xb_ld(&bar[XB_XGEN(b.x)]) == gen, bar);
            __builtin_amdgcn_fence(__ATOMIC_ACQUIRE, "agent");
            asm volatile("s_waitcnt vmcnt(0)" ::: "memory");
        } else {
            XB_SPIN(xb_ld(&bar[XB_XGEN(b.x)]) == gen, bar);
            __builtin_amdgcn_fence(__ATOMIC_ACQUIRE, "agent");
            asm volatile("s_waitcnt vmcnt(0)" ::: "memory");
        }
    }
    __syncthreads();
}

namespace pg8 {
constexpr int BM = 256, BK = 64, HALF = 128, HTB = HALF * BK * 2, STAGE_BYTES = 8 * HTB;
__host__ __device__ __forceinline__ int lds_byte(int r, int c) { const int pos = (c >> 3) ^ ((r >> 1) & 7); return r * 128 + pos * 16 + (c & 7) * 2; }
__host__ __device__ __forceinline__ void stage_rc(int b, int& R, int& C) { R = b >> 7; const int pos = (b >> 4) & 7; C = (pos ^ ((R >> 1) & 7)) * 8 + ((b & 15) >> 1); }
__host__ __device__ __forceinline__ int perm32(int rho) { const int n = rho >> 4, i = rho & 15; return 8 * (i >> 2) + 4 * n + (i & 3); }

struct Unit { const char* A; const char* B0; int pm, pn, aux, nt; };

typedef int i32x8 __attribute__((ext_vector_type(8)));
__device__ __forceinline__ i32x8 cat_i8(const bf16x8& lo, const bf16x8& hi) { const u32x4 a = __builtin_bit_cast(u32x4, lo), b = __builtin_bit_cast(u32x4, hi); return (i32x8){(int)a.x, (int)a.y, (int)a.z, (int)a.w, (int)b.x, (int)b.y, (int)b.z, (int)b.w}; }
constexpr int FP8_SCALE_A = 0x7F7F7F7F, FP8_SCALE_B = 0x7F7F7F7F;
constexpr float FP8_WSCALE = 1.f / 32.f;
template <class E, class = void> struct has_brow : std::false_type {};
template <class E> struct has_brow<E, std::void_t<decltype(E::brow(0))>> : std::true_type {};
template <class E, class = void> struct has_lds_store : std::false_type {};
template <class E> struct has_lds_store<E, std::void_t<decltype(E::LDS_STORE)>> : std::true_type {};
template <class Epi, class Sched, bool ALIGN_EPI, bool FP8 = false>
__device__ __forceinline__ void gemm_phase(LAS unsigned char* lds, const Sched& S, const Epi& E, const int ldaB  , const int ldbB, const size_t hstepB  , const int wave_sgpr) {
    int tid = tid_of(wave_sgpr); asm volatile("" : "+v"(tid));
    const int wid = __builtin_amdgcn_readfirstlane(tid >> 6), lane = tid & 63, wr = wid >> 2, wc = wid & 3, fr = lane & 15, fq = lane >> 4;
    unsigned voffA[2], voffB[2];
#pragma unroll
    for (int i = 0; i < 2; ++i) { int R, C; stage_rc(tid * 16 + i * 8192, R, C); int Rb = Epi::PERM ? ((R & ~31) + perm32(R & 31)) : R;
        if constexpr (has_brow<Epi>::value) Rb = Epi::brow(R);
        voffA[i] = (unsigned)(R * ldaB + C * 2); voffB[i] = (unsigned)(Rb * ldbB + C * 2); }
    const size_t kstep = (size_t)(BK * 2);
    const size_t hstepA = (size_t)HALF * ldaB;
    const unsigned ldsw = (unsigned)wid * 1024u;
    const unsigned ldsbase = (unsigned)(size_t)lds + ldsw;
    const int aoff = lds_byte(wr * 64 + fr, fq * 8), boff = lds_byte(wc * 32 + fr, fq * 8);
#define PG8_SA(b, h) (((b) * 2 + (h)) * HTB)
#define PG8_SB(b, h) ((4 + (b) * 2 + (h)) * HTB)
#define PG8_STAGE(bufoff, gbase, voff) do { _Pragma("unroll") for (int _i = 0; _i < 2; ++_i) { \
        if constexpr (FP8) { unsigned keep_; asm volatile("s_mov_b32 %0, m0\n\ts_mov_b32 m0, %2\n\ts_nop 0\n\tglobal_load_lds_dwordx4 %1, %3\n\ts_mov_b32 m0, %0" : "=&s"(keep_) \
            : "v"((voff)[_i]), "s"(ldsbase + (unsigned)((bufoff) + _i * 8192)), "s"((const char*)(gbase)) : "memory"); } \
        else __builtin_amdgcn_global_load_lds((const unsigned*)((const char*)(gbase) + (voff)[_i]), (LAS unsigned*)(lds + (bufoff) + ldsw + _i * 8192), 16, 0, 0); } } while (0)
#define PG8_LDA(dst, b, h) do { int ao1_ = aoff ^ 64; asm volatile("" : "+v"(ao1_)); _Pragma("unroll") for (int m = 0; m < 4; ++m) { dst[m][0] = *(const LAS bf16x8*)(lds + PG8_SA(b, h) + aoff + m * 2048); dst[m][1] = *(const LAS bf16x8*)(lds + PG8_SA(b, h) + ao1_ + m * 2048); } } while (0)
#define PG8_LDB(dst, b, h) do { int bo1_ = boff ^ 64; asm volatile("" : "+v"(bo1_)); _Pragma("unroll") for (int n = 0; n < 2; ++n) { dst[n][0] = *(const LAS bf16x8*)(lds + PG8_SB(b, h) + boff + n * 2048); dst[n][1] = *(const LAS bf16x8*)(lds + PG8_SB(b, h) + bo1_ + n * 2048); } } while (0)
#define PG8_MMA(ai, bj, At, Bt) do { __builtin_amdgcn_s_setprio(1); _Pragma("unroll") for (int m = 0; m < 4; ++m) _Pragma("unroll") for (int n = 0; n < 2; ++n) { \
        if constexpr (FP8) acc[ai][bj][m][n] = __builtin_amdgcn_mfma_scale_f32_16x16x128_f8f6f4(cat_i8(Bt[n][0], Bt[n][1]), cat_i8(At[m][0], At[m][1]), acc[ai][bj][m][n], 0, 0, 0, FP8_SCALE_B, 0, FP8_SCALE_A); \
        else { _Pragma("unroll") for (int k = 0; k < 2; ++k) acc[ai][bj][m][n] = __builtin_amdgcn_mfma_f32_16x16x32_bf16(Bt[n][k], At[m][k], acc[ai][bj][m][n], 0, 0, 0); } } __builtin_amdgcn_s_setprio(0); } while (0)
#define PG8_WAIT_V(n) asm volatile("s_waitcnt vmcnt(" #n ")" ::: "memory")
#define PG8_WAIT_L(n) asm volatile("s_waitcnt lgkmcnt(" #n ")" ::: "memory")
#define PG8_BAR __builtin_amdgcn_s_barrier()
#define PG8_SCHED __builtin_amdgcn_sched_barrier(0)
    Unit cur, nxt; int ui = 0;
    if (!S.next(0, cur)) return;
    f32x4 acc[2][2][4][2];
#pragma unroll
    for (int a = 0; a < 2; ++a)
#pragma unroll
        for (int b = 0; b < 2; ++b)
#pragma unroll
            for (int m = 0; m < 4; ++m)
#pragma unroll
                for (int n = 0; n < 2; ++n) acc[a][b][m][n] = (f32x4){0.f, 0.f, 0.f, 0.f};
    bf16x8 At[4][2], B0[2][2], B1[2][2];
    const char* cA = cur.A; const char* cB0 = cur.B0;
    PG8_STAGE(PG8_SB(0, 0), cB0, voffB); PG8_STAGE(PG8_SB(0, 1), cB0 + hstepB, voffB); PG8_STAGE(PG8_SA(0, 0), cA, voffA); PG8_STAGE(PG8_SA(0, 1), cA + hstepA, voffA);
    if (wr == 1) PG8_BAR;
    PG8_WAIT_V(2); PG8_BAR;
    PG8_STAGE(PG8_SB(1, 0), cB0 + kstep, voffB); PG8_STAGE(PG8_SA(1, 0), cA + kstep, voffA); PG8_STAGE(PG8_SB(1, 1), cB0 + hstepB + kstep, voffB);
    PG8_WAIT_V(6); PG8_BAR;
    for (;;) {
        const bool has_next = S.next(ui + 1, nxt);
        const char* nA = has_next ? nxt.A : cA; const char* nB0 = has_next ? nxt.B0 : cB0;
        int nt = cur.nt; asm volatile("" : "+s"(nt));
        for (int t = 0; t < nt; t += 2) {
            const bool last = (t == nt - 2);
            const char* a1 = cA + (size_t)(t + 1) * kstep;
            const char* a2 = last ? nA : cA + (size_t)(t + 2) * kstep;
            const char* b20 = last ? nB0 : cB0 + (size_t)(t + 2) * kstep;
            const char* a3 = a2 + kstep; const char* b30 = b20 + kstep;
            PG8_LDB(B0, 0, 0); PG8_LDB(B1, 0, 1); PG8_SCHED; PG8_LDA(At, 0, 0); PG8_STAGE(PG8_SA(1, 1), a1 + hstepA, voffA);
            PG8_WAIT_V(8); PG8_WAIT_L(0); PG8_BAR; PG8_MMA(0, 0, At, B0); PG8_MMA(0, 1, At, B1); PG8_BAR; PG8_SCHED;
            PG8_LDA(At, 0, 1); PG8_STAGE(PG8_SB(0, 0), b20, voffB); PG8_STAGE(PG8_SB(0, 1), b20 + hstepB, voffB); PG8_STAGE(PG8_SA(0, 0), a2, voffA);
            PG8_WAIT_V(8); PG8_WAIT_L(0); PG8_BAR; PG8_MMA(1, 0, At, B0); PG8_MMA(1, 1, At, B1); PG8_BAR; PG8_SCHED;
            PG8_LDB(B0, 1, 0); PG8_LDB(B1, 1, 1); PG8_SCHED; PG8_LDA(At, 1, 0); PG8_STAGE(PG8_SA(0, 1), a2 + hstepA, voffA);
            PG8_WAIT_V(8); PG8_WAIT_L(0); PG8_BAR; PG8_MMA(0, 0, At, B0); PG8_MMA(0, 1, At, B1); PG8_BAR; PG8_SCHED;
            PG8_LDA(At, 1, 1); PG8_STAGE(PG8_SB(1, 0), b30, voffB); PG8_STAGE(PG8_SB(1, 1), b30 + hstepB, voffB); PG8_STAGE(PG8_SA(1, 0), a3, voffA);
            PG8_WAIT_V(8); PG8_WAIT_L(0); PG8_BAR; PG8_MMA(1, 0, At, B0); PG8_MMA(1, 1, At, B1); PG8_BAR; PG8_SCHED;
        }
        if constexpr (ALIGN_EPI) { if (wr == 0) PG8_BAR; }
        { int t_e = tid_of(wave_sgpr); asm volatile("" : "+v"(t_e)); const int fr_e = t_e & 15, fq_e = (t_e >> 4) & 3;
          if constexpr (has_lds_store<Epi>::value) { static_assert(ALIGN_EPI, "LDS-staged epilogues use workgroup barriers"); E.lds_store(acc, cur, wr, wc, fr_e, fq_e, lds + STAGE_BYTES, t_e); }
          else E(acc, cur, wr, wc, fr_e, fq_e); }
        if (!has_next) break;
#pragma unroll
        for (int a = 0; a < 2; ++a)
#pragma unroll
            for (int b = 0; b < 2; ++b)
#pragma unroll
                for (int m = 0; m < 4; ++m)
#pragma unroll
                    for (int n = 0; n < 2; ++n) acc[a][b][m][n] = (f32x4){0.f, 0.f, 0.f, 0.f};
        cur = nxt; cA = nA; cB0 = nB0; ++ui;
        if constexpr (ALIGN_EPI) { if (wr == 1) PG8_BAR; }
    }
    PG8_WAIT_V(0);
    if constexpr (!ALIGN_EPI) { if (wr == 0) PG8_BAR; }
    PG8_BAR;
#undef PG8_SA
#undef PG8_SB
#undef PG8_STAGE
#undef PG8_LDA
#undef PG8_LDB
#undef PG8_MMA
#undef PG8_WAIT_V
#undef PG8_WAIT_L
#undef PG8_BAR
#undef PG8_SCHED
}

constexpr int NXCD = 8, WGM = 8;
struct StaticSched {
    const char* A; const char* Bt; size_t ldaB, ldbB; int nM, nN, nwg, G, c, nt;
    __device__ void init(const void* A_, const void* Bt_, int M, int N, int K, int lda, int ldb, int G_, int c_) { A = (const char*)A_; Bt = (const char*)Bt_; ldaB = (size_t)lda * 2; ldbB = (size_t)ldb * 2; nM = M / BM; nN = N / BM; nwg = nM * nN; G = G_; c = c_; nt = K / BK; }
    __device__ bool next(int i, Unit& u) const {
        const long L = (long)i * G + c; if (L >= nwg) return false;
        int wgid = (int)L; { const int q = nwg / NXCD, r = nwg % NXCD, xcd = wgid % NXCD, off = wgid / NXCD; wgid = (xcd < r ? xcd * (q + 1) : r * (q + 1) + (xcd - r) * q) + off; }
        const int nig = WGM * nN, gid = wgid / nig, fm = gid * WGM, gsz = (nM - fm) < WGM ? (nM - fm) : WGM;
        u.pm = fm + ((wgid % nig) % gsz); u.pn = (wgid % nig) / gsz; u.aux = 0; u.nt = nt;
        u.A = A + (size_t)u.pm * BM * ldaB; u.B0 = Bt + (size_t)u.pn * BM * ldbB; return true;
    }
};
}

struct Args { const float* in[22]; float* out; unsigned char* ws; int ph_lo, ph_hi; };
struct Frame {
    LAS unsigned char* lds; volatile LAS unsigned* MISC;
    int vcu, G, wv;
    unsigned char* ws;
};
enum { I_X = 0, I_C, I_CTX, I_CCTX, I_WMOD, I_BMOD, I_NMIX, I_NFFN, I_NFIN, I_RWIN, I_RDEC, I_RGN, I_RWOUT, I_FNW, I_NAQKV, I_NARPB, I_NAOUT, I_RTW, I_RTB, I_MG, I_MU, I_MD };

__device__ __forceinline__ const float* modv(const unsigned char* ws, int layer, int bidx, int which) { return (const float*)(ws + WS_MOD) + ((size_t)(layer * 5 + bidx) * NMOD + which) * D; }
__device__ __forceinline__ int bidx_of_row(int row) { return row < NLAT ? (row >> 12) : 4; }

#ifndef REP_MASK
#define REP_MASK 0
#endif
#define NREP(b) (1 + ((REP_MASK >> (b)) & 1))
__device__ __forceinline__ int rope_perm(int n) {
    if (n >= 2048) return n;
    const int head = n >> 8, c = n & 255, qd = c >> 6, i = c & 63;
    const int j = (qd == 0) ? i : (qd == 2) ? 64 + i : (qd == 1) ? 128 + i : 192 + i;
    return head * 256 + j;
}
struct TItem { const float* W; bf16* WT; int K, N, item; bool rp; bool f8; };
__device__ __forceinline__ void titem_load(const TItem& t, f32x4 (&v)[16], int lane) {
    const int nblk = t.N / 64, kb = t.item / nblk, nb = t.item % nblk, k0 = 64 * kb, n0 = 64 * nb;
    const float* src = t.W + (size_t)(k0 + (lane >> 4)) * t.N + n0 + (lane & 15) * 4;
#pragma unroll
    for (int r = 0; r < 16; ++r) v[r] = *(const f32x4*)(src + (size_t)(4 * r) * t.N);
}
__device__ __forceinline__ void titem_store(const TItem& t, const f32x4 (&v)[16], LAS float* scr, int lane) {
    const int nblk = t.N / 64, kb = t.item / nblk, nb = t.item % nblk, k0 = 64 * kb, n0 = 64 * nb;
#pragma unroll
    for (int r = 0; r < 16; ++r) { const int kk = 4 * r + (lane >> 4), n4 = (lane & 15) * 4;
        scr[kk * 65 + n4 + 0] = v[r][0]; scr[kk * 65 + n4 + 1] = v[r][1]; scr[kk * 65 + n4 + 2] = v[r][2]; scr[kk * 65 + n4 + 3] = v[r][3]; }
    LDS_WAIT(); asm volatile("" ::: "memory");
    const int c = lane & 7;
#pragma unroll 2
    for (int j = 0; j < 8; ++j) { const int n = 8 * j + (lane >> 3); const LAS float* s = scr + (8 * c) * 65 + n;
        float x[8];
#pragma unroll
        for (int q = 0; q < 8; ++q) x[q] = s[q * 65];
        const int nd = t.rp ? rope_perm(n0 + n) : (n0 + n);
        if (t.f8) { u32x2 o8; int q = __builtin_amdgcn_cvt_pk_fp8_f32(x[0] * 32.f, x[1] * 32.f, 0, false); q = __builtin_amdgcn_cvt_pk_fp8_f32(x[2] * 32.f, x[3] * 32.f, q, true); o8.x = (unsigned)q;
            q = __builtin_amdgcn_cvt_pk_fp8_f32(x[4] * 32.f, x[5] * 32.f, 0, false); q = __builtin_amdgcn_cvt_pk_fp8_f32(x[6] * 32.f, x[7] * 32.f, q, true); o8.y = (unsigned)q;
            *(u32x2*)((unsigned char*)t.WT + (size_t)nd * t.K + k0 + 8 * c) = o8; }
        else { u32x4 o; o.x = pk2(x[0], x[1]); o.y = pk2(x[2], x[3]); o.z = pk2(x[4], x[5]); o.w = pk2(x[6], x[7]); *(u32x4*)(t.WT + (size_t)nd * t.K + k0 + 8 * c) = o; } }
    LDS_WAIT(); asm volatile("" ::: "memory");
}
__device__ __forceinline__ int seg_items(int seg) { return seg < 2 ? 16 * 96 : seg < 4 ? 32 * 16 : seg == 4 ? 256 : seg == 5 ? 16 * 48 : seg == 6 ? 256 : 16 * 256; }
template <int NSEG>
__device__ __forceinline__ TItem titem_decode(const Args& a, bf16* WB, const int (&segs)[NSEG], int it) {
    int seg = segs[0], before = 0, accn = 0; bool found = false;
#pragma unroll
    for (int i = 0; i < NSEG; ++i) { const int n = seg_items(segs[i]); if (!found && it < accn + n) { seg = segs[i]; before = accn; found = true; } accn += n; }
    const int li = it - before;
    TItem t; t.rp = false; t.f8 = false; t.item = li;
    if (seg < 2) { t.W = a.in[I_RWIN] + (size_t)seg * 1024 * 6144; t.K = 1024; t.N = 6144; t.WT = WB + WE_RIN + (size_t)seg * 6144 * 1024; t.rp = true; t.f8 = FP8_INPROJ != 0; }
    else if (seg < 4) { const int j = seg - 2; t.W = a.in[I_RWOUT] + (size_t)j * 2048 * 1024; t.K = 2048; t.N = 1024; t.WT = WB + WE_ROUT + (size_t)j * 1024 * 2048; t.f8 = FP8_OUTPROJ != 0; }
    else if (seg == 4) { t.W = a.in[I_FNW]; t.K = 1024; t.N = 1024; t.WT = WB + WE_FN; t.f8 = FP8_OUT2 != 0; }
    else if (seg == 5) { t.W = a.in[I_NAQKV]; t.K = 1024; t.N = 3072; t.WT = WB + WE_NQKV; t.f8 = FP8_INPROJ != 0; }
    else if (seg == 6) { t.W = a.in[I_NAOUT]; t.K = 1024; t.N = 1024; t.WT = WB + WE_NOUT; t.f8 = FP8_OUT2 != 0; }
    else { const int l = (seg - 7) / 3, which = (seg - 7) % 3, mi = l * 16 + (li >> 8); t.item = li & 255; t.K = 1024; t.N = 1024;
        t.W = a.in[which == 0 ? I_MG : which == 1 ? I_MU : I_MD] + (size_t)mi * 1048576; t.f8 = true;
        t.WT = (bf16*)((unsigned char*)(WB + (which == 0 ? WE_MG : which == 1 ? WE_MU : WE_MD)) + (size_t)mi * 1048576); }
    return t;
}
constexpr int BG_NSEG = 19;
constexpr int BG_NEED_RIN0 = 1536, BG_NEED_ROUT0 = BG_NEED_RIN0 + 512, BG_NEED_MOE0 = BG_NEED_ROUT0 + 3 * 4096, BG_NEED_FN = BG_NEED_MOE0 + 256, BG_NEED_MOE1 = BG_NEED_FN + 3 * 4096,
              BG_NEED_NQKV = BG_NEED_MOE1 + 768, BG_NEED_NOUT = BG_NEED_NQKV + 256, BG_NEED_MOE2 = BG_NEED_NOUT + 3 * 4096, BG_NEED_RIN1 = BG_NEED_MOE2 + 1536, BG_NEED_ROUT1 = BG_NEED_RIN1 + 512,
              BG_TOTAL = BG_NEED_ROUT1 + 3 * 4096;
constexpr int CW_QHEAD = 4096, CW_PHDONE = 8192;
__device__ __forceinline__ TItem bg_decode(const Args& a, bf16* WB, int it) {
    const int segs[BG_NSEG] = {0, 2, 7, 8, 9, 4, 10, 11, 12, 5, 6, 13, 14, 15, 1, 3, 16, 17, 18};
    return titem_decode<BG_NSEG>(a, WB, segs, it);
}
__device__ __forceinline__ void bg_work(const Args& a, unsigned char* wso, LAS unsigned char* lds, volatile LAS unsigned* misc, int wave, int lane, int ph, bool busy, int need) {
    unsigned* ctl = (unsigned*)(wso + WS_CTL);
    bf16* WB = (bf16*)(wso + WS_W);
    LAS float* scr = (LAS float*)lds + wave * (64 * 65);
    for (;;) {
        __syncthreads();
        if (wave == 0 && lane == 0) {
            const unsigned h = __hip_atomic_load(ctl + CW_QHEAD, __ATOMIC_RELAXED, __HIP_MEMORY_SCOPE_AGENT);
            unsigned base = (unsigned)BG_TOTAL;
            bool go = h < (unsigned)BG_TOTAL;
            if (go && h >= (unsigned)need) { if (busy) go = false; else if (__hip_atomic_load(ctl + CW_PHDONE + 64 * ph, __ATOMIC_RELAXED, __HIP_MEMORY_SCOPE_AGENT) != 0u) go = false; }
            if (go) base = __hip_atomic_fetch_add(ctl + CW_QHEAD, 64u, __ATOMIC_RELAXED, __HIP_MEMORY_SCOPE_AGENT);
            misc[64] = base;
        }
        __syncthreads();
        const int base = (int)misc[64];
        if (base >= BG_TOTAL) break;
        f32x4 va[16], vb[16];
        TItem ta = bg_decode(a, WB, min(base + wave, BG_TOTAL - 1)), tb = ta;
        bool oka = base + wave < BG_TOTAL, okb = false;
        if (oka) titem_load(ta, va, lane);
#pragma unroll 1
        for (int i = 0; i < 8; i += 2) {
            const int ib = base + wave + 8 * (i + 1), ia2 = base + wave + 8 * (i + 2);
            okb = ib < BG_TOTAL; if (okb) { tb = bg_decode(a, WB, ib); titem_load(tb, vb, lane); }
            if (oka) titem_store(ta, va, scr, lane);
            oka = (i + 2 < 8) && ia2 < BG_TOTAL; if (oka) { ta = bg_decode(a, WB, ia2); titem_load(ta, va, lane); }
            if (okb) titem_store(tb, vb, scr, lane);
        }
    }
}
__device__ __forceinline__ void bg_signal(unsigned char* wso, int ph) {
    __hip_atomic_fetch_add((unsigned*)(wso + WS_CTL) + CW_PHDONE + 64 * ph, 1u, __ATOMIC_RELAXED, __HIP_MEMORY_SCOPE_AGENT);
}

__device__ __forceinline__ void p_prologue(Frame& F, const Args& a) {
    int tid = tid_of(F.wv); asm volatile("" : "+v"(tid)); const int lane = tid & 63, wave = __builtin_amdgcn_readfirstlane(tid >> 6); (void)lane; (void)wave;
    GAS unsigned char* wsg_ = (GAS unsigned char*)F.ws; asm volatile("" : "+s"(wsg_)); unsigned char* wso = (unsigned char*)wsg_;
    for (int rr_ = 0; rr_ < NREP(16); ++rr_) if ((int)blockIdx.x < NLAYER * 48) {
        LAS float* act = (LAS float*)F.lds;
        LAS float* red = act + 5 * 1024;
        for (int idx = tid; idx < 5 * 1024; idx += 512) { const int r = idx >> 10, k = idx & 1023; const float v = (r < 4) ? a.in[I_C][r * 1024 + k] : a.in[I_CCTX][k]; act[idx] = silu_f(v); }
        __syncthreads();
        {
            const int u = (int)blockIdx.x;
            const int layer = u / 48, n0 = (u % 48) * 128;
            const float* w = a.in[I_WMOD] + (size_t)layer * 1024 * 6144 + n0 + 2 * lane;
            f32x2 s0 = (f32x2){0.f, 0.f}, s1 = s0, s2 = s0, s3 = s0, s4 = s0;
            const int kb = wave * 128;
#pragma unroll 16
            for (int k = 0; k < 128; ++k) { const f32x2 wv = *(const f32x2*)(w + (size_t)(kb + k) * 6144);
                s0 += wv * act[kb + k]; s1 += wv * act[1024 + kb + k]; s2 += wv * act[2048 + kb + k]; s3 += wv * act[3072 + kb + k]; s4 += wv * act[4096 + kb + k]; }
            *(LAS f32x2*)(red + (wave * 5 + 0) * 128 + 2 * lane) = s0; *(LAS f32x2*)(red + (wave * 5 + 1) * 128 + 2 * lane) = s1; *(LAS f32x2*)(red + (wave * 5 + 2) * 128 + 2 * lane) = s2;
            *(LAS f32x2*)(red + (wave * 5 + 3) * 128 + 2 * lane) = s3; *(LAS f32x2*)(red + (wave * 5 + 4) * 128 + 2 * lane) = s4;
            __syncthreads();
            for (int o = tid; o < 5 * 128; o += 512) { const int r = o >> 7, l = o & 127; float sm = 0.f;
#pragma unroll
                for (int w8 = 0; w8 < 8; ++w8) sm += red[(w8 * 5 + r) * 128 + l];
                const int nn = n0 + l; sm += a.in[I_BMOD][layer * 6144 + nn];
                ((float*)(wso + WS_MOD))[((size_t)(layer * 5 + r) * NMOD + nn / 1024) * D + (nn & 1023)] = sm; }
            __syncthreads();
        }
    }
    __syncthreads();
    for (int rr_ = 0; rr_ < NREP(17); ++rr_) {
        bf16* AL = (bf16*)(wso + WS_AL);
        const int nchunk = 8 * 512 * 1024 / 8;
        for (int ch = F.vcu * 512 + tid; ch < nchunk; ch += F.G * 512) {
            const int r = ch >> 16, m = (ch >> 7) & 511, k0 = (ch & 127) * 8;
            const int mul = 8 * m + r;
            float v[8];
#pragma unroll
            for (int e = 0; e < 8; ++e) { const int l = 4 * (k0 >> 3) + (e & 3); const float x = (float)((mul * l) & 4095) * (1.f / 4096.f);
                v[e] = (e < 4) ? __builtin_amdgcn_cosf(x) * (1.f / 64.f) : -__builtin_amdgcn_sinf(x) * (1.f / 64.f); }
            if (FP8_F2) { int t0 = __builtin_amdgcn_cvt_pk_fp8_f32(v[0] * 256.f, v[1] * 256.f, 0, false); t0 = __builtin_amdgcn_cvt_pk_fp8_f32(v[2] * 256.f, v[3] * 256.f, t0, true);
                int t1 = __builtin_amdgcn_cvt_pk_fp8_f32(v[4] * 256.f, v[5] * 256.f, 0, false); t1 = __builtin_amdgcn_cvt_pk_fp8_f32(v[6] * 256.f, v[7] * 256.f, t1, true);
                *(u32x2*)((unsigned char*)AL + (size_t)r * 512 * 1024 + (size_t)m * 1024 + k0) = (u32x2){(unsigned)t0, (unsigned)t1}; }
            else {
            u32x4 o; o.x = pk2(v[0], v[1]); o.y = pk2(v[2], v[3]); o.z = pk2(v[4], v[5]); o.w = pk2(v[6], v[7]);
            *(u32x4*)(AL + (size_t)r * 512 * 1024 + (size_t)m * 1024 + k0) = o; }
        }
        if (F.vcu == 4 % F.G) {
            bf16* A1N = (bf16*)(wso + WS_A1N);
            for (int idx = tid; idx < 512 * 256; idx += 512) { const int row = idx >> 8, c = idx & 255, chh = row >> 8, sgn = (row >> 7) & 1, cp = chh * 128 + (row & 127); const float x = (float)((c * cp) & 255) * (1.f / 256.f);
                const float v = (sgn == 0) ? __builtin_amdgcn_cosf(x) : __builtin_amdgcn_sinf(x); A1N[idx] = (bf16)f2bf(v * (1.f / 16.f)); }
        }
        if (F.vcu == 2 % F.G) {
            bf16* A1 = (bf16*)(wso + WS_A1);
            for (int idx = tid; idx < 512 * 256; idx += 512) { const int row = idx >> 8, c = idx & 255, sgn = row >> 8, cp = row & 255; const float x = (float)((c * cp) & 255) * (1.f / 256.f);
                const float v = (sgn == 0) ? __builtin_amdgcn_cosf(x) : __builtin_amdgcn_sinf(x); A1[idx] = (bf16)f2bf(v * (1.f / 16.f)); }
        }
        if (F.vcu == 3 % F.G) {
            bf16* ALC = (bf16*)(wso + WS_ALC);
            for (int idx = tid; idx < 256 * 512; idx += 512) { const int lp = idx >> 9, k = idx & 511, kk = k & 255; const float x = (float)((lp * kk) & 255) * (1.f / 256.f);
                const float v = (k < 256) ? __builtin_amdgcn_cosf(x) : -__builtin_amdgcn_sinf(x); ALC[idx] = (bf16)f2bf(v * (1.f / 16.f)); }
        }
        if (F.vcu == 1 % F.G) {
            f32x2* rt = (f32x2*)(wso + WS_ROPE);
            for (int idx = tid; idx < 64 * 64; idx += 512) { const int pos = idx >> 6, f = idx & 63; const float inv = powf(10000.f, -(float)f / 64.f); const float ang = (float)pos * inv;
                rt[idx] = (f32x2){cosf(ang), sinf(ang)}; }
        }
        __syncthreads();
    }
    bg_work(a, wso, F.lds, F.MISC, wave, lane, 0, true, BG_NEED_RIN0);
}

struct Row16 { f32x4 v[4]; };
__device__ __forceinline__ Row16 ld_row_f32(const float* p, int lane) { Row16 r;
#pragma unroll
    for (int j = 0; j < 4; ++j) r.v[j] = *(const f32x4*)(p + 256 * j + 4 * lane);
    return r; }
__device__ __forceinline__ void st_row_f32(float* p, int lane, const Row16& r) {
#pragma unroll
    for (int j = 0; j < 4; ++j) *(f32x4*)(p + 256 * j + 4 * lane) = r.v[j]; }
__device__ __forceinline__ Row16 ld_row_bf16(const bf16* p, int lane) { Row16 r;
#pragma unroll
    for (int j = 0; j < 4; ++j) { const u32x2 u = *(const u32x2*)(p + 256 * j + 4 * lane); r.v[j] = (f32x4){bflo(u.x), bfhi(u.x), bflo(u.y), bfhi(u.y)}; }
    return r; }
__device__ __forceinline__ void st_row_bf16(bf16* p, int lane, const Row16& r) {
#pragma unroll
    for (int j = 0; j < 4; ++j) { u32x2 u; u.x = pk2(r.v[j][0], r.v[j][1]); u.y = pk2(r.v[j][2], r.v[j][3]); *(u32x2*)(p + 256 * j + 4 * lane) = u; } }
__device__ __forceinline__ float row_rstd(const Row16& r, int lane) { float s = 0.f;
#pragma unroll
    for (int j = 0; j < 4; ++j) s += (r.v[j][0] * r.v[j][0] + r.v[j][1] * r.v[j][1]) + (r.v[j][2] * r.v[j][2] + r.v[j][3] * r.v[j][3]);
    return rsqrtf(wave_sum(s, lane) * (1.f / D) + EPS); }

#define PRE_NPF 3
__device__ __forceinline__ void st_row_fp8(unsigned char* p, int lane, const Row16& r) {
#pragma unroll
    for (int j = 0; j < 4; ++j) { int t = __builtin_amdgcn_cvt_pk_fp8_f32(r.v[j][0], r.v[j][1], 0, false); t = __builtin_amdgcn_cvt_pk_fp8_f32(r.v[j][2], r.v[j][3], t, true); *(int*)(p + 256 * j + 4 * lane) = t; } }
template <int MODE>
__device__ __forceinline__ void p_pre(Frame& F, const Args& a, int layer) {
    int tid = tid_of(F.wv); asm volatile("" : "+v"(tid)); const int lane = tid & 63, wave = __builtin_amdgcn_readfirstlane(tid >> 6); (void)lane; (void)wave;
    GAS unsigned char* wsg_ = (GAS unsigned char*)F.ws; asm volatile("" : "+s"(wsg_)); unsigned char* wso = (unsigned char*)wsg_;
    int vcu_o = F.vcu; asm volatile("" : "+s"(vcu_o));
    const int gw = vcu_o * 8 + wave, NGW = F.G * 8;
    bf16* XALL = (bf16*)(wso + WS_XALL); bf16* ACT = (bf16*)(wso + WS_ACT);
    const bf16* YB = (const bf16*)(wso + WS_YB); const int* DEST = (const int*)(wso + WS_DEST); const float* ROUTE = (const float*)(wso + WS_ROUTE);
    const int nrows = (MODE == 2) ? NLAT : NTOK;
    const bool fold = (MODE == 1) && (layer == 1);
    const bool f8act = FP8_INPROJ && (MODE == 0 || (MODE == 1 && layer != 1));
    const int nitems = fold ? (NLAT / 4 + NCTX) : nrows;
    const int it0 = (int)((unsigned)(gw * nitems) / (unsigned)NGW), it1 = (int)((unsigned)((gw + 1) * nitems) / (unsigned)NGW);
    const int nseq = (it1 - it0) << (fold ? 2 : 0);
    auto row_of = [&](int p) -> int {
        if (!fold) return it0 + p;
        const int item = it0 + (p >> 2), q = p & 3;
        if (item < NLAT / 4) return (item >> 10) * 4096 + (item & 1023) + ((q & 1) * 2 + (q >> 1)) * 1024;
        return q ? -1 : NLAT + (item - NLAT / 4); };
    const Row16 nw = ld_row_f32((MODE < 2 ? a.in[I_NMIX] + layer * D : a.in[I_NFIN]), lane);
    int dd0 = 0, dd1 = 0, ww0 = 0, ww1 = 0;
    if (MODE > 0) { const int r = row_of(lane); if (lane < nseq && r >= 0) { const u32x2 dv = *(const u32x2*)(DEST + r * 2); const u32x2 wv = *(const u32x2*)(ROUTE + r * 8 + 4); dd0 = (int)dv.x; dd1 = (int)dv.y; ww0 = (int)wv.x; ww1 = (int)wv.y; } }
    struct Slot { f32x4 xf[MODE == 0 ? 4 : 1]; u32x2 x[MODE == 0 ? 1 : 4], y0[MODE == 0 ? 1 : 4], y1[MODE == 0 ? 1 : 4]; };
    auto issue = [&](Slot& S, int p) {
        int pc = p < nseq ? p : nseq - 1; int r = row_of(pc); if (r < 0) { pc &= ~3; r = row_of(pc); }
        if (MODE == 0) { const float* src = r < NLAT ? a.in[I_X] + (size_t)r * D : a.in[I_CTX] + (size_t)(r - NLAT) * D;
#pragma unroll
            for (int j = 0; j < 4; ++j) S.xf[j] = *(const f32x4*)(src + 256 * j + 4 * lane);
        } else {
            const int d0 = __builtin_amdgcn_readlane(dd0, pc), d1 = __builtin_amdgcn_readlane(dd1, pc);
            const bf16* px = XALL + (size_t)r * D; const bf16* p0 = YB + (size_t)d0 * D; const bf16* p1 = YB + (size_t)d1 * D;
#pragma unroll
            for (int j = 0; j < 4; ++j) S.x[j] = *(const u32x2*)(px + 256 * j + 4 * lane);
#pragma unroll
            for (int j = 0; j < 4; ++j) { if (FP8_YB) S.y0[j].x = *(const unsigned*)((const unsigned char*)YB + (size_t)d0 * D + 256 * j + 4 * lane); else S.y0[j] = *(const u32x2*)(p0 + 256 * j + 4 * lane); }
#pragma unroll
            for (int j = 0; j < 4; ++j) { if (FP8_YB) S.y1[j].x = *(const unsigned*)((const unsigned char*)YB + (size_t)d1 * D + 256 * j + 4 * lane); else S.y1[j] = *(const u32x2*)(p1 + 256 * j + 4 * lane); }
        } };
    int cur_bi = -1; Row16 gp, sh, sc, hA, hB;
    auto consume = [&](const Slot& S, int p) {
        const int row = row_of(p);
        if (row < 0) return;
        const int bi = bidx_of_row(row);
        if (bi != cur_bi) { cur_bi = bi;
            if (MODE > 0) gp = ld_row_f32(modv(wso, layer - 1, bi, 5), lane);
            if (MODE < 2) { sh = ld_row_f32(modv(wso, layer, bi, 0), lane); sc = ld_row_f32(modv(wso, layer, bi, 1), lane); } }
        Row16 x;
        if (MODE == 0) {
#pragma unroll
            for (int j = 0; j < 4; ++j) x.v[j] = S.xf[j];
        } else {
            const float ysc = FP8_YB ? pg8::FP8_WSCALE : 1.f;
            const float w0 = __builtin_bit_cast(float, __builtin_amdgcn_readlane(ww0, p)) * ysc, w1 = __builtin_bit_cast(float, __builtin_amdgcn_readlane(ww1, p)) * ysc;
#pragma unroll
            for (int j = 0; j < 4; ++j) {
                const f32x4 xv = {bflo(S.x[j].x), bfhi(S.x[j].x), bflo(S.x[j].y), bfhi(S.x[j].y)};
                f32x4 a0, a1;
                if (FP8_YB) { const f32x2 l0 = __builtin_amdgcn_cvt_pk_f32_fp8((int)S.y0[j].x, false), h0 = __builtin_amdgcn_cvt_pk_f32_fp8((int)S.y0[j].x, true), l1 = __builtin_amdgcn_cvt_pk_f32_fp8((int)S.y1[j].x, false), h1 = __builtin_amdgcn_cvt_pk_f32_fp8((int)S.y1[j].x, true);
                    a0 = (f32x4){l0.x, l0.y, h0.x, h0.y}; a1 = (f32x4){l1.x, l1.y, h1.x, h1.y}; }
                else { a0 = (f32x4){bflo(S.y0[j].x), bfhi(S.y0[j].x), bflo(S.y0[j].y), bfhi(S.y0[j].y)}; a1 = (f32x4){bflo(S.y1[j].x), bfhi(S.y1[j].x), bflo(S.y1[j].y), bfhi(S.y1[j].y)}; }
                x.v[j] = xv + gp.v[j] * (a0 * w0 + a1 * w1); }
        }
        Row16 h;
        const float rs = row_rstd(x, lane);
        if (MODE < 2) {
            st_row_bf16(XALL + (size_t)row * D, lane, x);
#pragma unroll
            for (int j = 0; j < 4; ++j) h.v[j] = (x.v[j] * rs) * nw.v[j] * (sc.v[j] + 1.f) + sh.v[j];
            if (fold && row < NLAT) {
                const int q = p & 3;
                bf16* ab = ACT + (size_t)((row & ~4095) + (row & 1023)) * D;
                if (q == 0) hA = h;
                else if (q == 1) { Row16 o2;
#pragma unroll
                    for (int j = 0; j < 4; ++j) { o2.v[j] = hA.v[j] - h.v[j]; hA.v[j] = hA.v[j] + h.v[j]; }
                    st_row_bf16(ab + (size_t)2048 * D, lane, o2); }
                else if (q == 2) hB = h;
                else { Row16 o0, o1, o3;
#pragma unroll
                    for (int j = 0; j < 4; ++j) { const f32x4 od = hB.v[j] + h.v[j]; o0.v[j] = hA.v[j] + od; o1.v[j] = hA.v[j] - od; o3.v[j] = h.v[j] - hB.v[j]; }
                    st_row_bf16(ab, lane, o0); st_row_bf16(ab + (size_t)1024 * D, lane, o1); st_row_bf16(ab + (size_t)3072 * D, lane, o3); }
            } else if (f8act) st_row_fp8((unsigned char*)ACT + (size_t)row * D, lane, h);
            else st_row_bf16(ACT + (size_t)row * D, lane, h);
        } else {
#pragma unroll
            for (int j = 0; j < 4; ++j) h.v[j] = (x.v[j] * rs) * nw.v[j];
            st_row_f32(a.out + (size_t)row * D, lane, h);
        } };
    Slot ring[PRE_NPF];
#pragma unroll
    for (int u = 0; u < PRE_NPF; ++u) issue(ring[u], u);
    for (int pb = 0; pb < nseq; pb += PRE_NPF) {
#pragma unroll
        for (int u = 0; u < PRE_NPF; ++u) { const int p = pb + u; if (p < nseq) consume(ring[u], p); issue(ring[u], p + PRE_NPF); }
    }
}

#define MID_RS 2064
__device__ __forceinline__ void p_mid(Frame& F, const Args& a, int layer, int nrows) {
    int tid = tid_of(F.wv); asm volatile("" : "+v"(tid)); const int lane = tid & 63, wave = __builtin_amdgcn_readfirstlane(tid >> 6); (void)lane; (void)wave;
    GAS unsigned char* wsg_ = (GAS unsigned char*)F.ws; asm volatile("" : "+s"(wsg_)); unsigned char* wso = (unsigned char*)wsg_;
    int vcu_o = F.vcu; asm volatile("" : "+s"(vcu_o));
    const int gw = vcu_o * 8 + wave, NGW = F.G * 8;
    const bf16* XALL = (const bf16*)(wso + WS_XALL); unsigned char* ACT8 = wso + WS_ACT;
    LAS unsigned char* wh = F.lds; LAS unsigned char* wl = F.lds + 16 * MID_RS;
    LAS int* cnt = (LAS int*)(F.lds + 66048);
    LAS float* stage = (LAS float*)(F.lds + 66560) + wave * 256;
    LAS float* ps = (LAS float*)(F.lds + 75776) + wave * 2048;
    const int ngroups = nrows >> 4;
    const int g0 = (int)((unsigned)(gw * ngroups) / (unsigned)NGW), g1 = (int)((unsigned)((gw + 1) * ngroups) / (unsigned)NGW);
    const int n = lane & 15, kg = lane >> 4;
    for (int c = tid; c < 4096; c += 512) { const f32x4 v = *(const f32x4*)(a.in[I_RTW] + 4 * c); const int k = c >> 2, e4 = (c & 3) * 4;
#pragma unroll
        for (int i = 0; i < 4; ++i) { const unsigned hb = f2bf(v[i]); const float rem = v[i] - __builtin_bit_cast(float, hb << 16);
            *(LAS unsigned short*)(wh + (e4 + i) * MID_RS + 2 * k) = (unsigned short)hb; *(LAS unsigned short*)(wl + (e4 + i) * MID_RS + 2 * k) = (unsigned short)f2bf(rem); } }
    if (tid < 16) cnt[tid] = 0;
    __syncthreads();
    float rbias[16];
#pragma unroll
    for (int e = 0; e < 16; ++e) rbias[e] = a.in[I_RTB][e];
    int cur_bi = -1;
    for (int g = g0; g < g1; ++g) {
        const int row = 16 * g + n;
        u32x4 ring[8];
        const bf16* px = XALL + (size_t)row * D + 8 * kg;
#pragma unroll
        for (int c = 0; c < 8; ++c) ring[c] = *(const u32x4*)(px + 32 * c);
        const int bi = bidx_of_row(16 * g);
        if (bi != cur_bi) { cur_bi = bi;
            const float* nwp = a.in[I_NFFN] + layer * D; const float* shp = modv(wso, layer, bi, 3); const float* scp = modv(wso, layer, bi, 4);
#pragma unroll
            for (int i = 0; i < 4; ++i) { const int o = 4 * (lane + 64 * i); const f32x4 nwv = *(const f32x4*)(nwp + o), scv = *(const f32x4*)(scp + o), shv = *(const f32x4*)(shp + o);
                *(LAS f32x4*)(ps + o) = nwv * (scv + 1.f); *(LAS f32x4*)(ps + 1024 + o) = shv; } }
        float ss = 0.f;
#pragma unroll
        for (int c = 0; c < 32; ++c) { const u32x4 xv = ring[c & 7];
            ring[c & 7] = *(const u32x4*)(px + 32 * ((c + 8) & 31));
#pragma unroll
            for (int i = 0; i < 4; ++i) { const float v0 = bflo(xv[i]), v1 = bfhi(xv[i]); ss += v0 * v0 + v1 * v1; } }
        ss += shx(ss, 16, lane); ss += shx(ss, 32, lane);
        const float rs = rsqrtf(ss * (1.f / D) + EPS);
        f32x4 acc = (f32x4){0.f, 0.f, 0.f, 0.f};
        unsigned char* arow = ACT8 + (size_t)row * D + 8 * kg;
        const LAS unsigned char* whp = wh + n * MID_RS + 16 * kg; const LAS unsigned char* wlp = wl + n * MID_RS + 16 * kg;
        const LAS float* psp = ps + 8 * kg;
#pragma unroll
        for (int c = 0; c < 32; ++c) {
            const f32x4 P0 = *(const LAS f32x4*)(psp + 32 * c), P1 = *(const LAS f32x4*)(psp + 32 * c + 4), S0 = *(const LAS f32x4*)(psp + 1024 + 32 * c), S1 = *(const LAS f32x4*)(psp + 1024 + 32 * c + 4);
            const u32x4 xv = ring[c & 7];
            if (c + 8 < 32) ring[c & 7] = *(const u32x4*)(px + 32 * (c + 8));
            const f32x4 x0 = {bflo(xv[0]), bfhi(xv[0]), bflo(xv[1]), bfhi(xv[1])}, x1 = {bflo(xv[2]), bfhi(xv[2]), bflo(xv[3]), bfhi(xv[3])};
            const f32x4 f0 = (x0 * rs) * P0 + S0, f1 = (x1 * rs) * P1 + S1;
            { int t0 = __builtin_amdgcn_cvt_pk_fp8_f32(f0[0], f0[1], 0, false); t0 = __builtin_amdgcn_cvt_pk_fp8_f32(f0[2], f0[3], t0, true);
              int t1 = __builtin_amdgcn_cvt_pk_fp8_f32(f1[0], f1[1], 0, false); t1 = __builtin_amdgcn_cvt_pk_fp8_f32(f1[2], f1[3], t1, true);
              *(u32x2*)(arow + 32 * c) = (u32x2){(unsigned)t0, (unsigned)t1}; }
            u32x4 hb, lb;
            hb[0] = pk2(f0[0], f0[1]); hb[1] = pk2(f0[2], f0[3]); hb[2] = pk2(f1[0], f1[1]); hb[3] = pk2(f1[2], f1[3]);
            lb[0] = pk2(f0[0] - bflo(hb[0]), f0[1] - bfhi(hb[0])); lb[1] = pk2(f0[2] - bflo(hb[1]), f0[3] - bfhi(hb[1]));
            lb[2] = pk2(f1[0] - bflo(hb[2]), f1[1] - bfhi(hb[2])); lb[3] = pk2(f1[2] - bflo(hb[3]), f1[3] - bfhi(hb[3]));
            const bf16x8 bh = __builtin_bit_cast(bf16x8, hb), bl = __builtin_bit_cast(bf16x8, lb);
            const bf16x8 ah = *(const LAS bf16x8*)(whp + 64 * c), al = *(const LAS bf16x8*)(wlp + 64 * c);
            acc = __builtin_amdgcn_mfma_f32_16x16x32_bf16(ah, bh, acc, 0, 0, 0); acc = __builtin_amdgcn_mfma_f32_16x16x32_bf16(ah, bl, acc, 0, 0, 0); acc = __builtin_amdgcn_mfma_f32_16x16x32_bf16(al, bh, acc, 0, 0, 0);
            __builtin_amdgcn_sched_barrier(0);
        }
        *(LAS f32x4*)(stage + n * 16 + 4 * kg) = acc;
        {
            const bool act = lane < 16;
            const int rl = lane & 15;
            float sel[16], sco[16];
#pragma unroll
            for (int e4 = 0; e4 < 4; ++e4) { const f32x4 v = *(const LAS f32x4*)(stage + rl * 16 + 4 * e4);
#pragma unroll
                for (int i = 0; i < 4; ++i) { const int e = 4 * e4 + i; sco[e] = __builtin_amdgcn_rcpf(1.f + __expf(-v[i])); sel[e] = sco[e] + rbias[e]; } }
            int gbest = 0; float gbs = -1e30f;
#pragma unroll
            for (int gq = 0; gq < 4; ++gq) { float m1 = -1e30f, m2 = -1e30f;
#pragma unroll
                for (int l = 0; l < 4; ++l) { const float v = sel[4 * gq + l]; if (v > m1) { m2 = m1; m1 = v; } else if (v > m2) m2 = v; }
                const float gs = m1 + m2; if (gs > gbs) { gbs = gs; gbest = gq; } }
            float gsel[4], gsco[4];
#pragma unroll
            for (int l = 0; l < 4; ++l) { gsel[l] = sel[0 * 4 + l]; gsco[l] = sco[0 * 4 + l]; }
#pragma unroll
            for (int gq = 1; gq < 4; ++gq) if (gbest == gq) {
#pragma unroll
                for (int l = 0; l < 4; ++l) { gsel[l] = sel[gq * 4 + l]; gsco[l] = sco[gq * 4 + l]; } }
            int l0 = 0; float b0 = gsel[0];
#pragma unroll
            for (int l = 1; l < 4; ++l) if (gsel[l] > b0) { b0 = gsel[l]; l0 = l; }
            int l1 = -1; float b1 = -1e30f;
#pragma unroll
            for (int l = 0; l < 4; ++l) if (l != l0 && gsel[l] > b1) { b1 = gsel[l]; l1 = l; }
            float s0 = gsco[0], s1 = gsco[0];
#pragma unroll
            for (int l = 1; l < 4; ++l) { if (l0 == l) s0 = gsco[l]; if (l1 == l) s1 = gsco[l]; }
            const int e0 = gbest * 4 + l0, e1 = gbest * 4 + l1;
            const float inv = 1.f / (s0 + s1);
            if (act) {
                const int r0 = atomicAdd((int*)&cnt[e0], 1), r1 = atomicAdd((int*)&cnt[e1], 1);
                int* R = (int*)(wso + WS_ROUTE) + (size_t)(16 * g + lane) * 8;
                *(u32x4*)R = (u32x4){(unsigned)e0, (unsigned)e1, (unsigned)r0, (unsigned)r1}; *(f32x2*)(R + 4) = (f32x2){s0 * inv, s1 * inv};
            }
        }
    }
    __syncthreads();
    if (tid < 16) ((int*)(wso + WS_BLKCNT))[blockIdx.x * 16 + tid] = cnt[tid];
    __syncthreads();
}

__device__ __forceinline__ void p_perm(Frame& F, int nrows) {
    int tid = tid_of(F.wv); asm volatile("" : "+v"(tid)); const int lane = tid & 63, wave = __builtin_amdgcn_readfirstlane(tid >> 6); (void)lane; (void)wave;
    GAS unsigned char* wsg_ = (GAS unsigned char*)F.ws; asm volatile("" : "+s"(wsg_)); unsigned char* wso = (unsigned char*)wsg_;
    int vcu_o = F.vcu; asm volatile("" : "+s"(vcu_o));
    const int gw = vcu_o * 8 + wave, NGW = F.G * 8;
    LAS int* tab = (LAS int*)F.lds;
    LAS int* base = tab + 256 * 16;
    LAS int* part = base + 64;
    const int* BC = (const int*)(wso + WS_BLKCNT);
    const unsigned char* ACT = (const unsigned char*)(wso + WS_ACT); unsigned char* XP = (unsigned char*)(wso + WS_XP); int* DEST = (int*)(wso + WS_DEST);
    const int ngroups = nrows >> 4;
    const int r0w = 16 * (int)((unsigned)(gw * ngroups) / (unsigned)NGW), r1w = 16 * (int)((unsigned)((gw + 1) * ngroups) / (unsigned)NGW);
    const int nmine = r1w - r0w;
    constexpr int PERM_MAXR = 16;
    u32x4 rt = {0u, 0u, 0u, 0u};
    if (lane < nmine) rt = *(const u32x4*)((const int*)(wso + WS_ROUTE) + (size_t)(r0w + lane) * 8);
    u32x4 rowv[PERM_MAXR];
#pragma unroll
    for (int i = 0; i < PERM_MAXR; ++i) { const int row = min(r0w + i, r1w - 1); rowv[i] = *(const u32x4*)(ACT + (size_t)row * D + 16 * lane); }
    for (int idx = tid; idx < F.G * 16; idx += 512) tab[idx] = BC[idx];
    __syncthreads();
    {
        const int e = tid & 15, pt = tid >> 4; const int per = (F.G + 31) >> 5; const int b0 = pt * per, b1 = min(b0 + per, F.G);
        int t = 0, m = 0;
        for (int b = b0; b < b1; ++b) { const int v = tab[b * 16 + e]; m += (b < (int)blockIdx.x) ? v : 0; t += v; }
        part[(pt * 16 + e) * 2] = t; part[(pt * 16 + e) * 2 + 1] = m;
    }
    __syncthreads();
    if (tid < 16) {
        int t = 0, m = 0;
#pragma unroll 4
        for (int pt = 0; pt < 32; ++pt) { t += part[(pt * 16 + tid) * 2]; m += part[(pt * 16 + tid) * 2 + 1]; }
        const int padded = (t + 255) & ~255;
        int incl = padded;
#pragma unroll
        for (int o = 1; o < 16; o <<= 1) { const int up = __builtin_amdgcn_ds_bpermute(((lane - o) & 63) << 2, incl); if (tid >= o) incl += up; }
        const int ps = incl - padded;
        base[tid] = ps + m;
        if (blockIdx.x == 0) { ((int*)(wso + WS_MOETAB))[tid] = ps >> 8; if (tid == 15) ((int*)(wso + WS_MOETAB))[16] = incl >> 8; }
    }
    __syncthreads();
    const int e0 = (int)rt.x, e1 = (int)rt.y;
    const int d0 = base[e0 & 15] + (int)rt.z, d1 = base[e1 & 15] + (int)rt.w;
    if (lane < nmine) *(u32x2*)(DEST + (size_t)(r0w + lane) * 2) = (u32x2){(unsigned)d0, (unsigned)d1};
#pragma unroll
    for (int i = 0; i < PERM_MAXR; ++i) if (i < nmine) {
        const int q0 = __builtin_amdgcn_readlane(d0, i), q1 = __builtin_amdgcn_readlane(d1, i);
        *(u32x4*)(XP + (size_t)q0 * D + 16 * lane) = rowv[i]; *(u32x4*)(XP + (size_t)q1 * D + 16 * lane) = rowv[i];
    }
}

using pg8::Unit;
__device__ __forceinline__ unsigned cvt_pk_bf16(float lo, float hi) { unsigned r; asm volatile("v_cvt_pk_bf16_f32 %0, %1, %2" : "=v"(r) : "v"(lo), "v"(hi)); return r; }
__device__ __forceinline__ u32x4 pack8(const f32x4& v0, const f32x4& v1) { u32x4 o; o.x = cvt_pk_bf16(v0[0], v0[1]); o.y = cvt_pk_bf16(v0[2], v0[3]); o.z = cvt_pk_bf16(v1[0], v1[1]); o.w = cvt_pk_bf16(v1[2], v1[3]); return o; }

struct EpiResid {
    static constexpr bool PERM = false;
    bf16* X; const unsigned char* ws; int layer, which; float scale = 1.f;
    __device__ __forceinline__ void operator()(const f32x4 (&acc)[2][2][4][2], const Unit& u, int wr, int wc, int fr, int fq) const {
        const int row0 = u.pm * 256 + wr * 64 + fr, col0 = u.pn * 256 + wc * 32 + 4 * fq;
        const float* g = modv(ws, layer, bidx_of_row(u.pm * 256), which);
        f32x4 gv[2][2];
#pragma unroll
        for (int bj = 0; bj < 2; ++bj)
#pragma unroll
            for (int n = 0; n < 2; ++n) gv[bj][n] = *(const f32x4*)(g + col0 + bj * 128 + n * 16) * scale;
#pragma unroll
        for (int ai = 0; ai < 2; ++ai)
#pragma unroll
            for (int m = 0; m < 4; ++m) { bf16* rowp = X + (size_t)(row0 + ai * 128 + m * 16) * D + col0;
                u32x2 xv[2][2];
#pragma unroll
                for (int bj = 0; bj < 2; ++bj)
#pragma unroll
                    for (int n = 0; n < 2; ++n) xv[bj][n] = *(const u32x2*)(rowp + bj * 128 + n * 16);
#pragma unroll
                for (int bj = 0; bj < 2; ++bj)
#pragma unroll
                    for (int n = 0; n < 2; ++n) { const f32x4 y = gv[bj][n] * acc[ai][bj][m][n]; const u32x2 x = xv[bj][n]; u32x2 o;
                        o.x = cvt_pk_bf16(bflo(x.x) + y[0], bfhi(x.x) + y[1]); o.y = cvt_pk_bf16(bflo(x.y) + y[2], bfhi(x.y) + y[3]); *(u32x2*)(rowp + bj * 128 + n * 16) = o; } }
    }
};
struct EpiBf16 {
    static constexpr bool PERM = true;
    bf16* O; int ldc; float scale;
    __device__ __forceinline__ void operator()(const f32x4 (&acc)[2][2][4][2], const Unit& u, int wr, int wc, int fr, int fq) const {
        const int row0 = u.aux + u.pm * 256 + wr * 64 + fr, col0 = u.pn * 256 + wc * 32 + 8 * fq;
#pragma unroll
        for (int ai = 0; ai < 2; ++ai)
#pragma unroll
            for (int m = 0; m < 4; ++m) { bf16* rowp = O + (size_t)(row0 + ai * 128 + m * 16) * ldc + col0;
#pragma unroll
                for (int bj = 0; bj < 2; ++bj) *(u32x4*)(rowp + bj * 128) = pack8(acc[ai][bj][m][0] * scale, acc[ai][bj][m][1] * scale); }
    }
};
struct EpiQKV {
    static constexpr bool PERM = true;
    bf16* Q; bf16* K; bf16* V; float qscale, kvscale;
    __device__ __forceinline__ void operator()(const f32x4 (&acc)[2][2][4][2], const Unit& u, int wr, int wc, int fr, int fq) const {
        const int which = u.pn >> 2; bf16* base = Q + (size_t)which * ((WS_NK - WS_NQ) / 2); const float sc = which == 0 ? qscale : kvscale;
        const int row0 = u.pm * 256 + wr * 64 + fr, col0 = (u.pn & 3) * 256 + wc * 32 + 8 * fq;
#pragma unroll
        for (int ai = 0; ai < 2; ++ai)
#pragma unroll
            for (int m = 0; m < 4; ++m) { bf16* rowp = base + (size_t)(row0 + ai * 128 + m * 16) * D + col0;
#pragma unroll
                for (int bj = 0; bj < 2; ++bj) *(u32x4*)(rowp + bj * 128) = pack8(acc[ai][bj][m][0] * sc, acc[ai][bj][m][1] * sc); }
    }
};
struct EpiRetIn {
    static constexpr bool PERM = true;
    bf16* Q; bf16* K; bf16* V; bf16* Gt; const LAS unsigned* rope;
    __device__ __forceinline__ void operator()(const f32x4 (&acc)[2][2][4][2], const Unit& u, int wr, int wc, int fr, int fq) const {
        const int row0 = u.pm * 256 + wr * 64 + fr;
        if (u.pn < 8) {
            const int head = u.pn & 3; const bool isK = u.pn >= 4; bf16* base = isK ? K : Q; const float sc = (isK ? 0.0625f : 1.f) * (FP8_INPROJ ? pg8::FP8_WSCALE : 1.f);
            const int jt = wc * 32 + 8 * fq;
            const int nat_a = jt < 64 ? jt : 64 + jt;
            const int f0 = jt & 63;
#pragma unroll
            for (int ai = 0; ai < 2; ++ai)
#pragma unroll
                for (int m = 0; m < 4; ++m) {
                    const int row = row0 + ai * 128 + m * 16;
                    f32x4 a0 = acc[ai][0][m][0], a1 = acc[ai][0][m][1], b0 = acc[ai][1][m][0], b1 = acc[ai][1][m][1];
                    if (u.pm * 256 < NLAT) {
                        const int t = row & 4095; const int pos = jt < 64 ? (t >> 6) : (t & 63);
                        const LAS unsigned* cs = rope + pos * 64 + f0;
#pragma unroll
                        for (int e = 0; e < 4; ++e) { typedef _Float16 h2 __attribute__((ext_vector_type(2))); const h2 p0 = __builtin_bit_cast(h2, cs[e]), p1 = __builtin_bit_cast(h2, cs[4 + e]);
                            const f32x2 c0 = (f32x2){(float)p0[0], (float)p0[1]}, c1 = (f32x2){(float)p1[0], (float)p1[1]};
                            const float x0 = a0[e], y0 = b0[e], x1 = a1[e], y1 = b1[e];
                            a0[e] = x0 * c0.x - y0 * c0.y; b0[e] = x0 * c0.y + y0 * c0.x; a1[e] = x1 * c1.x - y1 * c1.y; b1[e] = x1 * c1.y + y1 * c1.x; }
                    }
                    bf16* rowp = base + (size_t)row * D + head * 256 + nat_a;
                    *(u32x4*)(rowp) = pack8(a0 * sc, a1 * sc); *(u32x4*)(rowp + 64) = pack8(b0 * sc, b1 * sc);
                }
        } else {
            bf16* base = u.pn < 16 ? V : Gt; const int col0 = ((u.pn - 8) & 7) * 256 + wc * 32 + 8 * fq;
#pragma unroll
            for (int ai = 0; ai < 2; ++ai)
#pragma unroll
                for (int m = 0; m < 4; ++m) { bf16* rowp = base + (size_t)(row0 + ai * 128 + m * 16) * 2048 + col0;
#pragma unroll
                    for (int bj = 0; bj < 2; ++bj) { const float ws_ = FP8_INPROJ ? pg8::FP8_WSCALE : 1.f; const f32x4 v0 = acc[ai][bj][m][0] * ws_, v1 = acc[ai][bj][m][1] * ws_;
                        if (FP8_RETSTORE && u.pn >= 16) {
                            int t0 = __builtin_amdgcn_cvt_pk_fp8_f32(v0[0], v0[1], 0, false); t0 = __builtin_amdgcn_cvt_pk_fp8_f32(v0[2], v0[3], t0, true);
                            int t1 = __builtin_amdgcn_cvt_pk_fp8_f32(v1[0], v1[1], 0, false); t1 = __builtin_amdgcn_cvt_pk_fp8_f32(v1[2], v1[3], t1, true);
                            *(u32x2*)((unsigned char*)Gt + (size_t)(row0 + ai * 128 + m * 16) * 2048 + col0 + bj * 128) = (u32x2){(unsigned)t0, (unsigned)t1};
                        } else *(u32x4*)(rowp + bj * 128) = pack8(v0, v1); } }
        }
    }
};
struct EpiF1 {
    static constexpr bool PERM = true;
    bf16* G2; bf16* G2c;
    __device__ __forceinline__ void operator()(const f32x4 (&acc)[2][2][4][2], const Unit& u, int wr, int wc, int fr, int fq) const {
        const int g = u.aux, s = u.pm; const int tok0 = u.pn * 256;
        char* base; unsigned ldrB; int lcol;
        if (tok0 < NLAT) { const int b = tok0 >> 12, par = (tok0 >> 11) & 1; base = (char*)(G2 + (size_t)(b * 1024 + g * 256) * 8192 + par * 4096 + s * 2048); ldrB = 16384u; lcol = tok0 & 2047; }
        else { const int b = (tok0 - NLAT) >> 8; base = (char*)(G2c + (size_t)(b * 1024 + g * 256) * 512 + s * 256); ldrB = 1024u; lcol = 0; }
        const unsigned off0 = (unsigned)(wr * 64 + fr) * ldrB + (unsigned)(lcol + wc * 32 + 8 * fq) * 2u;
#pragma unroll
        for (int ai = 0; ai < 2; ++ai)
#pragma unroll
            for (int m = 0; m < 4; ++m) { const unsigned off = off0 + (unsigned)(ai * 128 + m * 16) * ldrB;
#pragma unroll
                for (int bj = 0; bj < 2; ++bj) *(u32x4*)(base + off + bj * 256) = pack8(acc[ai][bj][m][0], acc[ai][bj][m][1]); }
    }
};
struct EpiF1n {
    static constexpr bool PERM = false;
    __host__ __device__ static constexpr int brow(int R) { return ((R >> 4) & 1) * 512 + (R >> 5) * 16 + (R & 15); }
    bf16* G2;
    static constexpr int EB = FP8_F2 ? 1 : 2;
    __device__ __forceinline__ static void st8(char* p, const f32x4& uq, const f32x4& vq) {
        if (FP8_F2) { int t0 = __builtin_amdgcn_cvt_pk_fp8_f32(uq[0], uq[1], 0, false); t0 = __builtin_amdgcn_cvt_pk_fp8_f32(uq[2], uq[3], t0, true);
            int t1 = __builtin_amdgcn_cvt_pk_fp8_f32(vq[0], vq[1], 0, false); t1 = __builtin_amdgcn_cvt_pk_fp8_f32(vq[2], vq[3], t1, true); *(u32x2*)p = (u32x2){(unsigned)t0, (unsigned)t1}; }
        else { u32x4 o; o.x = cvt_pk_bf16(uq[0], uq[1]); o.y = cvt_pk_bf16(uq[2], uq[3]); o.z = cvt_pk_bf16(vq[0], vq[1]); o.w = cvt_pk_bf16(vq[2], vq[3]); *(u32x4*)p = o; } }
    __device__ __forceinline__ void operator()(const f32x4 (&acc)[2][2][4][2], const Unit& u, int wr, int wc, int fr, int fq) const {
        const int g = u.aux >> 1, grp = u.aux & 1, b = u.pn >> 3, lt = u.pn & 7;
        char* base = (char*)G2 + ((size_t)(b * 1024 + g * 256 + u.pm * 128) * 8192 + lt * 128) * EB;
        const unsigned off0 = ((unsigned)(wr * 64 + fr) * 8192u + (unsigned)(wc * 32 + 8 * fq)) * (unsigned)EB;
        constexpr float cs = 0.70710678118654752f;
#define F1_ST(R_, U_, V_) st8(base + off + (R_) * 1024 * EB, (U_), (V_))
#pragma unroll
        for (int m = 0; m < 4; ++m) { const unsigned off = off0 + (unsigned)(m * 16) * 8192u * (unsigned)EB;
            const f32x4 C0 = acc[0][0][m][0], C1 = acc[0][0][m][1], C2 = acc[0][1][m][0], C3 = acc[0][1][m][1];
            const f32x4 S0 = acc[1][0][m][0], S1 = acc[1][0][m][1], S2 = acc[1][1][m][0], S3 = acc[1][1][m][1];
            if (grp == 0) {
                F1_ST(0, C0 + C1, S0 + S1); F1_ST(4, C0 - C1, S0 - S1);
                F1_ST(2, C2 - S3, S2 + C3); F1_ST(6, C2 + S3, S2 - C3);
            } else {
                const f32x4 tc = (C1 + C3) * cs, ts = (S1 + S3) * cs, dc = (C3 - C1) * cs, ds = (S3 - S1) * cs;
                const f32x4 Ec = C0 + tc, Es = S0 + ts, Fc = C2 + dc, Fs = S2 + ds, Gc = C0 - tc, Gs = S0 - ts, Hc = C2 - dc, Hs = S2 - ds;
                F1_ST(1, Ec + Fs, Es - Fc); F1_ST(7, Ec - Fs, Es + Fc);
                F1_ST(5, Gc + Hs, Gs - Hc); F1_ST(3, Gc - Hs, Gs + Hc);
            }
        }
#undef F1_ST
    }
};
struct EpiMoe1 {
    static constexpr bool PERM = false;
    unsigned char* H;
    __device__ __forceinline__ void operator()(const f32x4 (&acc)[2][2][4][2], const Unit& u, int wr, int wc, int fr, int fq) const {
        const int row0 = u.pm * 256 + wr * 64 + fr, col0 = u.pn * 128 + wc * 32 + 4 * fq;
#pragma unroll
        for (int ai = 0; ai < 2; ++ai)
#pragma unroll
            for (int m = 0; m < 4; ++m) {
#pragma unroll
                for (int n = 0; n < 2; ++n) { f32x4 h;
#pragma unroll
                    for (int e = 0; e < 4; ++e) h[e] = silu_f(acc[ai][0][m][n][e] * pg8::FP8_WSCALE) * (acc[ai][1][m][n][e] * pg8::FP8_WSCALE);
                    int t = __builtin_amdgcn_cvt_pk_fp8_f32(h[0], h[1], 0, false); t = __builtin_amdgcn_cvt_pk_fp8_f32(h[2], h[3], t, true);
                    *(int*)(H + (size_t)(row0 + ai * 128 + m * 16) * D + col0 + 16 * n) = t; } }
    }
};
struct EpiFp8N {
    static constexpr bool PERM = false;
    static constexpr bool LDS_STORE = true;
    static constexpr int RS = 272;
    unsigned char* O;
    __device__ __forceinline__ void lds_store(const f32x4 (&acc)[2][2][4][2], const Unit& u, int wr, int wc, int fr, int fq, LAS unsigned char* buf, int tid) const {
#pragma unroll
        for (int p = 0; p < 4; ++p) {
            if (wr == (p & 1)) {
#pragma unroll
                for (int m = 0; m < 4; ++m)
#pragma unroll
                    for (int bj = 0; bj < 2; ++bj)
#pragma unroll
                        for (int n = 0; n < 2; ++n) { const f32x4 v = acc[p >> 1][bj][m][n]; int t = __builtin_amdgcn_cvt_pk_fp8_f32(v[0], v[1], 0, false); t = __builtin_amdgcn_cvt_pk_fp8_f32(v[2], v[3], t, true);
                            *(LAS int*)(buf + (m * 16 + fr) * RS + bj * 128 + wc * 32 + n * 16 + 4 * fq) = t; }
            }
            asm volatile("s_waitcnt lgkmcnt(0)" ::: "memory"); __builtin_amdgcn_s_barrier(); asm volatile("" ::: "memory");
#pragma unroll
            for (int k = 0; k < 2; ++k) { const int row = (tid >> 4) + 32 * k, ch = tid & 15;
                const u32x4 v = *(const LAS u32x4*)(buf + row * RS + ch * 16);
                *(u32x4*)(O + (size_t)(u.pm * 256 + 64 * p + row) * D + u.pn * 256 + ch * 16) = v; }
            asm volatile("s_waitcnt lgkmcnt(0)" ::: "memory"); __builtin_amdgcn_s_barrier(); asm volatile("" ::: "memory");
        }
    }
    __device__ __forceinline__ void operator()(const f32x4 (&acc)[2][2][4][2], const Unit& u, int wr, int wc, int fr, int fq) const {
        const int row0 = u.pm * 256 + wr * 64 + fr, col0 = u.pn * 256 + wc * 32 + 4 * fq;
#pragma unroll
        for (int ai = 0; ai < 2; ++ai)
#pragma unroll
            for (int m = 0; m < 4; ++m) { unsigned char* rowp = O + (size_t)(row0 + ai * 128 + m * 16) * D + col0;
#pragma unroll
                for (int bj = 0; bj < 2; ++bj)
#pragma unroll
                    for (int n = 0; n < 2; ++n) { const f32x4 v = acc[ai][bj][m][n]; int t = __builtin_amdgcn_cvt_pk_fp8_f32(v[0], v[1], 0, false); t = __builtin_amdgcn_cvt_pk_fp8_f32(v[2], v[3], t, true); *(int*)(rowp + bj * 128 + n * 16) = t; } }
    }
};
struct EpiBf16N {
    static constexpr bool PERM = false;
    bf16* O; int ldc; float scale;
    __device__ __forceinline__ void operator()(const f32x4 (&acc)[2][2][4][2], const Unit& u, int wr, int wc, int fr, int fq) const {
        const int row0 = u.aux + u.pm * 256 + wr * 64 + fr, col0 = u.pn * 256 + wc * 32 + 4 * fq;
#pragma unroll
        for (int ai = 0; ai < 2; ++ai)
#pragma unroll
            for (int m = 0; m < 4; ++m) { bf16* rowp = O + (size_t)(row0 + ai * 128 + m * 16) * ldc + col0;
#pragma unroll
                for (int bj = 0; bj < 2; ++bj)
#pragma unroll
                    for (int n = 0; n < 2; ++n) { const f32x4 v = acc[ai][bj][m][n] * scale; u32x2 o; o.x = cvt_pk_bf16(v[0], v[1]); o.y = cvt_pk_bf16(v[2], v[3]); *(u32x2*)(rowp + bj * 128 + n * 16) = o; } }
    }
};

struct F1nSched {
    static constexpr bool HOOKS = false;
    const char* A1N; const char* ACT; int G, c;
    __device__ bool next(int i, Unit& u) const { const int L = i * G + c; if (L >= 512) return false;
        const int b = L >> 7, g = (L >> 5) & 3, chh = (L >> 4) & 1, lt = (L >> 1) & 7, grp = L & 1; u.pm = chh; u.pn = b * 8 + lt; u.aux = 2 * g + grp; u.nt = 4;
        u.A = A1N + (size_t)chh * 256 * 512; u.B0 = ACT + (size_t)(b * 4096 + grp * 2048 + lt * 64) * 2048 + g * 512; return true; }
};
struct F1Sched {
    static constexpr bool HOOKS = false;
    const char* A1; const char* ACT; int G, c;
    __device__ bool next(int i, Unit& u) const { const int L = i * G + c; if (L >= 4 * 2 * 4) return false;
        const int g = L >> 3, rem = L & 7; u.pm = rem & 1; u.pn = 64 + (rem >> 1); u.aux = g; u.nt = 4;
        u.A = A1 + (size_t)u.pm * 256 * 512; u.B0 = ACT + (size_t)u.pn * 256 * 2048 + g * 512; return true; }
};
struct F2Sched {
    static constexpr bool HOOKS = false;
    const char* AL; const char* G2; int G, c;
    __device__ bool next(int i, Unit& u) const { const int L = i * G + c; if (L >= 256) return false;
        constexpr int EB = FP8_F2 ? 1 : 2;
        const int b = L >> 6, rem = L & 63, r = rem >> 3; u.pm = (rem >> 2) & 1; u.pn = rem & 3; u.aux = b * 4096 + r; u.nt = FP8_F2 ? 8 : 16;
        u.A = AL + ((size_t)r * 512 * 1024 + (size_t)u.pm * 256 * 1024) * EB; u.B0 = G2 + (((size_t)b * 1024 + u.pn * 256) * 8192 + (size_t)r * 1024) * EB; return true; }
};
struct EpiF2 {
    static constexpr bool PERM = true;
    bf16* O;
    __device__ __forceinline__ void operator()(const f32x4 (&acc_)[2][2][4][2], const Unit& u, int wr, int wc, int fr, int fq) const {
        f32x4 acc[2][2][4][2];
#pragma unroll
        for (int i0 = 0; i0 < 2; ++i0)
#pragma unroll
            for (int i1 = 0; i1 < 2; ++i1)
#pragma unroll
                for (int i2 = 0; i2 < 4; ++i2)
#pragma unroll
                    for (int i3 = 0; i3 < 2; ++i3) acc[i0][i1][i2][i3] = acc_[i0][i1][i2][i3] * (FP8_F2 ? (1.f / 256.f) : 1.f);
        const int r = u.aux & 7, rb = u.aux & ~7; const int r0 = u.pm * 256 + wr * 64 + fr, col0 = u.pn * 256 + wc * 32 + 8 * fq;
#pragma unroll
        for (int ai = 0; ai < 2; ++ai)
#pragma unroll
            for (int m = 0; m < 4; ++m) { bf16* rowp = O + (size_t)(rb + 8 * (r0 + ai * 128 + m * 16) + r) * D + col0;
#pragma unroll
                for (int bj = 0; bj < 2; ++bj) {
                    if (FP8_OUT2) { const f32x4 v0 = acc[ai][bj][m][0], v1 = acc[ai][bj][m][1];
                        int t0 = __builtin_amdgcn_cvt_pk_fp8_f32(v0[0], v0[1], 0, false); t0 = __builtin_amdgcn_cvt_pk_fp8_f32(v0[2], v0[3], t0, true);
                        int t1 = __builtin_amdgcn_cvt_pk_fp8_f32(v1[0], v1[1], 0, false); t1 = __builtin_amdgcn_cvt_pk_fp8_f32(v1[2], v1[3], t1, true);
                        *(u32x2*)((unsigned char*)O + (size_t)(rb + 8 * (r0 + ai * 128 + m * 16) + r) * D + col0 + bj * 128) = (u32x2){(unsigned)t0, (unsigned)t1}; }
                    else *(u32x4*)(rowp + bj * 128) = pack8(acc[ai][bj][m][0], acc[ai][bj][m][1]); } }
    }
};
struct F2cSched {
    const char* ALC; const char* G2C; int G, c;
    __device__ bool next(int i, Unit& u) const { const int L = i * G + c; if (L >= 16) return false;
        const int b = L >> 2; u.pm = 0; u.pn = L & 3; u.aux = NLAT + b * 256; u.nt = 8;
        u.A = ALC; u.B0 = G2C + ((size_t)b * 1024 + u.pn * 256) * 1024; return true; }
};
struct MoeSched {
    const volatile LAS int* tstart; const char* A; const char* W0; int nct, cstep, G, c;
    __device__ bool next(int i, Unit& u) const { const int L = i * G + c; const int rt = L / nct, ct = L % nct; if (rt >= tstart[16]) return false;
        int e = 0;
#pragma unroll
        for (int k = 1; k < 16; ++k) e += (rt >= tstart[k]) ? 1 : 0;
        e = __builtin_amdgcn_readfirstlane(e);
        u.pm = rt; u.pn = ct; u.aux = 0; u.nt = 8; u.A = A + (size_t)rt * 256 * 1024;
        u.B0 = W0 + (size_t)e * 1048576 + (size_t)ct * cstep; return true; }
};

__device__ __forceinline__ f32x4 mfma16(const bf16x8& a, const bf16x8& b, const f32x4& c) { return __builtin_amdgcn_mfma_f32_16x16x32_bf16(a, b, c, 0, 0, 0); }
__device__ __forceinline__ s16x4 lds_tr(const LAS unsigned char* p) { return __builtin_amdgcn_ds_read_tr16_b64_v4i16((s16x4 LAS*)p); }
__device__ __forceinline__ bf16x8 cat8(const s16x4& a, const s16x4& b) { return (bf16x8){a[0], a[1], a[2], a[3], b[0], b[1], b[2], b[3]}; }
__device__ __forceinline__ bf16x8 pack_acc8(const f32x4& a, const f32x4& b) { const u32x4 u = pack8(a, b); return __builtin_bit_cast(bf16x8, u); }
__device__ __forceinline__ float logsig(float x) { const float e = __expf(-x);
    return -e * (1.f + e * (-0.5f + e * (0.333333343f + e * (-0.25f + e * (0.2f + e * (-0.166666672f + e * (0.142857149f + e * -0.125f))))))); }

constexpr int SG_RS = 144;
template <bool BF8>
__device__ __forceinline__ void small_gemm_ctx(Frame& F, const bf16* A, int lda, const bf16* Bt, int ldb, int K, bf16* X, const float* gate) {
    int tid = tid_of(F.wv); asm volatile("" : "+v"(tid)); const int lane = tid & 63, wave = __builtin_amdgcn_readfirstlane(tid >> 6);
    LAS unsigned char* lds = F.lds;
    for (int t = F.vcu; t < 256; t += F.G) {
        const int tm = t >> 4, tn = t & 15;
        const int pr = tid >> 3, pc = tid & 7;
        const bf16* ag = A + (size_t)(NLAT + 64 * tm + pr) * lda + pc * 8;
        const bf16* bg = Bt + (size_t)(64 * tn + pr) * ldb + pc * 8;
        const unsigned char* bg8 = (const unsigned char*)Bt + (size_t)(64 * tn + pr) * ldb + pc * 8;
        auto ldb_piece = [&](int kt) -> u32x4 {
            if constexpr (BF8) { const u32x2 w = *(const u32x2*)(bg8 + kt * 64); u32x4 o;
                const f32x2 a0 = __builtin_amdgcn_cvt_pk_f32_fp8((int)w.x, false), a1 = __builtin_amdgcn_cvt_pk_f32_fp8((int)w.x, true), a2 = __builtin_amdgcn_cvt_pk_f32_fp8((int)w.y, false), a3 = __builtin_amdgcn_cvt_pk_f32_fp8((int)w.y, true);
                o.x = cvt_pk_bf16(a0.x, a0.y); o.y = cvt_pk_bf16(a1.x, a1.y); o.z = cvt_pk_bf16(a2.x, a2.y); o.w = cvt_pk_bf16(a3.x, a3.y); return o; }
            else return *(const u32x4*)(bg + kt * 64); };
        const int wm = wave >> 1, wn = wave & 1, l15 = lane & 15, quad = lane >> 4;
        f32x4 acc[2] = {(f32x4){0.f, 0.f, 0.f, 0.f}, (f32x4){0.f, 0.f, 0.f, 0.f}};
        const int nk = K / 64;
        u32x4 ra[8], rb[8];
#pragma unroll
        for (int i = 0; i < 8; ++i) { ra[i] = *(const u32x4*)(ag + i * 64); rb[i] = ldb_piece(i); }
        __syncthreads();
        for (int kt0 = 0; kt0 < nk; kt0 += 8) {
#pragma unroll
            for (int i = 0; i < 8; ++i) {
                const int kt = kt0 + i;
                LAS unsigned char* sa = lds + (i & 1) * (2 * 64 * SG_RS); LAS unsigned char* sb = sa + 64 * SG_RS;
                *(LAS u32x4*)(sa + pr * SG_RS + pc * 16) = ra[i]; *(LAS u32x4*)(sb + pr * SG_RS + pc * 16) = rb[i];
                if (kt + 8 < nk) { ra[i] = *(const u32x4*)(ag + (kt + 8) * 64); rb[i] = ldb_piece(kt + 8); }
                __syncthreads();
#pragma unroll
                for (int ks = 0; ks < 2; ++ks) {
                    const bf16x8 af = *(const LAS bf16x8*)(sa + (16 * wm + l15) * SG_RS + (32 * ks + 8 * quad) * 2);
#pragma unroll
                    for (int n = 0; n < 2; ++n) { const bf16x8 bf = *(const LAS bf16x8*)(sb + (32 * wn + 16 * n + l15) * SG_RS + (32 * ks + 8 * quad) * 2);
                        acc[n] = mfma16(bf, af, acc[n]); }
                }
            }
        }
        bf16* xr = X + (size_t)(NLAT + 64 * tm + 16 * wm + l15) * D + 64 * tn + 32 * wn + 4 * quad;
        const float* gp = gate + 64 * tn + 32 * wn + 4 * quad;
#pragma unroll
        for (int n = 0; n < 2; ++n) { const f32x4 gv = *(const f32x4*)(gp + 16 * n) * (BF8 ? pg8::FP8_WSCALE : 1.f); const u32x2 xv = *(const u32x2*)(xr + 16 * n); const f32x4 y = gv * acc[n]; u32x2 o;
            o.x = cvt_pk_bf16(bflo(xv.x) + y[0], bfhi(xv.x) + y[1]); o.y = cvt_pk_bf16(bflo(xv.y) + y[2], bfhi(xv.y) + y[3]); *(u32x2*)(xr + 16 * n) = o; }
    }
    __syncthreads();
}

constexpr int SC_QS = 528, SC_KS = 576, SC_VS = 144, SC_QT = 0, SC_KT = 128 * 528, SC_VT = SC_KT + 128 * 576;
static_assert(SC_VT + 128 * SC_VS <= MISC_OFF, "scan LDS map");
__device__ __forceinline__ int scan_rowbase(int dir, int b, int n) {
    if (dir == 0) return (n < 2) ? NLAT + b * 256 + n * 128 : b * 4096 + (n - 2) * 128;
    return (n < 2) ? NLAT + b * 256 + (1 - n) * 128 : b * 4096 + (33 - n) * 128;
}
__device__ __forceinline__ void p_ret_scan(Frame& F, const Args& a, int j) {
    int tid = tid_of(F.wv); asm volatile("" : "+v"(tid)); const int lane = tid & 63, wave = __builtin_amdgcn_readfirstlane(tid >> 6);
    GAS unsigned char* wsg_ = (GAS unsigned char*)F.ws; asm volatile("" : "+s"(wsg_)); unsigned char* wso = (unsigned char*)wsg_;
    const bf16* Q = (const bf16*)(wso + WS_RQ); const bf16* K = (const bf16*)(wso + WS_RK); const bf16* V = (const bf16*)(wso + WS_RV);
    LAS unsigned char* lds = F.lds;
    for (int u = F.vcu; u < 256; u += F.G) {
        const int dir = u & 1, slice = (u >> 1) & 7, bh = u >> 4, b = bh >> 2, h = bh & 3;
        __syncthreads();
        if (wave >= 4) {
            const int lt = tid - 256;
            const int qr = lt >> 5, qc = lt & 31, vr = lt >> 3, vc = lt & 7; const bool kswz = (qr & 4) != 0;
            const bf16* Qg = Q + (size_t)qr * 1024 + h * 256 + qc * 8;
            const bf16* Kg = K + (size_t)qr * 1024 + h * 256 + qc * 8;
            const bf16* Vg = V + (size_t)vr * 2048 + h * 512 + slice * 64 + vc * 8;
            LAS unsigned char* qd = lds + SC_QT + qr * SC_QS + qc * 16;
            LAS unsigned char* kd = lds + SC_KT + qr * SC_KS + qc * 16;
            LAS unsigned char* vd = lds + SC_VT + vr * SC_VS + vc * 16;
            u32x4 rq[16], rk[16], rv[4];
            { const size_t rb = (size_t)scan_rowbase(dir, b, 0), rb1 = (size_t)scan_rowbase(dir, b, 1);
#pragma unroll
              for (int i = 0; i < 16; ++i) { rq[i] = *(const u32x4*)(Qg + (rb + 8 * i) * 1024); rk[i] = *(const u32x4*)(Kg + (rb + 8 * i) * 1024); }
#pragma unroll
              for (int i = 0; i < 4; ++i) rv[i] = *(const u32x4*)(Vg + (rb + 32 * i) * 2048);
#pragma unroll
              for (int i = 0; i < 16; ++i) *(LAS u32x4*)(qd + i * 8 * SC_QS) = rq[i];
#pragma unroll
              for (int i = 0; i < 16; ++i) rq[i] = *(const u32x4*)(Qg + (rb1 + 8 * i) * 1024); }
            __syncthreads();
            for (int n = 0; n < 34; ++n) {
#pragma unroll
                for (int i = 0; i < 16; ++i) *(LAS u32x4*)(kd + i * 8 * SC_KS) = kswz ? (u32x4){rk[i].z, rk[i].w, rk[i].x, rk[i].y} : rk[i];
#pragma unroll
                for (int i = 0; i < 4; ++i) *(LAS u32x4*)(vd + i * 32 * SC_VS) = rv[i];
                { const size_t rbn = (size_t)scan_rowbase(dir, b, n < 33 ? n + 1 : n);
#pragma unroll
                  for (int i = 0; i < 16; ++i) rk[i] = *(const u32x4*)(Kg + (rbn + 8 * i) * 1024);
#pragma unroll
                  for (int i = 0; i < 4; ++i) rv[i] = *(const u32x4*)(Vg + (rbn + 32 * i) * 2048); }
                __syncthreads();
#pragma unroll
                for (int i = 0; i < 16; ++i) *(LAS u32x4*)(qd + i * 8 * SC_QS) = rq[i];
                { const size_t rbn2 = (size_t)scan_rowbase(dir, b, n < 32 ? n + 2 : n);
#pragma unroll
                  for (int i = 0; i < 16; ++i) rq[i] = *(const u32x4*)(Qg + (rbn2 + 8 * i) * 1024); }
                __syncthreads();
            }
        } else {
            const int w = wave, l15 = lane & 15, quad = lane >> 4, tq = l15 >> 2, tp = l15 & 3;
            bf16* O = (bf16*)(wso + (dir ? WS_ROB : WS_ROF));
            const float lg = logsig(a.in[I_RDEC][(j * 2 + dir) * 4 + h]);
            const float lg2 = lg * 1.44269504f;
            const float cdec = exp2f(128.f * lg2);
            f32x4 S[16];
#pragma unroll
            for (int m = 0; m < 16; ++m) S[m] = (f32x4){0.f, 0.f, 0.f, 0.f};
            __syncthreads();
            for (int n = 0; n < 34; ++n) {
                const size_t rb = (size_t)scan_rowbase(dir, b, n);
                int lane_s = lane; asm volatile("" : "+v"(lane_s)); const int l15s = lane_s & 15, quads = lane_s >> 4;
                {
                    bf16x8 Sf[8];
#pragma unroll
                    for (int s = 0; s < 8; ++s) Sf[s] = pack_acc8(S[2 * s], S[2 * s + 1]);
                    bf16x8 qf[3][8];
                    const LAS unsigned char* qbase = lds + SC_QT + l15 * SC_QS + quad * 16;
#pragma unroll
                    for (int s = 0; s < 8; ++s) { qf[0][s] = *(const LAS bf16x8*)(qbase + s * 64); qf[1][s] = *(const LAS bf16x8*)(qbase + 16 * SC_QS + s * 64); }
#pragma unroll
                    for (int tt = 0; tt < 8; ++tt) {
                        if (tt + 2 < 8) {
#pragma unroll
                            for (int s = 0; s < 8; ++s) qf[(tt + 2) % 3][s] = *(const LAS bf16x8*)(qbase + (16 * (tt + 2)) * SC_QS + s * 64);
                        }
                        __builtin_amdgcn_sched_barrier(0);
                        f32x4 acc0 = (f32x4){0.f, 0.f, 0.f, 0.f}, acc1 = acc0;
#pragma unroll
                        for (int s = 0; s < 8; s += 2) { acc0 = mfma16(Sf[s], qf[tt % 3][s], acc0); acc1 = mfma16(Sf[s + 1], qf[tt % 3][s + 1], acc1); }
                        const int i0 = 16 * tt + l15; const int j0 = 16 * tt + l15s;
                        const float qd0 = __builtin_amdgcn_exp2f(lg2 * (dir == 0 ? (float)(j0 + 1) : (float)(128 - j0)));
#if FP8_RETSTORE
                        { int t8 = __builtin_amdgcn_cvt_pk_fp8_f32((acc0[0] + acc1[0]) * qd0, (acc0[1] + acc1[1]) * qd0, 0, false); t8 = __builtin_amdgcn_cvt_pk_fp8_f32((acc0[2] + acc1[2]) * qd0, (acc0[3] + acc1[3]) * qd0, t8, true);
                          *(int*)((unsigned char*)O + ((rb + i0) * 2048 + h * 512 + slice * 64 + 16 * w + 4 * quad)) = t8; }
#else
                        u32x2 o0; o0.x = cvt_pk_bf16((acc0[0] + acc1[0]) * qd0, (acc0[1] + acc1[1]) * qd0); o0.y = cvt_pk_bf16((acc0[2] + acc1[2]) * qd0, (acc0[3] + acc1[3]) * qd0);
                        *(u32x2*)(O + (rb + i0) * 2048 + h * 512 + slice * 64 + 16 * w + 4 * quad) = o0;
#endif
                        __builtin_amdgcn_sched_barrier(0);
                    }
                }
                __syncthreads();
#pragma unroll
                for (int m = 0; m < 16; ++m) S[m] = S[m] * cdec;
                {
                    const int ksw = (quad & 1) << 3;
                    const LAS unsigned char* kb0 = lds + SC_KT + (4 * quad + tq) * SC_KS + 16 * tp;
                    const LAS unsigned char* vb0 = lds + SC_VT + (4 * quad + tq) * SC_VS + (16 * w + 4 * tp) * 2;
                    s16x4 kf[3][16], vf[4][2];
#pragma unroll
                    for (int s = 0; s < 4; ++s) { vf[s][0] = lds_tr(vb0 + 32 * s * SC_VS); vf[s][1] = lds_tr(vb0 + (32 * s + 16) * SC_VS); }
#define SC_LDK(dst, g) do { const LAS unsigned char* kb_ = kb0 + 32 * ((g) >> 1) * SC_KS + 256 * ((g) & 1); _Pragma("unroll") for (int q_ = 0; q_ < 4; ++q_) { \
        dst[4 * q_ + 0] = lds_tr(kb_ + q_ * 64 + ksw); dst[4 * q_ + 1] = lds_tr(kb_ + q_ * 64 + ksw + 16 * SC_KS); dst[4 * q_ + 2] = lds_tr(kb_ + q_ * 64 + (8 ^ ksw)); dst[4 * q_ + 3] = lds_tr(kb_ + q_ * 64 + (8 ^ ksw) + 16 * SC_KS); } } while (0)
                    SC_LDK(kf[0], 0); SC_LDK(kf[1], 1);
                    bf16x8 Bv = (bf16x8){0, 0, 0, 0, 0, 0, 0, 0};
#pragma unroll
                    for (int g = 0; g < 8; ++g) {
                        if (g + 2 < 8) SC_LDK(kf[(g + 2) % 3], g + 2);
                        __builtin_amdgcn_sched_barrier(0);
                        if ((g & 1) == 0) {
                            const int s = g >> 1; float vs[8];
#pragma unroll
                            for (int e = 0; e < 4; ++e) { const int t0 = 32 * s + 4 * quads + e, t1 = t0 + 16;
                                const float k0 = __builtin_amdgcn_exp2f(lg2 * (dir == 0 ? (float)(127 - t0) : (float)t0)), k1 = __builtin_amdgcn_exp2f(lg2 * (dir == 0 ? (float)(127 - t1) : (float)t1));
                                vs[e] = bf2f((unsigned short)vf[s][0][e]) * k0; vs[4 + e] = bf2f((unsigned short)vf[s][1][e]) * k1; }
                            u32x4 vb; vb.x = cvt_pk_bf16(vs[0], vs[1]); vb.y = cvt_pk_bf16(vs[2], vs[3]); vb.z = cvt_pk_bf16(vs[4], vs[5]); vb.w = cvt_pk_bf16(vs[6], vs[7]);
                            Bv = __builtin_bit_cast(bf16x8, vb);
                        }
#pragma unroll
                        for (int q = 0; q < 4; ++q) { const int sp = 4 * (g & 1) + q;
                            S[2 * sp] = mfma16(cat8(kf[g % 3][4 * q + 0], kf[g % 3][4 * q + 1]), Bv, S[2 * sp]); S[2 * sp + 1] = mfma16(cat8(kf[g % 3][4 * q + 2], kf[g % 3][4 * q + 3]), Bv, S[2 * sp + 1]); }
                        __builtin_amdgcn_sched_barrier(0);
                    }
#undef SC_LDK
                }
                __syncthreads();
            }
        }
    }
    __syncthreads();
}

constexpr int IN_KS = 544, IN_VQ = 128 * 288, IN_VS = 288;
__device__ __forceinline__ int intra_rowbase(int nchunks, int u) {
    const int bh = u / nchunks, cn = u % nchunks, b = bh >> 2;
    if (nchunks == 34) return (cn < 2) ? NLAT + b * 256 + cn * 128 : b * 4096 + (cn - 2) * 128;
    return b * 4096 + cn * 128;
}
#if FP8_RETSTORE
typedef u32x2 RPiece;
__device__ __forceinline__ void rp_unpack(const RPiece& p, float (&v)[8]) { const f32x2 a0 = __builtin_amdgcn_cvt_pk_f32_fp8((int)p.x, false), a1 = __builtin_amdgcn_cvt_pk_f32_fp8((int)p.x, true), a2 = __builtin_amdgcn_cvt_pk_f32_fp8((int)p.y, false), a3 = __builtin_amdgcn_cvt_pk_f32_fp8((int)p.y, true);
    v[0] = a0.x; v[1] = a0.y; v[2] = a1.x; v[3] = a1.y; v[4] = a2.x; v[5] = a2.y; v[6] = a3.x; v[7] = a3.y; }
#define RP_OFF(bytes_bf16) ((bytes_bf16) >> 1)
#else
typedef u32x4 RPiece;
__device__ __forceinline__ void rp_unpack(const RPiece& p, float (&v)[8]) { v[0] = bflo(p.x); v[1] = bfhi(p.x); v[2] = bflo(p.y); v[3] = bfhi(p.y); v[4] = bflo(p.z); v[5] = bfhi(p.z); v[6] = bflo(p.w); v[7] = bfhi(p.w); }
#define RP_OFF(bytes_bf16) (bytes_bf16)
#endif
__device__ __forceinline__ void p_ret_intra(Frame& F, const Args& a, int j, int nchunks) {
    int tid0 = tid_of(F.wv); asm volatile("" : "+v"(tid0)); const int wave = __builtin_amdgcn_readfirstlane(tid0 >> 6);
    GAS unsigned char* wsg_ = (GAS unsigned char*)F.ws; asm volatile("" : "+s"(wsg_)); unsigned char* wso = (unsigned char*)wsg_;
    const bf16* Q = (const bf16*)(wso + WS_RQ); const bf16* K = (const bf16*)(wso + WS_RK); const bf16* V = (const bf16*)(wso + WS_RV);
    const bf16* OF = (const bf16*)(wso + WS_ROF); const bf16* OB = (const bf16*)(wso + WS_ROB); const bf16* Gt = (const bf16*)(wso + WS_RG); bf16* OG = (bf16*)(wso + WS_ROG);
    const int w = wave;
    int vcu = F.vcu; asm volatile("" : "+s"(vcu));
    LAS unsigned char* lds = F.lds;
    const int nunits = 16 * nchunks;
    u32x4 rk[8];
    if (vcu < nunits) { const int rb0 = intra_rowbase(nchunks, vcu), h0 = (vcu / nchunks) & 3;
#pragma unroll
        for (int i = 0; i < 8; ++i) rk[i] = *(const u32x4*)(K + (size_t)(rb0 + (tid0 >> 5) + 16 * i) * 1024 + h0 * 256 + (tid0 & 31) * 8); }
    for (int u = vcu; u < nunits; u += F.G) {
        int tid_o = tid_of(F.wv); asm volatile("" : "+v"(tid_o));
        const int tid = tid_o, lane_o = tid_o & 63;
        const int l15 = lane_o & 15, quad = lane_o >> 4, tq = l15 >> 2, tp = l15 & 3;
        const int h = (u / nchunks) & 3;
        const int rowbase = intra_rowbase(nchunks, u);
        const float lgf = logsig(a.in[I_RDEC][(j * 2 + 0) * 4 + h]) * 1.44269504f, lgb = logsig(a.in[I_RDEC][(j * 2 + 1) * 4 + h]) * 1.44269504f;
        __syncthreads();
#pragma unroll
        for (int i = 0; i < 8; ++i) *(LAS u32x4*)(lds + ((tid >> 5) + 16 * i) * IN_KS + (tid & 31) * 16) = rk[i];
        bf16x8 Bq[8];
#pragma unroll
        for (int s = 0; s < 8; ++s) Bq[s] = *(const bf16x8*)(Q + (size_t)(rowbase + 16 * w + l15) * 1024 + h * 256 + 32 * s + 8 * quad);
        u32x4 rv[16];
#pragma unroll
        for (int i = 0; i < 16; ++i) rv[i] = *(const u32x4*)(V + (size_t)(rowbase + (tid >> 6) + 8 * i) * 2048 + h * 512 + (tid & 63) * 8);
        __syncthreads();
        bf16x8 Pf[4];
        {
            f32x4 sc[8];
#pragma unroll
            for (int kt = 0; kt < 8; ++kt) { sc[kt] = (f32x4){0.f, 0.f, 0.f, 0.f};
#pragma unroll
                for (int s = 0; s < 8; ++s) { const bf16x8 A = *(const LAS bf16x8*)(lds + (16 * kt + l15) * IN_KS + (32 * s + 8 * quad) * 2); sc[kt] = mfma16(A, Bq[s], sc[kt]); } }
            const int qi = 16 * w + l15;
#pragma unroll
            for (int kt = 0; kt < 8; ++kt)
#pragma unroll
                for (int e = 0; e < 4; ++e) { const int kj = 16 * kt + 4 * quad + e; const int d = qi - kj;
                    const float mk = (d == 0) ? 2.f : exp2f((d > 0 ? lgf : lgb) * fabsf((float)d)); sc[kt][e] *= mk; }
#pragma unroll
            for (int s2 = 0; s2 < 4; ++s2) Pf[s2] = pack_acc8(sc[2 * s2], sc[2 * s2 + 1]);
        }
        __syncthreads();
#pragma unroll
        for (int i = 0; i < 16; ++i) { const int row = (tid >> 6) + 8 * i, c16 = tid & 63;
            *(LAS u32x4*)(lds + (c16 >> 4) * IN_VQ + row * IN_VS + (c16 & 15) * 16) = rv[i]; }
        const unsigned ro = ((unsigned)(rowbase + 16 * w + l15) * 2048u + (unsigned)(h * 512 + 8 * quad)) * 2u;
#define ROW16(base, el) (*(const RPiece*)((const char*)(base) + (RP_OFF(ro + (unsigned)(el) * 2u) + (unsigned)dep)))
        RPiece pf[6], pb[6];
#pragma unroll
        for (int kp = 0; kp < 4; ++kp) { pf[kp] = *(const RPiece*)((const char*)OF + RP_OFF(ro + 64u * kp)); pb[kp] = *(const RPiece*)((const char*)OB + RP_OFF(ro + 64u * kp)); }
        __syncthreads();
        __builtin_amdgcn_sched_barrier(0);
        f32x4 o[32];
#pragma unroll
        for (int mt = 0; mt < 32; ++mt) {
            o[mt] = (f32x4){0.f, 0.f, 0.f, 0.f};
            const int kp = mt >> 1;
            const LAS unsigned char* vb = lds + (kp >> 2) * IN_VQ + (32 * (kp & 3) + 8 * tp + 4 * (mt & 1)) * 2;
#pragma unroll
            for (int s2 = 0; s2 < 4; ++s2) { const int r0 = 32 * s2 + 4 * quad + tq;
                const s16x4 v0 = lds_tr(vb + r0 * IN_VS), v1 = lds_tr(vb + (r0 + 16) * IN_VS);
                o[mt] = mfma16(cat8(v0, v1), Pf[s2], o[mt]); }
            if ((mt & 1) == 1) __builtin_amdgcn_sched_barrier(0);
        }
        if (FP8_OUTPROJ) __syncthreads();
        int dep = 0; asm volatile("" : "+v"(dep), "+v"(o[31][3]));
        float sum = 0.f;
#pragma unroll
        for (int bt = 0; bt < 3; ++bt) {
            const int p0 = bt == 0 ? 0 : (bt == 1 ? 4 : 10), np = bt == 0 ? 4 : 6;
            if (bt > 0) {
                asm volatile("" : "+v"(dep), "+v"(sum));
#pragma unroll
                for (int kp = 0; kp < 6; ++kp) { pf[kp] = ROW16(OF, 32 * (p0 + kp)); pb[kp] = ROW16(OB, 32 * (p0 + kp)); }
            }
#pragma unroll
            for (int kp = 0; kp < 6; ++kp) { if (kp >= np) continue; const int m0 = 2 * (p0 + kp), m1 = m0 + 1; float f[8], bk[8]; rp_unpack(pf[kp], f); rp_unpack(pb[kp], bk);
                o[m0][0] += f[0] + bk[0]; o[m0][1] += f[1] + bk[1]; o[m0][2] += f[2] + bk[2]; o[m0][3] += f[3] + bk[3];
                o[m1][0] += f[4] + bk[4]; o[m1][1] += f[5] + bk[5]; o[m1][2] += f[6] + bk[6]; o[m1][3] += f[7] + bk[7];
                sum += ((o[m0][0] + o[m0][1]) + (o[m0][2] + o[m0][3])) + ((o[m1][0] + o[m1][1]) + (o[m1][2] + o[m1][3])); }
        }
        asm volatile("" : "+v"(dep), "+v"(sum));
        RPiece gg[8];
#pragma unroll
        for (int kp = 0; kp < 8; ++kp) gg[kp] = ROW16(Gt, 32 * kp);
        sum += shx(sum, 16, lane_o); sum += shx(sum, 32, lane_o);
        const float mu = sum * (1.f / 512.f);
        float sq = 0.f;
#pragma unroll
        for (int mt = 0; mt < 32; ++mt) { o[mt] = o[mt] - mu; sq += (o[mt][0] * o[mt][0] + o[mt][1] * o[mt][1]) + (o[mt][2] * o[mt][2] + o[mt][3] * o[mt][3]); }
        sq += shx(sq, 16, lane_o); sq += shx(sq, 32, lane_o);
        const float rstd = rsqrtf(sq * (1.f / 512.f) + EPS);
        const float* gn = a.in[I_RGN] + j * 2048 + h * 512 + 8 * quad;
#pragma unroll
        for (int hb = 0; hb < 2; ++hb) {
            if (hb == 1) {
#pragma unroll
                for (int kp = 0; kp < 8; ++kp) gg[kp] = ROW16(Gt, 32 * (8 + kp));
                { const int un = (u + F.G < nunits) ? u + F.G : u; const int rbn = intra_rowbase(nchunks, un), hn = (un / nchunks) & 3;
#pragma unroll
                    for (int i = 0; i < 8; ++i) rk[i] = *(const u32x4*)(K + (size_t)(rbn + (tid >> 5) + 16 * i) * 1024 + hn * 256 + (tid & 31) * 8 + dep); }
            }
#pragma unroll
            for (int kp = 0; kp < 8; ++kp) { const int m0 = 2 * (8 * hb + kp), m1 = m0 + 1; float gf[8]; rp_unpack(gg[kp], gf);
                const f32x4 w0 = *(const f32x4*)(gn + 32 * (8 * hb + kp)), w1 = *(const f32x4*)(gn + 32 * (8 * hb + kp) + 4);
                u32x4 r;
                if (FP8_OUTPROJ && rowbase < NLAT) {
                    const float v0 = o[m0][0] * rstd * w0[0] * silu_f(gf[0]), v1 = o[m0][1] * rstd * w0[1] * silu_f(gf[1]), v2 = o[m0][2] * rstd * w0[2] * silu_f(gf[2]), v3 = o[m0][3] * rstd * w0[3] * silu_f(gf[3]);
                    const float v4 = o[m1][0] * rstd * w1[0] * silu_f(gf[4]), v5 = o[m1][1] * rstd * w1[1] * silu_f(gf[5]), v6 = o[m1][2] * rstd * w1[2] * silu_f(gf[6]), v7 = o[m1][3] * rstd * w1[3] * silu_f(gf[7]);
                    int t0 = __builtin_amdgcn_cvt_pk_fp8_f32(v0, v1, 0, false); t0 = __builtin_amdgcn_cvt_pk_fp8_f32(v2, v3, t0, true);
                    int t1 = __builtin_amdgcn_cvt_pk_fp8_f32(v4, v5, 0, false); t1 = __builtin_amdgcn_cvt_pk_fp8_f32(v6, v7, t1, true);
                    *(LAS u32x2*)(lds + (16 * w + l15) * 528 + 8 * quad + 32 * (8 * hb + kp)) = (u32x2){(unsigned)t0, (unsigned)t1}; r.w = (unsigned)t1;
                } else {
                r.x = cvt_pk_bf16(o[m0][0] * rstd * w0[0] * silu_f(gf[0]), o[m0][1] * rstd * w0[1] * silu_f(gf[1]));
                r.y = cvt_pk_bf16(o[m0][2] * rstd * w0[2] * silu_f(gf[2]), o[m0][3] * rstd * w0[3] * silu_f(gf[3]));
                r.z = cvt_pk_bf16(o[m1][0] * rstd * w1[0] * silu_f(gf[4]), o[m1][1] * rstd * w1[1] * silu_f(gf[5]));
                r.w = cvt_pk_bf16(o[m1][2] * rstd * w1[2] * silu_f(gf[6]), o[m1][3] * rstd * w1[3] * silu_f(gf[7]));
                *(u32x4*)((char*)OG + (FP8_OUTPROJ ? (size_t)36 * MiB - (size_t)NLAT * 4096 : (size_t)0) + (ro + 64u * (8 * hb + kp))) = r; }
                if (kp == 7) asm volatile("" : "+v"(dep), "+v"(r.w)); }
        }
        if (FP8_OUTPROJ && rowbase < NLAT) {
            asm volatile("s_waitcnt lgkmcnt(0)" ::: "memory");
#pragma unroll
            for (int i = 0; i < 8; ++i) { const int row = 2 * i + (lane_o >> 5), c16 = lane_o & 31;
                const u32x4 v = *(const LAS u32x4*)(lds + (16 * w + row) * 528 + c16 * 16);
                *(u32x4*)((char*)OG + (size_t)(rowbase + 16 * w + row) * 2048 + h * 512 + c16 * 16) = v; }
        }
    }
#undef ROW16
    __syncthreads();
}

constexpr int NA_VS = 144, NA_CTX = 576 * 144, NA_RPB = 832 * 144;
struct NaUnit { int b, h, r0, rsu, band; size_t ctxrow; };
__device__ __forceinline__ NaUnit na_unit(int u) {
    NaUnit n;
    if (u < 2048) { n.b = u >> 9; const int rem = u & 511; n.h = rem & 15; n.r0 = 2 * (rem >> 4); n.rsu = min(max(n.r0 - 4, 0), 56); n.band = 1; }
    else { const int uc = u - 2048; n.b = uc >> 5; n.h = (uc >> 1) & 15; n.r0 = (uc & 1) * 128; n.rsu = 0; n.band = 0; }
    n.ctxrow = (size_t)(NLAT + n.b * 256);
    return n;
}
__device__ __forceinline__ void na_load_img(const bf16* T, const NaUnit& n, int tid, u32x4 (&r)[13]) {
    const int c8 = tid & 7, k0 = tid >> 3;
    if (n.band) {
#pragma unroll
        for (int i = 0; i < 9; ++i) { const int kb = k0 + 64 * i; const int tok = min((n.rsu + i) * 64 + k0, 4095);
            r[i] = *(const u32x4*)(T + (size_t)(n.b * 4096 + tok) * 1024 + n.h * 64 + c8 * 8); (void)kb; }
    }
#pragma unroll
    for (int i = 0; i < 4; ++i) r[9 + i] = *(const u32x4*)(T + (n.ctxrow + k0 + 64 * i) * 1024 + n.h * 64 + c8 * 8);
}
__device__ __forceinline__ void na_store_img(LAS unsigned char* lds, const NaUnit& n, int tid, const u32x4 (&r)[13]) {
    const int c8 = tid & 7, k0 = tid >> 3;
    if (n.band) {
#pragma unroll
        for (int i = 0; i < 9; ++i) *(LAS u32x4*)(lds + (k0 + 64 * i) * NA_VS + c8 * 16) = r[i];
    }
#pragma unroll
    for (int i = 0; i < 4; ++i) *(LAS u32x4*)(lds + NA_CTX + (k0 + 64 * i) * NA_VS + c8 * 16) = r[9 + i];
}
__device__ __forceinline__ void p_na_attn(Frame& F, const Args& a) {
    int tid0 = tid_of(F.wv); asm volatile("" : "+v"(tid0)); const int wave = __builtin_amdgcn_readfirstlane(tid0 >> 6);
    GAS unsigned char* wsg_ = (GAS unsigned char*)F.ws; asm volatile("" : "+s"(wsg_)); unsigned char* wso = (unsigned char*)wsg_;
    const bf16* Q = (const bf16*)(wso + WS_NQ); const bf16* K = (const bf16*)(wso + WS_NK); const bf16* V = (const bf16*)(wso + WS_NV); bf16* O = (bf16*)(wso + WS_NO);
    const int w = wave;
    int vcu = F.vcu; asm volatile("" : "+s"(vcu));
    LAS unsigned char* lds = F.lds;
    constexpr int NU = 2048 + 128;
    u32x4 rimg[13];
    bf16x8 Bq0n = (bf16x8){0, 0, 0, 0, 0, 0, 0, 0}, Bq1n = Bq0n;
    auto qrow_of = [&](const NaUnit& n, int lane_o) -> size_t { const int l15 = lane_o & 15; const bool band = n.band != 0;
        const int r = band ? n.r0 + (w >> 2) : 0, jb = w & 3;
        return band ? (size_t)(n.b * 4096 + r * 64 + 16 * jb + l15) * 1024 + n.h * 64 : (n.ctxrow + n.r0 + 16 * w + l15) * 1024 + n.h * 64; };
    if (vcu < NU) { const NaUnit n0 = na_unit(vcu); na_load_img(K, n0, tid0, rimg);
        const size_t q0 = qrow_of(n0, tid0 & 63); Bq0n = *(const bf16x8*)(Q + q0 + 8 * ((tid0 & 63) >> 4)); Bq1n = *(const bf16x8*)(Q + q0 + 32 + 8 * ((tid0 & 63) >> 4)); }
    int hcur = -1;
    for (int u = vcu; u < NU; u += F.G) {
        int tid_o = tid_of(F.wv); asm volatile("" : "+v"(tid_o));
        const int tid = tid_o, lane_o = tid_o & 63;
        const int l15 = lane_o & 15, quad = lane_o >> 4, tq = l15 >> 2, tp = l15 & 3;
        const NaUnit n = na_unit(u);
        const bool band = n.band != 0;
        const int r = band ? n.r0 + (w >> 2) : 0, jb = w & 3, rs = min(max(r - 4, 0), 56);
        const int cb = band ? min(max(16 * jb - 8, 0), 32) : 0;
        const size_t qrow = qrow_of(n, lane_o);
        const bf16x8 Bq0 = Bq0n, Bq1 = Bq1n;
        __syncthreads();
        na_store_img(lds, n, tid, rimg);
        if (band && n.h != hcur) { hcur = n.h; if (tid < 465) ((LAS float*)(lds + NA_RPB))[tid] = a.in[I_NARPB][n.h * 465 + tid]; }
        na_load_img(V, n, tid, rimg);
        __syncthreads();
        constexpr float LOG2E = 1.44269504f;
        bf16x8 Pf[16];
        float m1 = -1e30f, sum1 = 0.f, m2 = -1e30f, sum2 = 0.f;
        if (band) {
            f32x4 sc[16];
#pragma unroll
            for (int t = 0; t < 16; ++t) { const int kk = 16 * t + l15, krow = kk >> 5, kc = kk & 31;
                const LAS unsigned char* kp = lds + ((rs - n.rsu + krow) * 64 + cb + kc) * NA_VS + quad * 16;
                const bf16x8 k0 = *(const LAS bf16x8*)kp, k1 = *(const LAS bf16x8*)(kp + 64);
                f32x4 acc = (f32x4){0.f, 0.f, 0.f, 0.f}; acc = mfma16(k0, Bq0, acc); acc = mfma16(k1, Bq1, acc); sc[t] = acc; }
            const LAS float* rpb = (const LAS float*)(lds + NA_RPB);
            const int qcol = 16 * jb + l15, cstart = min(max(qcol - 8, 0), 48);
            const int rel0 = cb + 4 * quad - qcol;
            const int drb = (rs - r + 7) * 31 + 15;
#pragma unroll
            for (int t = 0; t < 16; ++t)
#pragma unroll
                for (int e = 0; e < 4; ++e) { const int rel = rel0 + (t & 1) * 16 + e;
                    const int kcol = rel + qcol; const bool valid = (kcol >= cstart) && (kcol < cstart + 16);
                    const int idx = drb + (t >> 1) * 31 + min(max(rel, -15), 15);
                    const float v = valid ? sc[t][e] + rpb[idx] : -1e30f; sc[t][e] = v; m1 = fmaxf(m1, v); }
            m1 = fmaxf(m1, shx(m1, 16, lane_o)); m1 = fmaxf(m1, shx(m1, 32, lane_o));
            const float m1l = m1 * LOG2E;
#pragma unroll
            for (int s2 = 0; s2 < 8; ++s2) { f32x4 p0, p1;
#pragma unroll
                for (int e = 0; e < 4; ++e) { p0[e] = __builtin_amdgcn_exp2f(sc[2 * s2][e] * LOG2E - m1l); p1[e] = __builtin_amdgcn_exp2f(sc[2 * s2 + 1][e] * LOG2E - m1l); }
                sum1 += (p0[0] + p0[1]) + (p0[2] + p0[3]) + (p1[0] + p1[1]) + (p1[2] + p1[3]);
                Pf[s2] = pack_acc8(p0, p1); }
        } else {
#pragma unroll
            for (int s2 = 0; s2 < 8; ++s2) Pf[s2] = (bf16x8){0, 0, 0, 0, 0, 0, 0, 0};
        }
        {
            f32x4 sc[16];
#pragma unroll
            for (int t = 0; t < 16; ++t) { const LAS unsigned char* kp = lds + NA_CTX + (16 * t + l15) * NA_VS + quad * 16;
                const bf16x8 k0 = *(const LAS bf16x8*)kp, k1 = *(const LAS bf16x8*)(kp + 64);
                f32x4 acc = (f32x4){0.f, 0.f, 0.f, 0.f}; acc = mfma16(k0, Bq0, acc); acc = mfma16(k1, Bq1, acc); sc[t] = acc; }
#pragma unroll
            for (int t = 0; t < 16; ++t)
#pragma unroll
                for (int e = 0; e < 4; ++e) m2 = fmaxf(m2, sc[t][e]);
            m2 = fmaxf(m2, shx(m2, 16, lane_o)); m2 = fmaxf(m2, shx(m2, 32, lane_o));
            const float m2l = m2 * LOG2E;
#pragma unroll
            for (int s2 = 0; s2 < 8; ++s2) { f32x4 p0, p1;
#pragma unroll
                for (int e = 0; e < 4; ++e) { p0[e] = __builtin_amdgcn_exp2f(sc[2 * s2][e] * LOG2E - m2l); p1[e] = __builtin_amdgcn_exp2f(sc[2 * s2 + 1][e] * LOG2E - m2l); }
                sum2 += (p0[0] + p0[1]) + (p0[2] + p0[3]) + (p1[0] + p1[1]) + (p1[2] + p1[3]);
                Pf[8 + s2] = pack_acc8(p0, p1); }
        }
        sum1 += shx(sum1, 16, lane_o); sum1 += shx(sum1, 32, lane_o);
        sum2 += shx(sum2, 16, lane_o); sum2 += shx(sum2, 32, lane_o);
        const float mm = fmaxf(m1, m2);
        const float a1 = __builtin_amdgcn_exp2f((m1 - mm) * LOG2E), a2 = __builtin_amdgcn_exp2f((m2 - mm) * LOG2E);
        const float inv = 1.f / (sum1 * a1 + sum2 * a2);
        const float f1 = a1 * inv, f2 = a2 * inv;
        __syncthreads();
        na_store_img(lds, n, tid, rimg);
        { const int un = (u + F.G < NU) ? u + F.G : u; const NaUnit nn = na_unit(un); na_load_img(K, nn, tid, rimg);
          const size_t qn = qrow_of(nn, lane_o); Bq0n = *(const bf16x8*)(Q + qn + 8 * quad); Bq1n = *(const bf16x8*)(Q + qn + 32 + 8 * quad); }
        __syncthreads();
        f32x4 o[4], oc[4];
#pragma unroll
        for (int dt = 0; dt < 4; ++dt) { o[dt] = (f32x4){0.f, 0.f, 0.f, 0.f}; oc[dt] = (f32x4){0.f, 0.f, 0.f, 0.f}; }
        if (band) {
#pragma unroll
            for (int s2 = 0; s2 < 8; ++s2) {
                const LAS unsigned char* vp = lds + ((rs - n.rsu + s2) * 64 + cb + 4 * quad + tq) * NA_VS + 8 * tp;
#pragma unroll
                for (int dt = 0; dt < 4; ++dt) { const s16x4 v0 = lds_tr(vp + dt * 32), v1 = lds_tr(vp + 16 * NA_VS + dt * 32); o[dt] = mfma16(cat8(v0, v1), Pf[s2], o[dt]); } }
        }
#pragma unroll
        for (int s2 = 0; s2 < 8; ++s2) {
            const LAS unsigned char* vp = lds + NA_CTX + (32 * s2 + 4 * quad + tq) * NA_VS + 8 * tp;
#pragma unroll
            for (int dt = 0; dt < 4; ++dt) { const s16x4 v0 = lds_tr(vp + dt * 32), v1 = lds_tr(vp + 16 * NA_VS + dt * 32); oc[dt] = mfma16(cat8(v0, v1), Pf[8 + s2], oc[dt]); } }
#pragma unroll
        for (int dt = 0; dt < 4; ++dt) { const float y0 = o[dt][0] * f1 + oc[dt][0] * f2, y1 = o[dt][1] * f1 + oc[dt][1] * f2, y2 = o[dt][2] * f1 + oc[dt][2] * f2, y3 = o[dt][3] * f1 + oc[dt][3] * f2;
            if (FP8_OUT2 && band) { int t8 = __builtin_amdgcn_cvt_pk_fp8_f32(y0, y1, 0, false); t8 = __builtin_amdgcn_cvt_pk_fp8_f32(y2, y3, t8, true);
                *(int*)((unsigned char*)O + qrow + 16 * dt + 4 * quad) = t8; }
            else { u32x2 ov; ov.x = cvt_pk_bf16(y0, y1); ov.y = cvt_pk_bf16(y2, y3);
                *(u32x2*)((unsigned char*)O + (FP8_OUT2 ? CTX_SIDE - (size_t)NLAT * 2048 : (size_t)0) + 2 * (qrow + 16 * dt + 4 * quad)) = ov; } }
    }
    __syncthreads();
}

constexpr int NPHASES = 1 + 9 + 8 + 8 + 9 + 1;
#ifndef EN_MASK
#define EN_MASK 0xFFFF
#endif
#define EN(b) ((EN_MASK >> (b)) & 1)

__global__ void __launch_bounds__(512, 2) fwd_kernel(Args args) {
    extern __shared__ __attribute__((aligned(16))) unsigned char lds_raw[];
    Frame F;
    F.lds = (LAS unsigned char*)lds_raw;
    F.MISC = (volatile LAS unsigned*)(F.lds + MISC_OFF);
    const int tid = threadIdx.x;
    F.wv = __builtin_amdgcn_readfirstlane(tid >> 6);
    F.G = gridDim.x; { const int bx = blockIdx.x; F.vcu = (F.G % 8 == 0) ? (bx % 8) * (F.G / 8) + bx / 8 : bx; }
    F.ws = args.ws;
    if (tid < 256) F.MISC[tid] = 0u;
    __syncthreads();
    const int lo = args.ph_lo, hi = args.ph_hi;
    XcdBarrier bar; bar.bar = (unsigned*)(F.ws + WS_CTL); bar.x = 0; bar.st = F.MISC + 8;
    if (hi - lo > 1) bar = xcd_barrier_post((unsigned*)(F.ws + WS_CTL), F.MISC + 8);
    int ph = 0, need = BG_NEED_RIN0; bool bg_on = true;
#define PH_BEGIN if (ph >= lo && ph < hi) { GAS unsigned char* wsg_ = (GAS unsigned char*)F.ws; asm volatile("" : "+s"(wsg_)); unsigned char* wso = (unsigned char*)wsg_; bf16* WB = (bf16*)(wso + WS_W); (void)WB;
#define PH_END_BG(busy_expr) if (bg_on) { __syncthreads(); int t_ = tid_of(F.wv); asm volatile("" : "+v"(t_)); const bool bz_ = (busy_expr); if (bz_ && t_ == 0) bg_signal(wso, ph); \
        bg_work(args, wso, F.lds, F.MISC, __builtin_amdgcn_readfirstlane(t_ >> 6), t_ & 63, ph, bz_, need); } if (ph + 1 < hi) xcd_barrier(bar, F.wv); } ++ph;
#define PH_END PH_END_BG(true)
#define CNT_BUSY(nunits, c) ((((nunits) - (c) + F.G - 1) / F.G) == (((nunits) + F.G - 1) / F.G) && (c) < (nunits))
    const int cid = (int)blockIdx.x;

    PH_BEGIN for (int rep_ = 0; rep_ < NREP(0); ++rep_) { if (rep_) xcd_barrier(bar, F.wv); if (EN(0)) p_prologue(F, args); } PH_END

    for (int layer = 0; layer < NLAYER; ++layer) {
        const int kind = layer % 3, j = layer / 3;
        const bool need_ctx = layer < NLAYER - 1;
        const int mrows = need_ctx ? NTOK : NLAT;
        bg_on = (layer == 0);
        if (layer == 2) { need = BG_NEED_NQKV; bg_on = true; } if (layer == 3) { need = BG_NEED_RIN1; bg_on = true; }
        PH_BEGIN for (int rep_ = 0; rep_ < NREP(1); ++rep_) { if (rep_) xcd_barrier(bar, F.wv); if (EN(1)) { if (layer == 0) p_pre<0>(F, args, layer); else p_pre<1>(F, args, layer); } } PH_END
        bg_on = (layer == 0);
        if (kind == 0) {
            PH_BEGIN for (int rep_ = 0; rep_ < NREP(2); ++rep_) { if (rep_) xcd_barrier(bar, F.wv); if (EN(2)) {
                pg8::StaticSched S; S.init(wso + WS_ACT, WB + WE_RIN + (size_t)j * 6144 * 1024, NTOK, 6144, FP8_INPROJ ? 512 : 1024, FP8_INPROJ ? 512 : 1024, FP8_INPROJ ? 512 : 1024, F.G, cid);
                LAS unsigned* ropel = (LAS unsigned*)(F.lds + pg8::STAGE_BYTES);
                { int t_o = tid_of(F.wv); asm volatile("" : "+v"(t_o)); typedef _Float16 h2 __attribute__((ext_vector_type(2)));
                  for (int i = t_o; i < 64 * 64; i += 512) { const f32x2 v = ((const f32x2*)(wso + WS_ROPE))[i]; const h2 hv = (h2){(_Float16)v.x, (_Float16)v.y}; ropel[i] = __builtin_bit_cast(unsigned, hv); } }
                __syncthreads();
                EpiRetIn E{(bf16*)(wso + WS_RQ), (bf16*)(wso + WS_RK), (bf16*)(wso + WS_RV), (bf16*)(wso + WS_RG), ropel};
                if (FP8_INPROJ) pg8::gemm_phase<EpiRetIn, pg8::StaticSched, true, true>(F.lds, S, E, 1024, 1024, (size_t)128 * 1024, F.wv);
                else pg8::gemm_phase<EpiRetIn, pg8::StaticSched, true>(F.lds, S, E, 2048, 2048, (size_t)128 * 2048, F.wv);
            } } PH_END_BG(CNT_BUSY(68 * 24, cid))
            PH_BEGIN for (int rep_ = 0; rep_ < NREP(3); ++rep_) { if (rep_) xcd_barrier(bar, F.wv); if (EN(3)) p_ret_scan(F, args, j); } PH_END
            need = (j == 0) ? BG_NEED_ROUT0 : BG_NEED_ROUT1; bg_on = true;
            PH_BEGIN for (int rep_ = 0; rep_ < NREP(4); ++rep_) { if (rep_) xcd_barrier(bar, F.wv); if (EN(4)) p_ret_intra(F, args, j, need_ctx ? 34 : 32); } PH_END_BG(CNT_BUSY(16 * (need_ctx ? 34 : 32), F.vcu))
            bg_on = (layer == 0);
            PH_BEGIN for (int rep_ = 0; rep_ < NREP(5); ++rep_) { if (rep_) xcd_barrier(bar, F.wv); if (EN(5)) {
                pg8::StaticSched S; S.init(wso + WS_ROG, WB + WE_ROUT + (size_t)j * 1024 * 2048, NLAT, 1024, FP8_OUTPROJ ? 1024 : 2048, FP8_OUTPROJ ? 1024 : 2048, FP8_OUTPROJ ? 1024 : 2048, F.G, cid);
                EpiResid E{(bf16*)(wso + WS_XALL), wso, layer, 2, FP8_OUTPROJ ? pg8::FP8_WSCALE : 1.f};
                if (FP8_OUTPROJ) pg8::gemm_phase<EpiResid, pg8::StaticSched, true, true>(F.lds, S, E, 2048, 2048, (size_t)128 * 2048, F.wv);
                else pg8::gemm_phase<EpiResid, pg8::StaticSched, true>(F.lds, S, E, 4096, 4096, (size_t)128 * 4096, F.wv);
                if (need_ctx) small_gemm_ctx<FP8_OUTPROJ != 0>(F, (const bf16*)(wso + WS_ROG + (FP8_OUTPROJ ? (size_t)36 * MiB - (size_t)NLAT * 4096 : (size_t)0)), 2048, WB + WE_ROUT + (size_t)j * 1024 * 2048, 2048, 2048, (bf16*)(wso + WS_XALL), modv(wso, layer, 4, 2));
            } } PH_END
        } else if (kind == 1) {
            PH_BEGIN for (int rep_ = 0; rep_ < NREP(6); ++rep_) { if (rep_) xcd_barrier(bar, F.wv); if (EN(6)) {
                { F1nSched S{(const char*)(wso + WS_A1N), (const char*)(wso + WS_ACT), F.G, F.vcu};
                  EpiF1n E{(bf16*)(wso + WS_G2)};
                  pg8::gemm_phase<EpiF1n, F1nSched, true>(F.lds, S, E, 512, 2048, (size_t)1024 * 2048, F.wv); }
                { F1Sched S{(const char*)(wso + WS_A1), (const char*)(wso + WS_ACT), F.G, F.vcu};
                  EpiF1 E{(bf16*)(wso + WS_G2), (bf16*)(wso + WS_G2C)};
                  pg8::gemm_phase<EpiF1, F1Sched, true>(F.lds, S, E, 512, 2048, (size_t)128 * 2048, F.wv); }
            } } PH_END_BG(CNT_BUSY(544, F.vcu))
            need = BG_NEED_FN; bg_on = true;
            PH_BEGIN for (int rep_ = 0; rep_ < NREP(7); ++rep_) { if (rep_) xcd_barrier(bar, F.wv); if (EN(7)) {
                { F2Sched S{(const char*)(wso + WS_AL), (const char*)(wso + WS_G2), F.G, F.vcu};
                  EpiF2 E{(bf16*)(wso + WS_FF)};
                  if (FP8_F2) pg8::gemm_phase<EpiF2, F2Sched, true, true>(F.lds, S, E, 1024, 8192, (size_t)128 * 8192, F.wv);
                  else pg8::gemm_phase<EpiF2, F2Sched, true>(F.lds, S, E, 2048, 16384, (size_t)128 * 16384, F.wv); }
                { F2cSched S{(const char*)(wso + WS_ALC), (const char*)(wso + WS_G2C), F.G, F.vcu};
                  EpiBf16 E{(bf16*)(wso + WS_FF + (FP8_OUT2 ? CTX_SIDE - (size_t)NLAT * 2048 : (size_t)0)), 1024, 1.f};
                  pg8::gemm_phase<EpiBf16, F2cSched, true>(F.lds, S, E, 1024, 1024, (size_t)128 * 1024, F.wv); }
            } } PH_END_BG(F.vcu < 16)
            bg_on = false;
            PH_BEGIN for (int rep_ = 0; rep_ < NREP(8); ++rep_) { if (rep_) xcd_barrier(bar, F.wv); if (EN(8)) {
                pg8::StaticSched S; S.init(wso + WS_FF, WB + WE_FN, NLAT, 1024, FP8_OUT2 ? 512 : 1024, FP8_OUT2 ? 512 : 1024, FP8_OUT2 ? 512 : 1024, F.G, cid);
                EpiResid E{(bf16*)(wso + WS_XALL), wso, layer, 2, FP8_OUT2 ? pg8::FP8_WSCALE : 1.f};
                if (FP8_OUT2) pg8::gemm_phase<EpiResid, pg8::StaticSched, true, true>(F.lds, S, E, 1024, 1024, (size_t)128 * 1024, F.wv);
                else pg8::gemm_phase<EpiResid, pg8::StaticSched, true>(F.lds, S, E, 2048, 2048, (size_t)128 * 2048, F.wv);
                small_gemm_ctx<FP8_OUT2 != 0>(F, (const bf16*)(wso + WS_FF + (FP8_OUT2 ? CTX_SIDE - (size_t)NLAT * 2048 : (size_t)0)), 1024, WB + WE_FN, 1024, 1024, (bf16*)(wso + WS_XALL), modv(wso, layer, 4, 2));
            } } PH_END
        } else {
            PH_BEGIN for (int rep_ = 0; rep_ < NREP(9); ++rep_) { if (rep_) xcd_barrier(bar, F.wv); if (EN(9)) {
                pg8::StaticSched S; S.init(wso + WS_ACT, WB + WE_NQKV, NTOK, 3072, FP8_INPROJ ? 512 : 1024, FP8_INPROJ ? 512 : 1024, FP8_INPROJ ? 512 : 1024, F.G, cid);
                EpiQKV E{(bf16*)(wso + WS_NQ), (bf16*)(wso + WS_NK), (bf16*)(wso + WS_NV), 0.125f * (FP8_INPROJ ? pg8::FP8_WSCALE : 1.f), FP8_INPROJ ? pg8::FP8_WSCALE : 1.f};
                if (FP8_INPROJ) pg8::gemm_phase<EpiQKV, pg8::StaticSched, true, true>(F.lds, S, E, 1024, 1024, (size_t)128 * 1024, F.wv);
                else pg8::gemm_phase<EpiQKV, pg8::StaticSched, true>(F.lds, S, E, 2048, 2048, (size_t)128 * 2048, F.wv);
            } } PH_END_BG(CNT_BUSY(68 * 12, cid))
            need = BG_NEED_NOUT; bg_on = true;
            PH_BEGIN for (int rep_ = 0; rep_ < NREP(10); ++rep_) { if (rep_) xcd_barrier(bar, F.wv); if (EN(10)) p_na_attn(F, args); } PH_END_BG(CNT_BUSY(2048 + 128, F.vcu))
            bg_on = false;
            PH_BEGIN for (int rep_ = 0; rep_ < NREP(11); ++rep_) { if (rep_) xcd_barrier(bar, F.wv); if (EN(11)) {
                pg8::StaticSched S; S.init(wso + WS_NO, WB + WE_NOUT, NLAT, 1024, FP8_OUT2 ? 512 : 1024, FP8_OUT2 ? 512 : 1024, FP8_OUT2 ? 512 : 1024, F.G, cid);
                EpiResid E{(bf16*)(wso + WS_XALL), wso, layer, 2, FP8_OUT2 ? pg8::FP8_WSCALE : 1.f};
                if (FP8_OUT2) pg8::gemm_phase<EpiResid, pg8::StaticSched, true, true>(F.lds, S, E, 1024, 1024, (size_t)128 * 1024, F.wv);
                else pg8::gemm_phase<EpiResid, pg8::StaticSched, true>(F.lds, S, E, 2048, 2048, (size_t)128 * 2048, F.wv);
                small_gemm_ctx<FP8_OUT2 != 0>(F, (const bf16*)(wso + WS_NO + (FP8_OUT2 ? CTX_SIDE - (size_t)NLAT * 2048 : (size_t)0)), 1024, WB + WE_NOUT, 1024, 1024, (bf16*)(wso + WS_XALL), modv(wso, layer, 4, 2));
            } } PH_END
        }
        PH_BEGIN for (int rep_ = 0; rep_ < NREP(12); ++rep_) { if (rep_) xcd_barrier(bar, F.wv); if (EN(12)) p_mid(F, args, layer, mrows); } PH_END
        need = (layer == 0) ? BG_NEED_MOE0 : (layer == 1) ? BG_NEED_MOE1 : (layer == 2) ? BG_NEED_MOE2 : BG_TOTAL; bg_on = true;
        PH_BEGIN for (int rep_ = 0; rep_ < NREP(13); ++rep_) { if (rep_) xcd_barrier(bar, F.wv); if (EN(13)) p_perm(F, mrows); } PH_END
        bg_on = (layer == 0);
        PH_BEGIN for (int rep_ = 0; rep_ < NREP(14); ++rep_) { if (rep_) xcd_barrier(bar, F.wv); if (EN(14)) {
            volatile LAS int* ts = (volatile LAS int*)(F.MISC + 32);
            { int t_o = tid_of(F.wv); asm volatile("" : "+v"(t_o)); if (t_o < 17) ts[t_o] = ((const int*)(wso + WS_MOETAB))[t_o]; }
            __syncthreads();
            MoeSched S{ts, (const char*)(wso + WS_XP), (const char*)(wso + WS_W) + WE_MG * 2 + (size_t)layer * 16 * 1048576, 8, 131072, F.G, F.vcu};
            EpiMoe1 E{(unsigned char*)(wso + WS_H)};
            pg8::gemm_phase<EpiMoe1, MoeSched, true, true>(F.lds, S, E, 1024, 1024, (size_t)(WE_MU - WE_MG) * 2, F.wv);
        } } PH_END_BG(CNT_BUSY(((volatile LAS int*)(F.MISC + 32))[16] * 8, F.vcu))
        PH_BEGIN for (int rep_ = 0; rep_ < NREP(15); ++rep_) { if (rep_) xcd_barrier(bar, F.wv); if (EN(15)) {
            volatile LAS int* ts = (volatile LAS int*)(F.MISC + 32);
            { int t_o = tid_of(F.wv); asm volatile("" : "+v"(t_o)); if (t_o < 17) ts[t_o] = ((const int*)(wso + WS_MOETAB))[t_o]; }
            __syncthreads();
            MoeSched S{ts, (const char*)(wso + WS_H), (const char*)(wso + WS_W) + WE_MD * 2 + (size_t)layer * 16 * 1048576, 4, 262144, F.G, F.vcu};
#if FP8_YB
            EpiFp8N E{(unsigned char*)(wso + WS_YB)};
            pg8::gemm_phase<EpiFp8N, MoeSched, true, true>(F.lds, S, E, 1024, 1024, (size_t)128 * 1024, F.wv);
#else
            EpiBf16N E{(bf16*)(wso + WS_YB), 1024, pg8::FP8_WSCALE};
            pg8::gemm_phase<EpiBf16N, MoeSched, true, true>(F.lds, S, E, 1024, 1024, (size_t)128 * 1024, F.wv);
#endif
        } } PH_END_BG(CNT_BUSY(((volatile LAS int*)(F.MISC + 32))[16] * 4, F.vcu))
    }
    PH_BEGIN p_pre<2>(F, args, 4); PH_END
#undef PH_BEGIN
#undef PH_END
#undef PH_END_BG
#undef CNT_BUSY
}

extern "C" void kernel_launch(void* const* d_in, const int* in_sizes, int n_in, void* d_out, int out_size, void* d_ws, size_t ws_size, hipStream_t stream) {
    static int grid = 0;
    if (grid == 0) {
        if (n_in != 22 || out_size != NLAT * D || ws_size < WS_END) { fprintf(stderr, "kernel_launch: unexpected shapes (n_in %d out %d ws %zu)\n", n_in, out_size, ws_size); grid = -1; return; }
        int dev = 0, cus = 0, per_cu = 0;
        if (hipGetDevice(&dev) != hipSuccess || hipDeviceGetAttribute(&cus, hipDeviceAttributeMultiprocessorCount, dev) != hipSuccess) { grid = -1; return; }
        if (hipFuncSetAttribute((const void*)fwd_kernel, hipFuncAttributeMaxDynamicSharedMemorySize, LDS_BYTES) != hipSuccess) { fprintf(stderr, "kernel_launch: hipFuncSetAttribute failed\n"); grid = -1; return; }
        if (hipOccupancyMaxActiveBlocksPerMultiprocessor(&per_cu, (const void*)fwd_kernel, 512, LDS_BYTES) != hipSuccess || per_cu < 1) fprintf(stderr, "kernel_launch: occupancy query reports %d\n", per_cu);
        (void)hipGetLastError();
        grid = cus;
    }
    if (grid < 0) return;
    (void)hipMemsetAsync((char*)d_ws + WS_CTL, 0, CTL_ZERO_BYTES, stream);
    Args a{};
    for (int i = 0; i < 22; ++i) a.in[i] = (const float*)d_in[i];
    a.out = (float*)d_out; a.ws = (unsigned char*)d_ws;
#if MK_PER_PHASE
    for (int p = 0; p < NPHASES; ++p) { a.ph_lo = p; a.ph_hi = p + 1; hipLaunchKernelGGL(fwd_kernel, dim3(grid), dim3(512), LDS_BYTES, stream, a); }
#else
    a.ph_lo = 0; a.ph_hi = NPHASES; hipLaunchKernelGGL(fwd_kernel, dim3(grid), dim3(512), LDS_BYTES, stream, a);
#endif
}
```

```cpp
#include <hip/hip_runtime.h>
#include <cstdio>
#include <cstdint>
#include <type_traits>

#define LAS __attribute__((address_space(3)))
#define GAS __attribute__((address_space(1)))
typedef unsigned short bf16;
typedef short bf16x8 __attribute__((ext_vector_type(8)));
typedef short s16x4 __attribute__((ext_vector_type(4)));
typedef float f32x4 __attribute__((ext_vector_type(4)));
typedef float f32x2 __attribute__((ext_vector_type(2)));
typedef unsigned u32x4 __attribute__((ext_vector_type(4)));
typedef unsigned u32x2 __attribute__((ext_vector_type(2)));

#ifndef FP8_INPROJ
#define FP8_INPROJ 1
#endif
#ifndef FP8_OUTPROJ
#define FP8_OUTPROJ 1
#endif
#ifndef FP8_RETSTORE
#define FP8_RETSTORE 1
#endif
#ifndef FP8_YB
#define FP8_YB 1
#endif
#ifndef FP8_OUT2
#define FP8_OUT2 1
#endif
constexpr size_t CTX_SIDE = 20u << 20;
#ifndef FP8_F2
#define FP8_F2 1
#endif
#ifndef MK_PER_PHASE
#define MK_PER_PHASE 0
#endif

constexpr int D = 1024, NB = 4, SEQ = 4096, LCTX = 256, NLAT = NB * SEQ, NCTX = NB * LCTX, NTOK = NLAT + NCTX;
constexpr int NLAYER = 4, NMOD = 6, NEXP = 16;
constexpr float EPS = 1e-6f;
constexpr int RH = 4, RDK = 256, RDV = 512, RCH = 128;
constexpr int NAH = 16, NAHD = 64;
constexpr int PMAX = 2 * NTOK + NEXP * 256;

constexpr size_t MiB = 1u << 20;
constexpr size_t WS_CTL = 0, CTL_ZERO_BYTES = 64 * 1024;
constexpr size_t WS_MOD = 1 * MiB;
constexpr size_t WS_ROPE = 2 * MiB;
constexpr size_t WS_A1 = WS_ROPE + 64 * 1024;
constexpr size_t WS_ALC = WS_A1 + 512 * 256 * 2;
constexpr size_t WS_A1N = WS_ALC + 256 * 512 * 2;
constexpr size_t WS_BLKCNT = 3 * MiB;
constexpr size_t WS_MOETAB = WS_BLKCNT + 64 * 1024;
constexpr size_t WS_ROUTE = 4 * MiB;
constexpr size_t WS_DEST = 5 * MiB;
constexpr size_t WS_W = 8 * MiB;
constexpr size_t WE_RIN = 0, WE_ROUT = WE_RIN + 2ull * 6144 * 1024, WE_FN = WE_ROUT + 2ull * 1024 * 2048, WE_NQKV = WE_FN + 1024ull * 1024,
                 WE_NOUT = WE_NQKV + 3072ull * 1024, WE_MG = WE_NOUT + 1024ull * 1024, WE_MU = WE_MG + 64ull * 1024 * 1024, WE_MD = WE_MU + 64ull * 1024 * 1024,
                 WE_END = WE_MD + 64ull * 1024 * 1024;
static_assert(WE_END * 2 <= 426 * MiB, "weights");
constexpr size_t WS_AL = 434 * MiB;
constexpr size_t WS_XALL = 498 * MiB;
constexpr size_t WS_ACT = 566 * MiB;
constexpr size_t WS_S = 600 * MiB;
constexpr size_t WS_RQ = WS_S, WS_RK = WS_S + 34 * MiB, WS_RV = WS_S + 68 * MiB, WS_RG = WS_S + 136 * MiB, WS_ROF = WS_S + 204 * MiB, WS_ROB = WS_S + 272 * MiB;
constexpr size_t WS_G2 = WS_S, WS_G2C = WS_S + 64 * MiB, WS_FF = WS_S + 68 * MiB;
constexpr size_t WS_NQ = WS_S, WS_NK = WS_S + 34 * MiB, WS_NV = WS_S + 68 * MiB, WS_NO = WS_S + 102 * MiB;
constexpr size_t WS_XP = WS_S, WS_H = WS_S + 76 * MiB, WS_YB = WS_S + 152 * MiB;
constexpr size_t WS_ROG = 940 * MiB;
constexpr size_t WS_END = 1008 * MiB;
static_assert((size_t)PMAX * 2048 <= 76 * MiB, "moe rows");

constexpr int LDS_BYTES = 159 * 1024;
constexpr int MISC_OFF = 158 * 1024;

__device__ __forceinline__ unsigned f2bf(float f) { unsigned u = __builtin_bit_cast(unsigned, f); return (u + 0x7fffu + ((u >> 16) & 1u)) >> 16; }
__device__ __forceinline__ unsigned pk2(float lo, float hi) { return f2bf(lo) | (f2bf(hi) << 16); }
__device__ __forceinline__ float bf2f(unsigned short b) { return __builtin_bit_cast(float, ((unsigned)b) << 16); }
__device__ __forceinline__ float bflo(unsigned u) { return __builtin_bit_cast(float, u << 16); }
__device__ __forceinline__ float bfhi(unsigned u) { return __builtin_bit_cast(float, u & 0xffff0000u); }
__device__ __forceinline__ float silu_f(float v) { return v * __builtin_amdgcn_rcpf(1.f + __expf(-v)); }
__device__ __forceinline__ float shx(float v, int o, int lane) { return __builtin_bit_cast(float, __builtin_amdgcn_ds_bpermute((lane ^ o) << 2, __builtin_bit_cast(int, v))); }
__device__ __forceinline__ float wave_sum(float v, int lane) {
#pragma unroll
    for (int o = 1; o < 64; o <<= 1) v += shx(v, o, lane);
    return v;
}
__device__ __forceinline__ int tid_of(int wave_sgpr) { int l; asm volatile("v_mbcnt_lo_u32_b32 %0, -1, 0\n\tv_mbcnt_hi_u32_b32 %0, -1, %0" : "=v"(l)); return wave_sgpr * 64 + l; }
#define LDS_WAIT() asm volatile("s_waitcnt lgkmcnt(0)" ::: "memory")
#define VM_WAIT() asm volatile("s_waitcnt vmcnt(0)" ::: "memory")

#define XB_TMO      128
#define XB_XCNT(j)  (256  + 64 * (j))
#define XB_XSUB(j)  (1280 + 64 * (j))
#define XB_XGEN(j)  (2304 + 64 * (j))
#define XB_TOP      3328
#define XB_TOPGEN   3392
#define XCD_BAR_WORDS 3456
#define XB_SPIN_CAP (1u << 18)
__device__ __forceinline__ unsigned xb_ld(unsigned* p)              { return __hip_atomic_load(p, __ATOMIC_RELAXED, __HIP_MEMORY_SCOPE_AGENT); }
__device__ __forceinline__ unsigned xb_add(unsigned* p, unsigned v) { return __hip_atomic_fetch_add(p, v, __ATOMIC_RELAXED, __HIP_MEMORY_SCOPE_AGENT); }
__device__ __forceinline__ unsigned xb_xcc_id() { return (unsigned)__builtin_amdgcn_s_getreg((3 << 11) | 20) & 0xFu; }
#define XB_SPIN(cond, bar) do { unsigned _sp = 0; while (cond) { __builtin_amdgcn_s_sleep(1); \
    if ((++_sp & 255u) == 0u) { if (xb_ld(&(bar)[XB_TMO])) break; if (_sp > XB_SPIN_CAP) { atomicAdd(&(bar)[XB_TMO], 1u); break; } } } } while (0)
struct XcdBarrier { unsigned* bar; unsigned x; volatile LAS unsigned* st; };
__device__ __forceinline__ XcdBarrier xcd_barrier_post(unsigned* bar, volatile LAS unsigned* st) {
    XcdBarrier b; b.bar = bar; b.x = xb_xcc_id(); b.st = st;
    if (threadIdx.x == 0) (void)xb_add(&bar[XB_XCNT(b.x)], 1u);
    return b;
}
__device__ __forceinline__ void xcd_barrier_complete(unsigned* bar, unsigned x, unsigned& nloc, unsigned& nx) {
    const unsigned G = gridDim.x * gridDim.y * gridDim.z;
    unsigned sum, cnt, mine, sp = 0u;
    for (;;) {
        sum = 0u; cnt = 0u; mine = 0u;
#pragma unroll
        for (unsigned j = 0; j < 16; ++j) { const unsigned c = xb_ld(&bar[XB_XCNT(j)]); sum += c; cnt += (c > 0u) ? 1u : 0u; mine = (j == x) ? c : mine; }
        if (sum == G) break;
        __builtin_amdgcn_s_sleep(1);
        if ((++sp & 255u) == 0u) { if (xb_ld(&bar[XB_TMO])) break; if (sp > XB_SPIN_CAP) { atomicAdd(&bar[XB_TMO], 1u); break; } }
    }
    nloc = mine > 0u ? mine : 1u; nx = cnt > 0u ? cnt : 1u;
}
__device__ __forceinline__ void xcd_barrier(const XcdBarrier& b, const int wave_sgpr) {
    asm volatile("s_waitcnt vmcnt(0)" ::: "memory");
    __syncthreads();
    if (tid_of(wave_sgpr) == 0) {
        unsigned* bar = b.bar;
        __builtin_amdgcn_s_waitcnt(0);
        unsigned nloc = b.st[0], nx = b.st[1];
        if (nloc == 0u) { xcd_barrier_complete(bar, b.x, nloc, nx); b.st[0] = nloc; b.st[1] = nx; }
        const unsigned old = xb_add(&bar[XB_XSUB(b.x)], 1u);
        const unsigned gen = old / nloc;
        if (old + 1u == (gen + 1u) * nloc) {
            __builtin_amdgcn_fence(__ATOMIC_RELEASE, "agent");
            asm volatile("s_waitcnt vmcnt(0)" ::: "memory");
            const unsigned og = xb_add(&bar[XB_TOP], 1u);
            const unsigned tg = og / nx;
            if (og + 1u == (tg + 1u) * nx) {
#pragma unroll
                for (unsigned jx = 0; jx < 16; ++jx) (void)xb_add(&bar[XB_XGEN(jx)], 1u);
                __builtin_amdgcn_fence(__ATOMIC_ACQUIRE, "agent");
                asm volatile("s_waitcnt vmcnt(0)" ::: "memory");
            } else {
                __builtin_amdgcn_fence(__ATOMIC_ACQUIRE, "agent");
                XB_SPIN(xb_ld(&bar[XB_XGEN(b.x)]) == gen, bar);
                asm volatile("s_waitcnt vmcnt(0)" ::: "memory");
            }
        } else {
            __builtin_amdgcn_fence(__ATOMIC_ACQUIRE, "agent");
            XB_SPIN(xb_ld(&bar[XB_XGEN(b.x)]) == gen, bar);
            asm volatile("s_waitcnt vmcnt(0)" ::: "memory");
        }
    }
    __syncthreads();
}

namespace pg8 {
constexpr int BM = 256, BK = 64, HALF = 128, HTB = HALF * BK * 2, STAGE_BYTES = 8 * HTB;
__host__ __device__ __forceinline__ int lds_byte(int r, int c) { const int pos = (c >> 3) ^ ((r >> 1) & 7); return r * 128 + pos * 16 + (c & 7) * 2; }
__host__ __device__ __forceinline__ void stage_rc(int b, int& R, int& C) { R = b >> 7; const int pos = (b >> 4) & 7; C = (pos ^ ((R >> 1) & 7)) * 8 + ((b & 15) >> 1); }
__host__ __device__ __forceinline__ int perm32(int rho) { const int n = rho >> 4, i = rho & 15; return 8 * (i >> 2) + 4 * n + (i & 3); }

struct Unit { const char* A; const char* B0; int pm, pn, aux, nt; };

typedef int i32x8 __attribute__((ext_vector_type(8)));
__device__ __forceinline__ i32x8 cat_i8(const bf16x8& lo, const bf16x8& hi) { const u32x4 a = __builtin_bit_cast(u32x4, lo), b = __builtin_bit_cast(u32x4, hi); return (i32x8){(int)a.x, (int)a.y, (int)a.z, (int)a.w, (int)b.x, (int)b.y, (int)b.z, (int)b.w}; }
constexpr int FP8_SCALE_A = 0x7F7F7F7F, FP8_SCALE_B = 0x7F7F7F7F;
constexpr float FP8_WSCALE = 1.f / 32.f;
template <class E, class = void> struct has_brow : std::false_type {};
template <class E> struct has_brow<E, std::void_t<decltype(E::brow(0))>> : std::true_type {};
template <class E, class = void> struct has_lds_store : std::false_type {};
template <class E> struct has_lds_store<E, std::void_t<decltype(E::LDS_STORE)>> : std::true_type {};
template <class Epi, class Sched, bool ALIGN_EPI, bool FP8 = false>
__device__ __forceinline__ void gemm_phase(LAS unsigned char* lds, const Sched& S, const Epi& E, const int ldaB  , const int ldbB, const size_t hstepB  , const int wave_sgpr) {
    int tid = tid_of(wave_sgpr); asm volatile("" : "+v"(tid));
    const int wid = __builtin_amdgcn_readfirstlane(tid >> 6), lane = tid & 63, wr = wid >> 2, wc = wid & 3, fr = lane & 15, fq = lane >> 4;
    unsigned voffA[2], voffB[2];
#pragma unroll
    for (int i = 0; i < 2; ++i) { int R, C; stage_rc(tid * 16 + i * 8192, R, C); int Rb = Epi::PERM ? ((R & ~31) + perm32(R & 31)) : R;
        if constexpr (has_brow<Epi>::value) Rb = Epi::brow(R);
        voffA[i] = (unsigned)(R * ldaB + C * 2); voffB[i] = (unsigned)(Rb * ldbB + C * 2); }
    const size_t kstep = (size_t)(BK * 2);
    const size_t hstepA = (size_t)HALF * ldaB;
    const unsigned ldsw = (unsigned)wid * 1024u;
    const unsigned ldsbase = (unsigned)(size_t)lds + ldsw;
    const int aoff = lds_byte(wr * 64 + fr, fq * 8), boff = lds_byte(wc * 32 + fr, fq * 8);
#define PG8_SA(b, h) (((b) * 2 + (h)) * HTB)
#define PG8_SB(b, h) ((4 + (b) * 2 + (h)) * HTB)
#define PG8_STAGE(bufoff, gbase, voff) do { _Pragma("unroll") for (int _i = 0; _i < 2; ++_i) { \
        if constexpr (FP8) { unsigned keep_; asm volatile("s_mov_b32 %0, m0\n\ts_mov_b32 m0, %2\n\ts_nop 0\n\tglobal_load_lds_dwordx4 %1, %3\n\ts_mov_b32 m0, %0" : "=&s"(keep_) \
            : "v"((voff)[_i]), "s"(ldsbase + (unsigned)((bufoff) + _i * 8192)), "s"((const char*)(gbase)) : "memory"); } \
        else __builtin_amdgcn_global_load_lds((const unsigned*)((const char*)(gbase) + (voff)[_i]), (LAS unsigned*)(lds + (bufoff) + ldsw + _i * 8192), 16, 0, 0); } } while (0)
#define PG8_LDA(dst, b, h) do { int ao1_ = aoff ^ 64; asm volatile("" : "+v"(ao1_)); _Pragma("unroll") for (int m = 0; m < 4; ++m) { dst[m][0] = *(const LAS bf16x8*)(lds + PG8_SA(b, h) + aoff + m * 2048); dst[m][1] = *(const LAS bf16x8*)(lds + PG8_SA(b, h) + ao1_ + m * 2048); } } while (0)
#define PG8_LDB(dst, b, h) do { int bo1_ = boff ^ 64; asm volatile("" : "+v"(bo1_)); _Pragma("unroll") for (int n = 0; n < 2; ++n) { dst[n][0] = *(const LAS bf16x8*)(lds + PG8_SB(b, h) + boff + n * 2048); dst[n][1] = *(const LAS bf16x8*)(lds + PG8_SB(b, h) + bo1_ + n * 2048); } } while (0)
#define PG8_MMA(ai, bj, At, Bt) do { __builtin_amdgcn_s_setprio(1); _Pragma("unroll") for (int m = 0; m < 4; ++m) _Pragma("unroll") for (int n = 0; n < 2; ++n) { \
        if constexpr (FP8) acc[ai][bj][m][n] = __builtin_amdgcn_mfma_scale_f32_16x16x128_f8f6f4(cat_i8(Bt[n][0], Bt[n][1]), cat_i8(At[m][0], At[m][1]), acc[ai][bj][m][n], 0, 0, 0, FP8_SCALE_B, 0, FP8_SCALE_A); \
        else { _Pragma("unroll") for (int k = 0; k < 2; ++k) acc[ai][bj][m][n] = __builtin_amdgcn_mfma_f32_16x16x32_bf16(Bt[n][k], At[m][k], acc[ai][bj][m][n], 0, 0, 0); } } __builtin_amdgcn_s_setprio(0); } while (0)
#define PG8_WAIT_V(n) asm volatile("s_waitcnt vmcnt(" #n ")" ::: "memory")
#define PG8_WAIT_L(n) asm volatile("s_waitcnt lgkmcnt(" #n ")" ::: "memory")
#define PG8_BAR __builtin_amdgcn_s_barrier()
#define PG8_SCHED __builtin_amdgcn_sched_barrier(0)
    Unit cur, nxt; int ui = 0;
    if (!S.next(0, cur)) return;
    f32x4 acc[2][2][4][2];
#pragma unroll
    for (int a = 0; a < 2; ++a)
#pragma unroll
        for (int b = 0; b < 2; ++b)
#pragma unroll
            for (int m = 0; m < 4; ++m)
#pragma unroll
                for (int n = 0; n < 2; ++n) acc[a][b][m][n] = (f32x4){0.f, 0.f, 0.f, 0.f};
    bf16x8 At[4][2], B0[2][2], B1[2][2];
    const char* cA = cur.A; const char* cB0 = cur.B0;
    PG8_STAGE(PG8_SB(0, 0), cB0, voffB); PG8_STAGE(PG8_SB(0, 1), cB0 + hstepB, voffB); PG8_STAGE(PG8_SA(0, 0), cA, voffA); PG8_STAGE(PG8_SA(0, 1), cA + hstepA, voffA);
    if (wr == 1) PG8_BAR;
    PG8_WAIT_V(2); PG8_BAR;
    PG8_STAGE(PG8_SB(1, 0), cB0 + kstep, voffB); PG8_STAGE(PG8_SA(1, 0), cA + kstep, voffA); PG8_STAGE(PG8_SB(1, 1), cB0 + hstepB + kstep, voffB);
    PG8_WAIT_V(6); PG8_BAR;
    for (;;) {
        const bool has_next = S.next(ui + 1, nxt);
        const char* nA = has_next ? nxt.A : cA; const char* nB0 = has_next ? nxt.B0 : cB0;
        int nt = cur.nt; asm volatile("" : "+s"(nt));
        for (int t = 0; t < nt; t += 2) {
            const bool last = (t == nt - 2);
            const char* a1 = cA + (size_t)(t + 1) * kstep;
            const char* a2 = last ? nA : cA + (size_t)(t + 2) * kstep;
            const char* b20 = last ? nB0 : cB0 + (size_t)(t + 2) * kstep;
            const char* a3 = a2 + kstep; const char* b30 = b20 + kstep;
            PG8_LDB(B0, 0, 0); PG8_LDB(B1, 0, 1); PG8_SCHED; PG8_LDA(At, 0, 0); PG8_STAGE(PG8_SA(1, 1), a1 + hstepA, voffA);
            PG8_WAIT_V(8); PG8_WAIT_L(0); PG8_BAR; PG8_MMA(0, 0, At, B0); PG8_MMA(0, 1, At, B1); PG8_BAR; PG8_SCHED;
            PG8_LDA(At, 0, 1); PG8_STAGE(PG8_SB(0, 0), b20, voffB); PG8_STAGE(PG8_SB(0, 1), b20 + hstepB, voffB); PG8_STAGE(PG8_SA(0, 0), a2, voffA);
            PG8_WAIT_V(8); PG8_WAIT_L(0); PG8_BAR; PG8_MMA(1, 0, At, B0); PG8_MMA(1, 1, At, B1); PG8_BAR; PG8_SCHED;
            PG8_LDB(B0, 1, 0); PG8_LDB(B1, 1, 1); PG8_SCHED; PG8_LDA(At, 1, 0); PG8_STAGE(PG8_SA(0, 1), a2 + hstepA, voffA);
            PG8_WAIT_V(8); PG8_WAIT_L(0); PG8_BAR; PG8_MMA(0, 0, At, B0); PG8_MMA(0, 1, At, B1); PG8_BAR; PG8_SCHED;
            PG8_LDA(At, 1, 1); PG8_STAGE(PG8_SB(1, 0), b30, voffB); PG8_STAGE(PG8_SB(1, 1), b30 + hstepB, voffB); PG8_STAGE(PG8_SA(1, 0), a3, voffA);
            PG8_WAIT_V(8); PG8_WAIT_L(0); PG8_BAR; PG8_MMA(1, 0, At, B0); PG8_MMA(1, 1, At, B1); PG8_BAR; PG8_SCHED;
        }
        if constexpr (ALIGN_EPI) { if (wr == 0) PG8_BAR; }
        { int t_e = tid_of(wave_sgpr); asm volatile("" : "+v"(t_e)); const int fr_e = t_e & 15, fq_e = (t_e >> 4) & 3;
          if constexpr (has_lds_store<Epi>::value) { static_assert(ALIGN_EPI, "LDS-staged epilogues use workgroup barriers"); E.lds_store(acc, cur, wr, wc, fr_e, fq_e, lds + STAGE_BYTES, t_e); }
          else E(acc, cur, wr, wc, fr_e, fq_e); }
        if (!has_next) break;
#pragma unroll
        for (int a = 0; a < 2; ++a)
#pragma unroll
            for (int b = 0; b < 2; ++b)
#pragma unroll
                for (int m = 0; m < 4; ++m)
#pragma unroll
                    for (int n = 0; n < 2; ++n) acc[a][b][m][n] = (f32x4){0.f, 0.f, 0.f, 0.f};
        cur = nxt; cA = nA; cB0 = nB0; ++ui;
        if constexpr (ALIGN_EPI) { if (wr == 1) PG8_BAR; }
    }
    PG8_WAIT_V(0);
    if constexpr (!ALIGN_EPI) { if (wr == 0) PG8_BAR; }
    PG8_BAR;
#undef PG8_SA
#undef PG8_SB
#undef PG8_STAGE
#undef PG8_LDA
#undef PG8_LDB
#undef PG8_MMA
#undef PG8_WAIT_V
#undef PG8_WAIT_L
#undef PG8_BAR
#undef PG8_SCHED
}

constexpr int NXCD = 8, WGM = 8;
struct StaticSched {
    const char* A; const char* Bt; size_t ldaB, ldbB; int nM, nN, nwg, G, c, nt;
    __device__ void init(const void* A_, const void* Bt_, int M, int N, int K, int lda, int ldb, int G_, int c_) { A = (const char*)A_; Bt = (const char*)Bt_; ldaB = (size_t)lda * 2; ldbB = (size_t)ldb * 2; nM = M / BM; nN = N / BM; nwg = nM * nN; G = G_; c = c_; nt = K / BK; }
    __device__ bool next(int i, Unit& u) const {
        const long L = (long)i * G + c; if (L >= nwg) return false;
        int wgid = (int)L; { const int q = nwg / NXCD, r = nwg % NXCD, xcd = wgid % NXCD, off = wgid / NXCD; wgid = (xcd < r ? xcd * (q + 1) : r * (q + 1) + (xcd - r) * q) + off; }
        const int nig = WGM * nN, gid = wgid / nig, fm = gid * WGM, gsz = (nM - fm) < WGM ? (nM - fm) : WGM;
        u.pm = fm + ((wgid % nig) % gsz); u.pn = (wgid % nig) / gsz; u.aux = 0; u.nt = nt;
        u.A = A + (size_t)u.pm * BM * ldaB; u.B0 = Bt + (size_t)u.pn * BM * ldbB; return true;
    }
};
}

struct Args { const float* in[22]; float* out; unsigned char* ws; int ph_lo, ph_hi; };
struct Frame {
    LAS unsigned char* lds; volatile LAS unsigned* MISC;
    int vcu, G, wv;
    unsigned char* ws;
};
enum { I_X = 0, I_C, I_CTX, I_CCTX, I_WMOD, I_BMOD, I_NMIX, I_NFFN, I_NFIN, I_RWIN, I_RDEC, I_RGN, I_RWOUT, I_FNW, I_NAQKV, I_NARPB, I_NAOUT, I_RTW, I_RTB, I_MG, I_MU, I_MD };

__device__ __forceinline__ const float* modv(const unsigned char* ws, int layer, int bidx, int which) { return (const float*)(ws + WS_MOD) + ((size_t)(layer * 5 + bidx) * NMOD + which) * D; }
__device__ __forceinline__ int bidx_of_row(int row) { return row < NLAT ? (row >> 12) : 4; }

#ifndef REP_MASK
#define REP_MASK 0
#endif
#define NREP(b) (1 + ((REP_MASK >> (b)) & 1))
__device__ __forceinline__ int rope_perm(int n) {
    if (n >= 2048) return n;
    const int head = n >> 8, c = n & 255, qd = c >> 6, i = c & 63;
    const int j = (qd == 0) ? i : (qd == 2) ? 64 + i : (qd == 1) ? 128 + i : 192 + i;
    return head * 256 + j;
}
struct TItem { const float* W; bf16* WT; int K, N, item; bool rp; bool f8; };
__device__ __forceinline__ void titem_load(const TItem& t, f32x4 (&v)[16], int lane) {
    const int nblk = t.N / 64, kb = t.item / nblk, nb = t.item % nblk, k0 = 64 * kb, n0 = 64 * nb;
    const float* src = t.W + (size_t)(k0 + (lane >> 4)) * t.N + n0 + (lane & 15) * 4;
#pragma unroll
    for (int r = 0; r < 16; ++r) v[r] = *(const f32x4*)(src + (size_t)(4 * r) * t.N);
}
__device__ __forceinline__ void titem_store(const TItem& t, const f32x4 (&v)[16], LAS float* scr, int lane) {
    const int nblk = t.N / 64, kb = t.item / nblk, nb = t.item % nblk, k0 = 64 * kb, n0 = 64 * nb;
#pragma unroll
    for (int r = 0; r < 16; ++r) { const int kk = 4 * r + (lane >> 4), n4 = (lane & 15) * 4;
        scr[kk * 65 + n4 + 0] = v[r][0]; scr[kk * 65 + n4 + 1] = v[r][1]; scr[kk * 65 + n4 + 2] = v[r][2]; scr[kk * 65 + n4 + 3] = v[r][3]; }
    LDS_WAIT(); asm volatile("" ::: "memory");
    const int c = lane & 7;
#pragma unroll 2
    for (int j = 0; j < 8; ++j) { const int n = 8 * j + (lane >> 3); const LAS float* s = scr + (8 * c) * 65 + n;
        float x[8];
#pragma unroll
        for (int q = 0; q < 8; ++q) x[q] = s[q * 65];
        const int nd = t.rp ? rope_perm(n0 + n) : (n0 + n);
        if (t.f8) { u32x2 o8; int q = __builtin_amdgcn_cvt_pk_fp8_f32(x[0] * 32.f, x[1] * 32.f, 0, false); q = __builtin_amdgcn_cvt_pk_fp8_f32(x[2] * 32.f, x[3] * 32.f, q, true); o8.x = (unsigned)q;
            q = __builtin_amdgcn_cvt_pk_fp8_f32(x[4] * 32.f, x[5] * 32.f, 0, false); q = __builtin_amdgcn_cvt_pk_fp8_f32(x[6] * 32.f, x[7] * 32.f, q, true); o8.y = (unsigned)q;
            *(u32x2*)((unsigned char*)t.WT + (size_t)nd * t.K + k0 + 8 * c) = o8; }
        else { u32x4 o; o.x = pk2(x[0], x[1]); o.y = pk2(x[2], x[3]); o.z = pk2(x[4], x[5]); o.w = pk2(x[6], x[7]); *(u32x4*)(t.WT + (size_t)nd * t.K + k0 + 8 * c) = o; } }
    LDS_WAIT(); asm volatile("" ::: "memory");
}
__device__ __forceinline__ int seg_items(int seg) { return seg < 2 ? 16 * 96 : seg < 4 ? 32 * 16 : seg == 4 ? 256 : seg == 5 ? 16 * 48 : seg == 6 ? 256 : 16 * 256; }
template <int NSEG>
__device__ __forceinline__ TItem titem_decode(const Args& a, bf16* WB, const int (&segs)[NSEG], int it) {
    int seg = segs[0], before = 0, accn = 0; bool found = false;
#pragma unroll
    for (int i = 0; i < NSEG; ++i) { const int n = seg_items(segs[i]); if (!found && it < accn + n) { seg = segs[i]; before = accn; found = true; } accn += n; }
    const int li = it - before;
    TItem t; t.rp = false; t.f8 = false; t.item = li;
    if (seg < 2) { t.W = a.in[I_RWIN] + (size_t)seg * 1024 * 6144; t.K = 1024; t.N = 6144; t.WT = WB + WE_RIN + (size_t)seg * 6144 * 1024; t.rp = true; t.f8 = FP8_INPROJ != 0; }
    else if (seg < 4) { const int j = seg - 2; t.W = a.in[I_RWOUT] + (size_t)j * 2048 * 1024; t.K = 2048; t.N = 1024; t.WT = WB + WE_ROUT + (size_t)j * 1024 * 2048; t.f8 = FP8_OUTPROJ != 0; }
    else if (seg == 4) { t.W = a.in[I_FNW]; t.K = 1024; t.N = 1024; t.WT = WB + WE_FN; t.f8 = FP8_OUT2 != 0; }
    else if (seg == 5) { t.W = a.in[I_NAQKV]; t.K = 1024; t.N = 3072; t.WT = WB + WE_NQKV; t.f8 = FP8_INPROJ != 0; }
    else if (seg == 6) { t.W = a.in[I_NAOUT]; t.K = 1024; t.N = 1024; t.WT = WB + WE_NOUT; t.f8 = FP8_OUT2 != 0; }
    else { const int l = (seg - 7) / 3, which = (seg - 7) % 3, mi = l * 16 + (li >> 8); t.item = li & 255; t.K = 1024; t.N = 1024;
        t.W = a.in[which == 0 ? I_MG : which == 1 ? I_MU : I_MD] + (size_t)mi * 1048576; t.f8 = true;
        t.WT = (bf16*)((unsigned char*)(WB + (which == 0 ? WE_MG : which == 1 ? WE_MU : WE_MD)) + (size_t)mi * 1048576); }
    return t;
}
constexpr int BG_NSEG = 19;
constexpr int BG_NEED_RIN0 = 1536, BG_NEED_ROUT0 = BG_NEED_RIN0 + 512, BG_NEED_MOE0 = BG_NEED_ROUT0 + 3 * 4096, BG_NEED_FN = BG_NEED_MOE0 + 256, BG_NEED_MOE1 = BG_NEED_FN + 3 * 4096,
              BG_NEED_NQKV = BG_NEED_MOE1 + 768, BG_NEED_NOUT = BG_NEED_NQKV + 256, BG_NEED_MOE2 = BG_NEED_NOUT + 3 * 4096, BG_NEED_RIN1 = BG_NEED_MOE2 + 1536, BG_NEED_ROUT1 = BG_NEED_RIN1 + 512,
              BG_TOTAL = BG_NEED_ROUT1 + 3 * 4096;
constexpr int CW_QHEAD = 4096, CW_PHDONE = 8192;
__device__ __forceinline__ TItem bg_decode(const Args& a, bf16* WB, int it) {
    const int segs[BG_NSEG] = {0, 2, 7, 8, 9, 4, 10, 11, 12, 5, 6, 13, 14, 15, 1, 3, 16, 17, 18};
    return titem_decode<BG_NSEG>(a, WB, segs, it);
}
__device__ __forceinline__ void bg_work(const Args& a, unsigned char* wso, LAS unsigned char* lds, volatile LAS unsigned* misc, int wave, int lane, int ph, bool busy, int need) {
    unsigned* ctl = (unsigned*)(wso + WS_CTL);
    bf16* WB = (bf16*)(wso + WS_W);
    LAS float* scr = (LAS float*)lds + wave * (64 * 65);
    for (;;) {
        __syncthreads();
        if (wave == 0 && lane == 0) {
            const unsigned h = __hip_atomic_load(ctl + CW_QHEAD, __ATOMIC_RELAXED, __HIP_MEMORY_SCOPE_AGENT);
            unsigned base = (unsigned)BG_TOTAL;
            bool go = h < (unsigned)BG_TOTAL;
            if (go && h >= (unsigned)need) { if (busy) go = false; else if (__hip_atomic_load(ctl + CW_PHDONE + 64 * ph, __ATOMIC_RELAXED, __HIP_MEMORY_SCOPE_AGENT) != 0u) go = false; }
            if (go) base = __hip_atomic_fetch_add(ctl + CW_QHEAD, 64u, __ATOMIC_RELAXED, __HIP_MEMORY_SCOPE_AGENT);
            misc[64] = base;
        }
        __syncthreads();
        const int base = (int)misc[64];
        if (base >= BG_TOTAL) break;
        f32x4 va[16], vb[16];
        TItem ta = bg_decode(a, WB, min(base + wave, BG_TOTAL - 1)), tb = ta;
        bool oka = base + wave < BG_TOTAL, okb = false;
        if (oka) titem_load(ta, va, lane);
#pragma unroll 1
        for (int i = 0; i < 8; i += 2) {
            const int ib = base + wave + 8 * (i + 1), ia2 = base + wave + 8 * (i + 2);
            okb = ib < BG_TOTAL; if (okb) { tb = bg_decode(a, WB, ib); titem_load(tb, vb, lane); }
            if (oka) titem_store(ta, va, scr, lane);
            oka = (i + 2 < 8) && ia2 < BG_TOTAL; if (oka) { ta = bg_decode(a, WB, ia2); titem_load(ta, va, lane); }
            if (okb) titem_store(tb, vb, scr, lane);
        }
    }
}
__device__ __forceinline__ void bg_signal(unsigned char* wso, int ph) {
    __hip_atomic_fetch_add((unsigned*)(wso + WS_CTL) + CW_PHDONE + 64 * ph, 1u, __ATOMIC_RELAXED, __HIP_MEMORY_SCOPE_AGENT);
}

__device__ __forceinline__ void p_prologue(Frame& F, const Args& a) {
    int tid = tid_of(F.wv); asm volatile("" : "+v"(tid)); const int lane = tid & 63, wave = __builtin_amdgcn_readfirstlane(tid >> 6); (void)lane; (void)wave;
    GAS unsigned char* wsg_ = (GAS unsigned char*)F.ws; asm volatile("" : "+s"(wsg_)); unsigned char* wso = (unsigned char*)wsg_;
    for (int rr_ = 0; rr_ < NREP(16); ++rr_) if ((int)blockIdx.x < NLAYER * 48) {
        LAS float* act = (LAS float*)F.lds;
        LAS float* red = act + 5 * 1024;
        for (int idx = tid; idx < 5 * 1024; idx += 512) { const int r = idx >> 10, k = idx & 1023; const float v = (r < 4) ? a.in[I_C][r * 1024 + k] : a.in[I_CCTX][k]; act[idx] = silu_f(v); }
        __syncthreads();
        {
            const int u = (int)blockIdx.x;
            const int layer = u / 48, n0 = (u % 48) * 128;
            const float* w = a.in[I_WMOD] + (size_t)layer * 1024 * 6144 + n0 + 2 * lane;
            f32x2 s0 = (f32x2){0.f, 0.f}, s1 = s0, s2 = s0, s3 = s0, s4 = s0;
            const int kb = wave * 128;
#pragma unroll 16
            for (int k = 0; k < 128; ++k) { const f32x2 wv = *(const f32x2*)(w + (size_t)(kb + k) * 6144);
                s0 += wv * act[kb + k]; s1 += wv * act[1024 + kb + k]; s2 += wv * act[2048 + kb + k]; s3 += wv * act[3072 + kb + k]; s4 += wv * act[4096 + kb + k]; }
            *(LAS f32x2*)(red + (wave * 5 + 0) * 128 + 2 * lane) = s0; *(LAS f32x2*)(red + (wave * 5 + 1) * 128 + 2 * lane) = s1; *(LAS f32x2*)(red + (wave * 5 + 2) * 128 + 2 * lane) = s2;
            *(LAS f32x2*)(red + (wave * 5 + 3) * 128 + 2 * lane) = s3; *(LAS f32x2*)(red + (wave * 5 + 4) * 128 + 2 * lane) = s4;
            __syncthreads();
            for (int o = tid; o < 5 * 128; o += 512) { const int r = o >> 7, l = o & 127; float sm = 0.f;
#pragma unroll
                for (int w8 = 0; w8 < 8; ++w8) sm += red[(w8 * 5 + r) * 128 + l];
                const int nn = n0 + l; sm += a.in[I_BMOD][layer * 6144 + nn];
                ((float*)(wso + WS_MOD))[((size_t)(layer * 5 + r) * NMOD + nn / 1024) * D + (nn & 1023)] = sm; }
            __syncthreads();
        }
    }
    __syncthreads();
    for (int rr_ = 0; rr_ < NREP(17); ++rr_) {
        bf16* AL = (bf16*)(wso + WS_AL);
        const int nchunk = 8 * 512 * 1024 / 8;
        for (int ch = F.vcu * 512 + tid; ch < nchunk; ch += F.G * 512) {
            const int r = ch >> 16, m = (ch >> 7) & 511, k0 = (ch & 127) * 8;
            const int mul = 8 * m + r;
            float v[8];
#pragma unroll
            for (int e = 0; e < 8; ++e) { const int l = 4 * (k0 >> 3) + (e & 3); const float x = (float)((mul * l) & 4095) * (1.f / 4096.f);
                v[e] = (e < 4) ? __builtin_amdgcn_cosf(x) * (1.f / 64.f) : -__builtin_amdgcn_sinf(x) * (1.f / 64.f); }
            if (FP8_F2) { int t0 = __builtin_amdgcn_cvt_pk_fp8_f32(v[0] * 256.f, v[1] * 256.f, 0, false); t0 = __builtin_amdgcn_cvt_pk_fp8_f32(v[2] * 256.f, v[3] * 256.f, t0, true);
                int t1 = __builtin_amdgcn_cvt_pk_fp8_f32(v[4] * 256.f, v[5] * 256.f, 0, false); t1 = __builtin_amdgcn_cvt_pk_fp8_f32(v[6] * 256.f, v[7] * 256.f, t1, true);
                *(u32x2*)((unsigned char*)AL + (size_t)r * 512 * 1024 + (size_t)m * 1024 + k0) = (u32x2){(unsigned)t0, (unsigned)t1}; }
            else {
            u32x4 o; o.x = pk2(v[0], v[1]); o.y = pk2(v[2], v[3]); o.z = pk2(v[4], v[5]); o.w = pk2(v[6], v[7]);
            *(u32x4*)(AL + (size_t)r * 512 * 1024 + (size_t)m * 1024 + k0) = o; }
        }
        if (F.vcu == 4 % F.G) {
            bf16* A1N = (bf16*)(wso + WS_A1N);
            for (int idx = tid; idx < 512 * 256; idx += 512) { const int row = idx >> 8, c = idx & 255, chh = row >> 8, sgn = (row >> 7) & 1, cp = chh * 128 + (row & 127); const float x = (float)((c * cp) & 255) * (1.f / 256.f);
                const float v = (sgn == 0) ? __builtin_amdgcn_cosf(x) : __builtin_amdgcn_sinf(x); A1N[idx] = (bf16)f2bf(v * (1.f / 16.f)); }
        }
        if (F.vcu == 2 % F.G) {
            bf16* A1 = (bf16*)(wso + WS_A1);
            for (int idx = tid; idx < 512 * 256; idx += 512) { const int row = idx >> 8, c = idx & 255, sgn = row >> 8, cp = row & 255; const float x = (float)((c * cp) & 255) * (1.f / 256.f);
                const float v = (sgn == 0) ? __builtin_amdgcn_cosf(x) : __builtin_amdgcn_sinf(x); A1[idx] = (bf16)f2bf(v * (1.f / 16.f)); }
        }
        if (F.vcu == 3 % F.G) {
            bf16* ALC = (bf16*)(wso + WS_ALC);
            for (int idx = tid; idx < 256 * 512; idx += 512) { const int lp = idx >> 9, k = idx & 511, kk = k & 255; const float x = (float)((lp * kk) & 255) * (1.f / 256.f);
                const float v = (k < 256) ? __builtin_amdgcn_cosf(x) : -__builtin_amdgcn_sinf(x); ALC[idx] = (bf16)f2bf(v * (1.f / 16.f)); }
        }
        if (F.vcu == 1 % F.G) {
            f32x2* rt = (f32x2*)(wso + WS_ROPE);
            for (int idx = tid; idx < 64 * 64; idx += 512) { const int pos = idx >> 6, f = idx & 63; const float inv = powf(10000.f, -(float)f / 64.f); const float ang = (float)pos * inv;
                rt[idx] = (f32x2){cosf(ang), sinf(ang)}; }
        }
        __syncthreads();
    }
    bg_work(a, wso, F.lds, F.MISC, wave, lane, 0, true, BG_NEED_RIN0);
}

struct Row16 { f32x4 v[4]; };
__device__ __forceinline__ Row16 ld_row_f32(const float* p, int lane) { Row16 r;
#pragma unroll
    for (int j = 0; j < 4; ++j) r.v[j] = *(const f32x4*)(p + 256 * j + 4 * lane);
    return r; }
__device__ __forceinline__ void st_row_f32(float* p, int lane, const Row16& r) {
#pragma unroll
    for (int j = 0; j < 4; ++j) *(f32x4*)(p + 256 * j + 4 * lane) = r.v[j]; }
__device__ __forceinline__ Row16 ld_row_bf16(const bf16* p, int lane) { Row16 r;
#pragma unroll
    for (int j = 0; j < 4; ++j) { const u32x2 u = *(const u32x2*)(p + 256 * j + 4 * lane); r.v[j] = (f32x4){bflo(u.x), bfhi(u.x), bflo(u.y), bfhi(u.y)}; }
    return r; }
__device__ __forceinline__ void st_row_bf16(bf16* p, int lane, const Row16& r) {
#pragma unroll
    for (int j = 0; j < 4; ++j) { u32x2 u; u.x = pk2(r.v[j][0], r.v[j][1]); u.y = pk2(r.v[j][2], r.v[j][3]); *(u32x2*)(p + 256 * j + 4 * lane) = u; } }
__device__ __forceinline__ float row_rstd(const Row16& r, int lane) { float s = 0.f;
#pragma unroll
    for (int j = 0; j < 4; ++j) s += (r.v[j][0] * r.v[j][0] + r.v[j][1] * r.v[j][1]) + (r.v[j][2] * r.v[j][2] + r.v[j][3] * r.v[j][3]);
    return rsqrtf(wave_sum(s, lane) * (1.f / D) + EPS); }

#define PRE_NPF 3
__device__ __forceinline__ void st_row_fp8(unsigned char* p, int lane, const Row16& r) {
#pragma unroll
    for (int j = 0; j < 4; ++j) { int t = __builtin_amdgcn_cvt_pk_fp8_f32(r.v[j][0], r.v[j][1], 0, false); t = __builtin_amdgcn_cvt_pk_fp8_f32(r.v[j][2], r.v[j][3], t, true); *(int*)(p + 256 * j + 4 * lane) = t; } }
template <int MODE>
__device__ __forceinline__ void p_pre(Frame& F, const Args& a, int layer) {
    int tid = tid_of(F.wv); asm volatile("" : "+v"(tid)); const int lane = tid & 63, wave = __builtin_amdgcn_readfirstlane(tid >> 6); (void)lane; (void)wave;
    GAS unsigned char* wsg_ = (GAS unsigned char*)F.ws; asm volatile("" : "+s"(wsg_)); unsigned char* wso = (unsigned char*)wsg_;
    int vcu_o = F.vcu; asm volatile("" : "+s"(vcu_o));
    const int gw = vcu_o * 8 + wave, NGW = F.G * 8;
    bf16* XALL = (bf16*)(wso + WS_XALL); bf16* ACT = (bf16*)(wso + WS_ACT);
    const bf16* YB = (const bf16*)(wso + WS_YB); const int* DEST = (const int*)(wso + WS_DEST); const float* ROUTE = (const float*)(wso + WS_ROUTE);
    const int nrows = (MODE == 2) ? NLAT : NTOK;
    const bool fold = (MODE == 1) && (layer == 1);
    const bool f8act = FP8_INPROJ && (MODE == 0 || (MODE == 1 && layer != 1));
    const int nitems = fold ? (NLAT / 4 + NCTX) : nrows;
    const int it0 = (int)((unsigned)(gw * nitems) / (unsigned)NGW), it1 = (int)((unsigned)((gw + 1) * nitems) / (unsigned)NGW);
    const int nseq = (it1 - it0) << (fold ? 2 : 0);
    auto row_of = [&](int p) -> int {
        if (!fold) return it0 + p;
        const int item = it0 + (p >> 2), q = p & 3;
        if (item < NLAT / 4) return (item >> 10) * 4096 + (item & 1023) + ((q & 1) * 2 + (q >> 1)) * 1024;
        return q ? -1 : NLAT + (item - NLAT / 4); };
    const Row16 nw = ld_row_f32((MODE < 2 ? a.in[I_NMIX] + layer * D : a.in[I_NFIN]), lane);
    int dd0 = 0, dd1 = 0, ww0 = 0, ww1 = 0;
    if (MODE > 0) { const int r = row_of(lane); if (lane < nseq && r >= 0) { const u32x2 dv = *(const u32x2*)(DEST + r * 2); const u32x2 wv = *(const u32x2*)(ROUTE + r * 8 + 4); dd0 = (int)dv.x; dd1 = (int)dv.y; ww0 = (int)wv.x; ww1 = (int)wv.y; } }
    struct Slot { f32x4 xf[MODE == 0 ? 4 : 1]; u32x2 x[MODE == 0 ? 1 : 4], y0[MODE == 0 ? 1 : 4], y1[MODE == 0 ? 1 : 4]; };
    auto issue = [&](Slot& S, int p) {
        int pc = p < nseq ? p : nseq - 1; int r = row_of(pc); if (r < 0) { pc &= ~3; r = row_of(pc); }
        if (MODE == 0) { const float* src = r < NLAT ? a.in[I_X] + (size_t)r * D : a.in[I_CTX] + (size_t)(r - NLAT) * D;
#pragma unroll
            for (int j = 0; j < 4; ++j) S.xf[j] = *(const f32x4*)(src + 256 * j + 4 * lane);
        } else {
            const int d0 = __builtin_amdgcn_readlane(dd0, pc), d1 = __builtin_amdgcn_readlane(dd1, pc);
            const bf16* px = XALL + (size_t)r * D; const bf16* p0 = YB + (size_t)d0 * D; const bf16* p1 = YB + (size_t)d1 * D;
#pragma unroll
            for (int j = 0; j < 4; ++j) S.x[j] = *(const u32x2*)(px + 256 * j + 4 * lane);
#pragma unroll
            for (int j = 0; j < 4; ++j) { if (FP8_YB) S.y0[j].x = *(const unsigned*)((const unsigned char*)YB + (size_t)d0 * D + 256 * j + 4 * lane); else S.y0[j] = *(const u32x2*)(p0 + 256 * j + 4 * lane); }
#pragma unroll
            for (int j = 0; j < 4; ++j) { if (FP8_YB) S.y1[j].x = *(const unsigned*)((const unsigned char*)YB + (size_t)d1 * D + 256 * j + 4 * lane); else S.y1[j] = *(const u32x2*)(p1 + 256 * j + 4 * lane); }
        } };
    int cur_bi = -1; Row16 gp, sh, sc, hA, hB;
    auto consume = [&](const Slot& S, int p) {
        const int row = row_of(p);
        if (row < 0) return;
        const int bi = bidx_of_row(row);
        if (bi != cur_bi) { cur_bi = bi;
            if (MODE > 0) gp = ld_row_f32(modv(wso, layer - 1, bi, 5), lane);
            if (MODE < 2) { sh = ld_row_f32(modv(wso, layer, bi, 0), lane); sc = ld_row_f32(modv(wso, layer, bi, 1), lane); } }
        Row16 x;
        if (MODE == 0) {
#pragma unroll
            for (int j = 0; j < 4; ++j) x.v[j] = S.xf[j];
        } else {
            const float ysc = FP8_YB ? pg8::FP8_WSCALE : 1.f;
            const float w0 = __builtin_bit_cast(float, __builtin_amdgcn_readlane(ww0, p)) * ysc, w1 = __builtin_bit_cast(float, __builtin_amdgcn_readlane(ww1, p)) * ysc;
#pragma unroll
            for (int j = 0; j < 4; ++j) {
                const f32x4 xv = {bflo(S.x[j].x), bfhi(S.x[j].x), bflo(S.x[j].y), bfhi(S.x[j].y)};
                f32x4 a0, a1;
                if (FP8_YB) { const f32x2 l0 = __builtin_amdgcn_cvt_pk_f32_fp8((int)S.y0[j].x, false), h0 = __builtin_amdgcn_cvt_pk_f32_fp8((int)S.y0[j].x, true), l1 = __builtin_amdgcn_cvt_pk_f32_fp8((int)S.y1[j].x, false), h1 = __builtin_amdgcn_cvt_pk_f32_fp8((int)S.y1[j].x, true);
                    a0 = (f32x4){l0.x, l0.y, h0.x, h0.y}; a1 = (f32x4){l1.x, l1.y, h1.x, h1.y}; }
                else { a0 = (f32x4){bflo(S.y0[j].x), bfhi(S.y0[j].x), bflo(S.y0[j].y), bfhi(S.y0[j].y)}; a1 = (f32x4){bflo(S.y1[j].x), bfhi(S.y1[j].x), bflo(S.y1[j].y), bfhi(S.y1[j].y)}; }
                x.v[j] = xv + gp.v[j] * (a0 * w0 + a1 * w1); }
        }
        Row16 h;
        const float rs = row_rstd(x, lane);
        if (MODE < 2) {
            st_row_bf16(XALL + (size_t)row * D, lane, x);
#pragma unroll
            for (int j = 0; j < 4; ++j) h.v[j] = (x.v[j] * rs) * nw.v[j] * (sc.v[j] + 1.f) + sh.v[j];
            if (fold && row < NLAT) {
                const int q = p & 3;
                bf16* ab = ACT + (size_t)((row & ~4095) + (row & 1023)) * D;
                if (q == 0) hA = h;
                else if (q == 1) { Row16 o2;
#pragma unroll
                    for (int j = 0; j < 4; ++j) { o2.v[j] = hA.v[j] - h.v[j]; hA.v[j] = hA.v[j] + h.v[j]; }
                    st_row_bf16(ab + (size_t)2048 * D, lane, o2); }
                else if (q == 2) hB = h;
                else { Row16 o0, o1, o3;
#pragma unroll
                    for (int j = 0; j < 4; ++j) { const f32x4 od = hB.v[j] + h.v[j]; o0.v[j] = hA.v[j] + od; o1.v[j] = hA.v[j] - od; o3.v[j] = h.v[j] - hB.v[j]; }
                    st_row_bf16(ab, lane, o0); st_row_bf16(ab + (size_t)1024 * D, lane, o1); st_row_bf16(ab + (size_t)3072 * D, lane, o3); }
            } else if (f8act) st_row_fp8((unsigned char*)ACT + (size_t)row * D, lane, h);
            else st_row_bf16(ACT + (size_t)row * D, lane, h);
        } else {
#pragma unroll
            for (int j = 0; j < 4; ++j) h.v[j] = (x.v[j] * rs) * nw.v[j];
            st_row_f32(a.out + (size_t)row * D, lane, h);
        } };
    Slot ring[PRE_NPF];
#pragma unroll
    for (int u = 0; u < PRE_NPF; ++u) issue(ring[u], u);
    for (int pb = 0; pb < nseq; pb += PRE_NPF) {
#pragma unroll
        for (int u = 0; u < PRE_NPF; ++u) { const int p = pb + u; if (p < nseq) consume(ring[u], p); issue(ring[u], p + PRE_NPF); }
    }
}

#define MID_RS 2064
__device__ __forceinline__ void p_mid(Frame& F, const Args& a, int layer, int nrows) {
    int tid = tid_of(F.wv); asm volatile("" : "+v"(tid)); const int lane = tid & 63, wave = __builtin_amdgcn_readfirstlane(tid >> 6); (void)lane; (void)wave;
    GAS unsigned char* wsg_ = (GAS unsigned char*)F.ws; asm volatile("" : "+s"(wsg_)); unsigned char* wso = (unsigned char*)wsg_;
    int vcu_o = F.vcu; asm volatile("" : "+s"(vcu_o));
    const int gw = vcu_o * 8 + wave, NGW = F.G * 8;
    const bf16* XALL = (const bf16*)(wso + WS_XALL); unsigned char* ACT8 = wso + WS_ACT;
    LAS unsigned char* wh = F.lds; LAS unsigned char* wl = F.lds + 16 * MID_RS;
    LAS int* cnt = (LAS int*)(F.lds + 66048);
    LAS float* stage = (LAS float*)(F.lds + 66560) + wave * 256;
    LAS float* ps = (LAS float*)(F.lds + 75776) + wave * 2048;
    const int ngroups = nrows >> 4;
    const int g0 = (int)((unsigned)(gw * ngroups) / (unsigned)NGW), g1 = (int)((unsigned)((gw + 1) * ngroups) / (unsigned)NGW);
    const int n = lane & 15, kg = lane >> 4;
    for (int c = tid; c < 4096; c += 512) { const f32x4 v = *(const f32x4*)(a.in[I_RTW] + 4 * c); const int k = c >> 2, e4 = (c & 3) * 4;
#pragma unroll
        for (int i = 0; i < 4; ++i) { const unsigned hb = f2bf(v[i]); const float rem = v[i] - __builtin_bit_cast(float, hb << 16);
            *(LAS unsigned short*)(wh + (e4 + i) * MID_RS + 2 * k) = (unsigned short)hb; *(LAS unsigned short*)(wl + (e4 + i) * MID_RS + 2 * k) = (unsigned short)f2bf(rem); } }
    if (tid < 16) cnt[tid] = 0;
    __syncthreads();
    float rbias[16];
#pragma unroll
    for (int e = 0; e < 16; ++e) rbias[e] = a.in[I_RTB][e];
    int cur_bi = -1;
    for (int g = g0; g < g1; ++g) {
        const int row = 16 * g + n;
        u32x4 ring[8];
        const bf16* px = XALL + (size_t)row * D + 8 * kg;
#pragma unroll
        for (int c = 0; c < 8; ++c) ring[c] = *(const u32x4*)(px + 32 * c);
        const int bi = bidx_of_row(16 * g);
        if (bi != cur_bi) { cur_bi = bi;
            const float* nwp = a.in[I_NFFN] + layer * D; const float* shp = modv(wso, layer, bi, 3); const float* scp = modv(wso, layer, bi, 4);
#pragma unroll
            for (int i = 0; i < 4; ++i) { const int o = 4 * (lane + 64 * i); const f32x4 nwv = *(const f32x4*)(nwp + o), scv = *(const f32x4*)(scp + o), shv = *(const f32x4*)(shp + o);
                *(LAS f32x4*)(ps + o) = nwv * (scv + 1.f); *(LAS f32x4*)(ps + 1024 + o) = shv; } }
        float ss = 0.f;
#pragma unroll
        for (int c = 0; c < 32; ++c) { const u32x4 xv = ring[c & 7];
            ring[c & 7] = *(const u32x4*)(px + 32 * ((c + 8) & 31));
#pragma unroll
            for (int i = 0; i < 4; ++i) { const float v0 = bflo(xv[i]), v1 = bfhi(xv[i]); ss += v0 * v0 + v1 * v1; } }
        ss += shx(ss, 16, lane); ss += shx(ss, 32, lane);
        const float rs = rsqrtf(ss * (1.f / D) + EPS);
        f32x4 acc = (f32x4){0.f, 0.f, 0.f, 0.f};
        unsigned char* arow = ACT8 + (size_t)row * D + 8 * kg;
        const LAS unsigned char* whp = wh + n * MID_RS + 16 * kg; const LAS unsigned char* wlp = wl + n * MID_RS + 16 * kg;
        const LAS float* psp = ps + 8 * kg;
#pragma unroll
        for (int c = 0; c < 32; ++c) {
            const f32x4 P0 = *(const LAS f32x4*)(psp + 32 * c), P1 = *(const LAS f32x4*)(psp + 32 * c + 4), S0 = *(const LAS f32x4*)(psp + 1024 + 32 * c), S1 = *(const LAS f32x4*)(psp + 1024 + 32 * c + 4);
            const u32x4 xv = ring[c & 7];
            if (c + 8 < 32) ring[c & 7] = *(const u32x4*)(px + 32 * (c + 8));
            const f32x4 x0 = {bflo(xv[0]), bfhi(xv[0]), bflo(xv[1]), bfhi(xv[1])}, x1 = {bflo(xv[2]), bfhi(xv[2]), bflo(xv[3]), bfhi(xv[3])};
            const f32x4 f0 = (x0 * rs) * P0 + S0, f1 = (x1 * rs) * P1 + S1;
            { int t0 = __builtin_amdgcn_cvt_pk_fp8_f32(f0[0], f0[1], 0, false); t0 = __builtin_amdgcn_cvt_pk_fp8_f32(f0[2], f0[3], t0, true);
              int t1 = __builtin_amdgcn_cvt_pk_fp8_f32(f1[0], f1[1], 0, false); t1 = __builtin_amdgcn_cvt_pk_fp8_f32(f1[2], f1[3], t1, true);
              *(u32x2*)(arow + 32 * c) = (u32x2){(unsigned)t0, (unsigned)t1}; }
            u32x4 hb, lb;
            hb[0] = pk2(f0[0], f0[1]); hb[1] = pk2(f0[2], f0[3]); hb[2] = pk2(f1[0], f1[1]); hb[3] = pk2(f1[2], f1[3]);
            lb[0] = pk2(f0[0] - bflo(hb[0]), f0[1] - bfhi(hb[0])); lb[1] = pk2(f0[2] - bflo(hb[1]), f0[3] - bfhi(hb[1]));
            lb[2] = pk2(f1[0] - bflo(hb[2]), f1[1] - bfhi(hb[2])); lb[3] = pk2(f1[2] - bflo(hb[3]), f1[3] - bfhi(hb[3]));
            const bf16x8 bh = __builtin_bit_cast(bf16x8, hb), bl = __builtin_bit_cast(bf16x8, lb);
            const bf16x8 ah = *(const LAS bf16x8*)(whp + 64 * c), al = *(const LAS bf16x8*)(wlp + 64 * c);
            acc = __builtin_amdgcn_mfma_f32_16x16x32_bf16(ah, bh, acc, 0, 0, 0); acc = __builtin_amdgcn_mfma_f32_16x16x32_bf16(ah, bl, acc, 0, 0, 0); acc = __builtin_amdgcn_mfma_f32_16x16x32_bf16(al, bh, acc, 0, 0, 0);
            __builtin_amdgcn_sched_barrier(0);
        }
        *(LAS f32x4*)(stage + n * 16 + 4 * kg) = acc;
        {
            const bool act = lane < 16;
            const int rl = lane & 15;
            float sel[16], sco[16];
#pragma unroll
            for (int e4 = 0; e4 < 4; ++e4) { const f32x4 v = *(const LAS f32x4*)(stage + rl * 16 + 4 * e4);
#pragma unroll
                for (int i = 0; i < 4; ++i) { const int e = 4 * e4 + i; sco[e] = __builtin_amdgcn_rcpf(1.f + __expf(-v[i])); sel[e] = sco[e] + rbias[e]; } }
            int gbest = 0; float gbs = -1e30f;
#pragma unroll
            for (int gq = 0; gq < 4; ++gq) { float m1 = -1e30f, m2 = -1e30f;
#pragma unroll
                for (int l = 0; l < 4; ++l) { const float v = sel[4 * gq + l]; if (v > m1) { m2 = m1; m1 = v; } else if (v > m2) m2 = v; }
                const float gs = m1 + m2; if (gs > gbs) { gbs = gs; gbest = gq; } }
            float gsel[4], gsco[4];
#pragma unroll
            for (int l = 0; l < 4; ++l) { gsel[l] = sel[0 * 4 + l]; gsco[l] = sco[0 * 4 + l]; }
#pragma unroll
            for (int gq = 1; gq < 4; ++gq) if (gbest == gq) {
#pragma unroll
                for (int l = 0; l < 4; ++l) { gsel[l] = sel[gq * 4 + l]; gsco[l] = sco[gq * 4 + l]; } }
            int l0 = 0; float b0 = gsel[0];
#pragma unroll
            for (int l = 1; l < 4; ++l) if (gsel[l] > b0) { b0 = gsel[l]; l0 = l; }
            int l1 = -1; float b1 = -1e30f;
#pragma unroll
            for (int l = 0; l < 4; ++l) if (l != l0 && gsel[l] > b1) { b1 = gsel[l]; l1 = l; }
            float s0 = gsco[0], s1 = gsco[0];
#pragma unroll
            for (int l = 1; l < 4; ++l) { if (l0 == l) s0 = gsco[l]; if (l1 == l) s1 = gsco[l]; }
            const int e0 = gbest * 4 + l0, e1 = gbest * 4 + l1;
            const float inv = 1.f / (s0 + s1);
            if (act) {
                const int r0 = atomicAdd((int*)&cnt[e0], 1), r1 = atomicAdd((int*)&cnt[e1], 1);
                int* R = (int*)(wso + WS_ROUTE) + (size_t)(16 * g + lane) * 8;
                *(u32x4*)R = (u32x4){(unsigned)e0, (unsigned)e1, (unsigned)r0, (unsigned)r1}; *(f32x2*)(R + 4) = (f32x2){s0 * inv, s1 * inv};
            }
        }
    }
    __syncthreads();
    if (tid < 16) ((int*)(wso + WS_BLKCNT))[blockIdx.x * 16 + tid] = cnt[tid];
    __syncthreads();
}

__device__ __forceinline__ void p_perm(Frame& F, int nrows) {
    int tid = tid_of(F.wv); asm volatile("" : "+v"(tid)); const int lane = tid & 63, wave = __builtin_amdgcn_readfirstlane(tid >> 6); (void)lane; (void)wave;
    GAS unsigned char* wsg_ = (GAS unsigned char*)F.ws; asm volatile("" : "+s"(wsg_)); unsigned char* wso = (unsigned char*)wsg_;
    int vcu_o = F.vcu; asm volatile("" : "+s"(vcu_o));
    const int gw = vcu_o * 8 + wave, NGW = F.G * 8;
    LAS int* tab = (LAS int*)F.lds;
    LAS int* base = tab + 256 * 16;
    LAS int* part = base + 64;
    const int* BC = (const int*)(wso + WS_BLKCNT);
    const unsigned char* ACT = (const unsigned char*)(wso + WS_ACT); unsigned char* XP = (unsigned char*)(wso + WS_XP); int* DEST = (int*)(wso + WS_DEST);
    const int ngroups = nrows >> 4;
    const int r0w = 16 * (int)((unsigned)(gw * ngroups) / (unsigned)NGW), r1w = 16 * (int)((unsigned)((gw + 1) * ngroups) / (unsigned)NGW);
    const int nmine = r1w - r0w;
    constexpr int PERM_MAXR = 16;
    u32x4 rt = {0u, 0u, 0u, 0u};
    if (lane < nmine) rt = *(const u32x4*)((const int*)(wso + WS_ROUTE) + (size_t)(r0w + lane) * 8);
    u32x4 rowv[PERM_MAXR];
#pragma unroll
    for (int i = 0; i < PERM_MAXR; ++i) { const int row = min(r0w + i, r1w - 1); rowv[i] = *(const u32x4*)(ACT + (size_t)row * D + 16 * lane); }
    for (int idx = tid; idx < F.G * 16; idx += 512) tab[idx] = BC[idx];
    __syncthreads();
    {
        const int e = tid & 15, pt = tid >> 4; const int per = (F.G + 31) >> 5; const int b0 = pt * per, b1 = min(b0 + per, F.G);
        int t = 0, m = 0;
        for (int b = b0; b < b1; ++b) { const int v = tab[b * 16 + e]; m += (b < (int)blockIdx.x) ? v : 0; t += v; }
        part[(pt * 16 + e) * 2] = t; part[(pt * 16 + e) * 2 + 1] = m;
    }
    __syncthreads();
    if (tid < 16) {
        int t = 0, m = 0;
#pragma unroll 4
        for (int pt = 0; pt < 32; ++pt) { t += part[(pt * 16 + tid) * 2]; m += part[(pt * 16 + tid) * 2 + 1]; }
        const int padded = (t + 255) & ~255;
        int incl = padded;
#pragma unroll
        for (int o = 1; o < 16; o <<= 1) { const int up = __builtin_amdgcn_ds_bpermute(((lane - o) & 63) << 2, incl); if (tid >= o) incl += up; }
        const int ps = incl - padded;
        base[tid] = ps + m;
        if (blockIdx.x == 0) { ((int*)(wso + WS_MOETAB))[tid] = ps >> 8; if (tid == 15) ((int*)(wso + WS_MOETAB))[16] = incl >> 8; }
    }
    __syncthreads();
    const int e0 = (int)rt.x, e1 = (int)rt.y;
    const int d0 = base[e0 & 15] + (int)rt.z, d1 = base[e1 & 15] + (int)rt.w;
    if (lane < nmine) *(u32x2*)(DEST + (size_t)(r0w + lane) * 2) = (u32x2){(unsigned)d0, (unsigned)d1};
#pragma unroll
    for (int i = 0; i < PERM_MAXR; ++i) if (i < nmine) {
        const int q0 = __builtin_amdgcn_readlane(d0, i), q1 = __builtin_amdgcn_readlane(d1, i);
        *(u32x4*)(XP + (size_t)q0 * D + 16 * lane) = rowv[i]; *(u32x4*)(XP + (size_t)q1 * D + 16 * lane) = rowv[i];
    }
}

using pg8::Unit;
__device__ __forceinline__ unsigned cvt_pk_bf16(float lo, float hi) { unsigned r; asm volatile("v_cvt_pk_bf16_f32 %0, %1, %2" : "=v"(r) : "v"(lo), "v"(hi)); return r; }
__device__ __forceinline__ u32x4 pack8(const f32x4& v0, const f32x4& v1) { u32x4 o; o.x = cvt_pk_bf16(v0[0], v0[1]); o.y = cvt_pk_bf16(v0[2], v0[3]); o.z = cvt_pk_bf16(v1[0], v1[1]); o.w = cvt_pk_bf16(v1[2], v1[3]); return o; }

struct EpiResid {
    static constexpr bool PERM = false;
    bf16* X; const unsigned char* ws; int layer, which; float scale = 1.f;
    __device__ __forceinline__ void operator()(const f32x4 (&acc)[2][2][4][2], const Unit& u, int wr, int wc, int fr, int fq) const {
        const int row0 = u.pm * 256 + wr * 64 + fr, col0 = u.pn * 256 + wc * 32 + 4 * fq;
        const float* g = modv(ws, layer, bidx_of_row(u.pm * 256), which);
        f32x4 gv[2][2];
#pragma unroll
        for (int bj = 0; bj < 2; ++bj)
#pragma unroll
            for (int n = 0; n < 2; ++n) gv[bj][n] = *(const f32x4*)(g + col0 + bj * 128 + n * 16) * scale;
#pragma unroll
        for (int ai = 0; ai < 2; ++ai)
#pragma unroll
            for (int m = 0; m < 4; ++m) { bf16* rowp = X + (size_t)(row0 + ai * 128 + m * 16) * D + col0;
                u32x2 xv[2][2];
#pragma unroll
                for (int bj = 0; bj < 2; ++bj)
#pragma unroll
                    for (int n = 0; n < 2; ++n) xv[bj][n] = *(const u32x2*)(rowp + bj * 128 + n * 16);
#pragma unroll
                for (int bj = 0; bj < 2; ++bj)
#pragma unroll
                    for (int n = 0; n < 2; ++n) { const f32x4 y = gv[bj][n] * acc[ai][bj][m][n]; const u32x2 x = xv[bj][n]; u32x2 o;
                        o.x = cvt_pk_bf16(bflo(x.x) + y[0], bfhi(x.x) + y[1]); o.y = cvt_pk_bf16(bflo(x.y) + y[2], bfhi(x.y) + y[3]); *(u32x2*)(rowp + bj * 128 + n * 16) = o; } }
    }
};
struct EpiBf16 {
    static constexpr bool PERM = true;
    bf16* O; int ldc; float scale;
    __device__ __forceinline__ void operator()(const f32x4 (&acc)[2][2][4][2], const Unit& u, int wr, int wc, int fr, int fq) const {
        const int row0 = u.aux + u.pm * 256 + wr * 64 + fr, col0 = u.pn * 256 + wc * 32 + 8 * fq;
#pragma unroll
        for (int ai = 0; ai < 2; ++ai)
#pragma unroll
            for (int m = 0; m < 4; ++m) { bf16* rowp = O + (size_t)(row0 + ai * 128 + m * 16) * ldc + col0;
#pragma unroll
                for (int bj = 0; bj < 2; ++bj) *(u32x4*)(rowp + bj * 128) = pack8(acc[ai][bj][m][0] * scale, acc[ai][bj][m][1] * scale); }
    }
};
struct EpiQKV {
    static constexpr bool PERM = true;
    bf16* Q; bf16* K; bf16* V; float qscale, kvscale;
    __device__ __forceinline__ void operator()(const f32x4 (&acc)[2][2][4][2], const Unit& u, int wr, int wc, int fr, int fq) const {
        const int which = u.pn >> 2; bf16* base = Q + (size_t)which * ((WS_NK - WS_NQ) / 2); const float sc = which == 0 ? qscale : kvscale;
        const int row0 = u.pm * 256 + wr * 64 + fr, col0 = (u.pn & 3) * 256 + wc * 32 + 8 * fq;
#pragma unroll
        for (int ai = 0; ai < 2; ++ai)
#pragma unroll
            for (int m = 0; m < 4; ++m) { bf16* rowp = base + (size_t)(row0 + ai * 128 + m * 16) * D + col0;
#pragma unroll
                for (int bj = 0; bj < 2; ++bj) *(u32x4*)(rowp + bj * 128) = pack8(acc[ai][bj][m][0] * sc, acc[ai][bj][m][1] * sc); }
    }
};
struct EpiRetIn {
    static constexpr bool PERM = true;
    bf16* Q; bf16* K; bf16* V; bf16* Gt; const LAS unsigned* rope;
    __device__ __forceinline__ void operator()(const f32x4 (&acc)[2][2][4][2], const Unit& u, int wr, int wc, int fr, int fq) const {
        const int row0 = u.pm * 256 + wr * 64 + fr;
        if (u.pn < 8) {
            const int head = u.pn & 3; const bool isK = u.pn >= 4; bf16* base = isK ? K : Q; const float sc = (isK ? 0.0625f : 1.f) * (FP8_INPROJ ? pg8::FP8_WSCALE : 1.f);
            const int jt = wc * 32 + 8 * fq;
            const int nat_a = jt < 64 ? jt : 64 + jt;
            const int f0 = jt & 63;
#pragma unroll
            for (int ai = 0; ai < 2; ++ai)
#pragma unroll
                for (int m = 0; m < 4; ++m) {
                    const int row = row0 + ai * 128 + m * 16;
                    f32x4 a0 = acc[ai][0][m][0], a1 = acc[ai][0][m][1], b0 = acc[ai][1][m][0], b1 = acc[ai][1][m][1];
                    if (u.pm * 256 < NLAT) {
                        const int t = row & 4095; const int pos = jt < 64 ? (t >> 6) : (t & 63);
                        const LAS unsigned* cs = rope + pos * 64 + f0;
#pragma unroll
                        for (int e = 0; e < 4; ++e) { typedef _Float16 h2 __attribute__((ext_vector_type(2))); const h2 p0 = __builtin_bit_cast(h2, cs[e]), p1 = __builtin_bit_cast(h2, cs[4 + e]);
                            const f32x2 c0 = (f32x2){(float)p0[0], (float)p0[1]}, c1 = (f32x2){(float)p1[0], (float)p1[1]};
                            const float x0 = a0[e], y0 = b0[e], x1 = a1[e], y1 = b1[e];
                            a0[e] = x0 * c0.x - y0 * c0.y; b0[e] = x0 * c0.y + y0 * c0.x; a1[e] = x1 * c1.x - y1 * c1.y; b1[e] = x1 * c1.y + y1 * c1.x; }
                    }
                    bf16* rowp = base + (size_t)row * D + head * 256 + nat_a;
                    *(u32x4*)(rowp) = pack8(a0 * sc, a1 * sc); *(u32x4*)(rowp + 64) = pack8(b0 * sc, b1 * sc);
                }
        } else {
            bf16* base = u.pn < 16 ? V : Gt; const int col0 = ((u.pn - 8) & 7) * 256 + wc * 32 + 8 * fq;
#pragma unroll
            for (int ai = 0; ai < 2; ++ai)
#pragma unroll
                for (int m = 0; m < 4; ++m) { bf16* rowp = base + (size_t)(row0 + ai * 128 + m * 16) * 2048 + col0;
#pragma unroll
                    for (int bj = 0; bj < 2; ++bj) { const float ws_ = FP8_INPROJ ? pg8::FP8_WSCALE : 1.f; const f32x4 v0 = acc[ai][bj][m][0] * ws_, v1 = acc[ai][bj][m][1] * ws_;
                        if (FP8_RETSTORE && u.pn >= 16) {
                            int t0 = __builtin_amdgcn_cvt_pk_fp8_f32(v0[0], v0[1], 0, false); t0 = __builtin_amdgcn_cvt_pk_fp8_f32(v0[2], v0[3], t0, true);
                            int t1 = __builtin_amdgcn_cvt_pk_fp8_f32(v1[0], v1[1], 0, false); t1 = __builtin_amdgcn_cvt_pk_fp8_f32(v1[2], v1[3], t1, true);
                            *(u32x2*)((unsigned char*)Gt + (size_t)(row0 + ai * 128 + m * 16) * 2048 + col0 + bj * 128) = (u32x2){(unsigned)t0, (unsigned)t1};
                        } else *(u32x4*)(rowp + bj * 128) = pack8(v0, v1); } }
        }
    }
};
struct EpiF1 {
    static constexpr bool PERM = true;
    bf16* G2; bf16* G2c;
    __device__ __forceinline__ void operator()(const f32x4 (&acc)[2][2][4][2], const Unit& u, int wr, int wc, int fr, int fq) const {
        const int g = u.aux, s = u.pm; const int tok0 = u.pn * 256;
        char* base; unsigned ldrB; int lcol;
        if (tok0 < NLAT) { const int b = tok0 >> 12, par = (tok0 >> 11) & 1; base = (char*)(G2 + (size_t)(b * 1024 + g * 256) * 8192 + par * 4096 + s * 2048); ldrB = 16384u; lcol = tok0 & 2047; }
        else { const int b = (tok0 - NLAT) >> 8; base = (char*)(G2c + (size_t)(b * 1024 + g * 256) * 512 + s * 256); ldrB = 1024u; lcol = 0; }
        const unsigned off0 = (unsigned)(wr * 64 + fr) * ldrB + (unsigned)(lcol + wc * 32 + 8 * fq) * 2u;
#pragma unroll
        for (int ai = 0; ai < 2; ++ai)
#pragma unroll
            for (int m = 0; m < 4; ++m) { const unsigned off = off0 + (unsigned)(ai * 128 + m * 16) * ldrB;
#pragma unroll
                for (int bj = 0; bj < 2; ++bj) *(u32x4*)(base + off + bj * 256) = pack8(acc[ai][bj][m][0], acc[ai][bj][m][1]); }
    }
};
struct EpiF1n {
    static constexpr bool PERM = false;
    __host__ __device__ static constexpr int brow(int R) { return ((R >> 4) & 1) * 512 + (R >> 5) * 16 + (R & 15); }
    bf16* G2;
    static constexpr int EB = FP8_F2 ? 1 : 2;
    __device__ __forceinline__ static void st8(char* p, const f32x4& uq, const f32x4& vq) {
        if (FP8_F2) { int t0 = __builtin_amdgcn_cvt_pk_fp8_f32(uq[0], uq[1], 0, false); t0 = __builtin_amdgcn_cvt_pk_fp8_f32(uq[2], uq[3], t0, true);
            int t1 = __builtin_amdgcn_cvt_pk_fp8_f32(vq[0], vq[1], 0, false); t1 = __builtin_amdgcn_cvt_pk_fp8_f32(vq[2], vq[3], t1, true); *(u32x2*)p = (u32x2){(unsigned)t0, (unsigned)t1}; }
        else { u32x4 o; o.x = cvt_pk_bf16(uq[0], uq[1]); o.y = cvt_pk_bf16(uq[2], uq[3]); o.z = cvt_pk_bf16(vq[0], vq[1]); o.w = cvt_pk_bf16(vq[2], vq[3]); *(u32x4*)p = o; } }
    __device__ __forceinline__ void operator()(const f32x4 (&acc)[2][2][4][2], const Unit& u, int wr, int wc, int fr, int fq) const {
        const int g = u.aux >> 1, grp = u.aux & 1, b = u.pn >> 3, lt = u.pn & 7;
        char* base = (char*)G2 + ((size_t)(b * 1024 + g * 256 + u.pm * 128) * 8192 + lt * 128) * EB;
        const unsigned off0 = ((unsigned)(wr * 64 + fr) * 8192u + (unsigned)(wc * 32 + 8 * fq)) * (unsigned)EB;
        constexpr float cs = 0.70710678118654752f;
#define F1_ST(R_, U_, V_) st8(base + off + (R_) * 1024 * EB, (U_), (V_))
#pragma unroll
        for (int m = 0; m < 4; ++m) { const unsigned off = off0 + (unsigned)(m * 16) * 8192u * (unsigned)EB;
            const f32x4 C0 = acc[0][0][m][0], C1 = acc[0][0][m][1], C2 = acc[0][1][m][0], C3 = acc[0][1][m][1];
            const f32x4 S0 = acc[1][0][m][0], S1 = acc[1][0][m][1], S2 = acc[1][1][m][0], S3 = acc[1][1][m][1];
            if (grp == 0) {
                F1_ST(0, C0 + C1, S0 + S1); F1_ST(4, C0 - C1, S0 - S1);
                F1_ST(2, C2 - S3, S2 + C3); F1_ST(6, C2 + S3, S2 - C3);
            } else {
                const f32x4 tc = (C1 + C3) * cs, ts = (S1 + S3) * cs, dc = (C3 - C1) * cs, ds = (S3 - S1) * cs;
                const f32x4 Ec = C0 + tc, Es = S0 + ts, Fc = C2 + dc, Fs = S2 + ds, Gc = C0 - tc, Gs = S0 - ts, Hc = C2 - dc, Hs = S2 - ds;
                F1_ST(1, Ec + Fs, Es - Fc); F1_ST(7, Ec - Fs, Es + Fc);
                F1_ST(5, Gc + Hs, Gs - Hc); F1_ST(3, Gc - Hs, Gs + Hc);
            }
        }
#undef F1_ST
    }
};
struct EpiMoe1 {
    static constexpr bool PERM = false;
    unsigned char* H;
    __device__ __forceinline__ void operator()(const f32x4 (&acc)[2][2][4][2], const Unit& u, int wr, int wc, int fr, int fq) const {
        const int row0 = u.pm * 256 + wr * 64 + fr, col0 = u.pn * 128 + wc * 32 + 4 * fq;
#pragma unroll
        for (int ai = 0; ai < 2; ++ai)
#pragma unroll
            for (int m = 0; m < 4; ++m) {
#pragma unroll
                for (int n = 0; n < 2; ++n) { f32x4 h;
#pragma unroll
                    for (int e = 0; e < 4; ++e) h[e] = silu_f(acc[ai][0][m][n][e] * pg8::FP8_WSCALE) * (acc[ai][1][m][n][e] * pg8::FP8_WSCALE);
                    int t = __builtin_amdgcn_cvt_pk_fp8_f32(h[0], h[1], 0, false); t = __builtin_amdgcn_cvt_pk_fp8_f32(h[2], h[3], t, true);
                    *(int*)(H + (size_t)(row0 + ai * 128 + m * 16) * D + col0 + 16 * n) = t; } }
    }
};
struct EpiFp8N {
    static constexpr bool PERM = false;
    static constexpr bool LDS_STORE = true;
    static constexpr int RS = 272;
    unsigned char* O;
    __device__ __forceinline__ void lds_store(const f32x4 (&acc)[2][2][4][2], const Unit& u, int wr, int wc, int fr, int fq, LAS unsigned char* buf, int tid) const {
#pragma unroll
        for (int p = 0; p < 4; ++p) {
            if (wr == (p & 1)) {
#pragma unroll
                for (int m = 0; m < 4; ++m)
#pragma unroll
                    for (int bj = 0; bj < 2; ++bj)
#pragma unroll
                        for (int n = 0; n < 2; ++n) { const f32x4 v = acc[p >> 1][bj][m][n]; int t = __builtin_amdgcn_cvt_pk_fp8_f32(v[0], v[1], 0, false); t = __builtin_amdgcn_cvt_pk_fp8_f32(v[2], v[3], t, true);
                            *(LAS int*)(buf + (m * 16 + fr) * RS + bj * 128 + wc * 32 + n * 16 + 4 * fq) = t; }
            }
            asm volatile("s_waitcnt lgkmcnt(0)" ::: "memory"); __builtin_amdgcn_s_barrier(); asm volatile("" ::: "memory");
#pragma unroll
            for (int k = 0; k < 2; ++k) { const int row = (tid >> 4) + 32 * k, ch = tid & 15;
                const u32x4 v = *(const LAS u32x4*)(buf + row * RS + ch * 16);
                *(u32x4*)(O + (size_t)(u.pm * 256 + 64 * p + row) * D + u.pn * 256 + ch * 16) = v; }
            asm volatile("s_waitcnt lgkmcnt(0)" ::: "memory"); __builtin_amdgcn_s_barrier(); asm volatile("" ::: "memory");
        }
    }
    __device__ __forceinline__ void operator()(const f32x4 (&acc)[2][2][4][2], const Unit& u, int wr, int wc, int fr, int fq) const {
        const int row0 = u.pm * 256 + wr * 64 + fr, col0 = u.pn * 256 + wc * 32 + 4 * fq;
#pragma unroll
        for (int ai = 0; ai < 2; ++ai)
#pragma unroll
            for (int m = 0; m < 4; ++m) { unsigned char* rowp = O + (size_t)(row0 + ai * 128 + m * 16) * D + col0;
#pragma unroll
                for (int bj = 0; bj < 2; ++bj)
#pragma unroll
                    for (int n = 0; n < 2; ++n) { const f32x4 v = acc[ai][bj][m][n]; int t = __builtin_amdgcn_cvt_pk_fp8_f32(v[0], v[1], 0, false); t = __builtin_amdgcn_cvt_pk_fp8_f32(v[2], v[3], t, true); *(int*)(rowp + bj * 128 + n * 16) = t; } }
    }
};
struct EpiBf16N {
    static constexpr bool PERM = false;
    bf16* O; int ldc; float scale;
    __device__ __forceinline__ void operator()(const f32x4 (&acc)[2][2][4][2], const Unit& u, int wr, int wc, int fr, int fq) const {
        const int row0 = u.aux + u.pm * 256 + wr * 64 + fr, col0 = u.pn * 256 + wc * 32 + 4 * fq;
#pragma unroll
        for (int ai = 0; ai < 2; ++ai)
#pragma unroll
            for (int m = 0; m < 4; ++m) { bf16* rowp = O + (size_t)(row0 + ai * 128 + m * 16) * ldc + col0;
#pragma unroll
                for (int bj = 0; bj < 2; ++bj)
#pragma unroll
                    for (int n = 0; n < 2; ++n) { const f32x4 v = acc[ai][bj][m][n] * scale; u32x2 o; o.x = cvt_pk_bf16(v[0], v[1]); o.y = cvt_pk_bf16(v[2], v[3]); *(u32x2*)(rowp + bj * 128 + n * 16) = o; } }
    }
};

struct F1nSched {
    static constexpr bool HOOKS = false;
    const char* A1N; const char* ACT; int G, c;
    __device__ bool next(int i, Unit& u) const { const int L = i * G + c; if (L >= 512) return false;
        const int b = L >> 7, g = (L >> 5) & 3, chh = (L >> 4) & 1, lt = (L >> 1) & 7, grp = L & 1; u.pm = chh; u.pn = b * 8 + lt; u.aux = 2 * g + grp; u.nt = 4;
        u.A = A1N + (size_t)chh * 256 * 512; u.B0 = ACT + (size_t)(b * 4096 + grp * 2048 + lt * 64) * 2048 + g * 512; return true; }
};
struct F1Sched {
    static constexpr bool HOOKS = false;
    const char* A1; const char* ACT; int G, c;
    __device__ bool next(int i, Unit& u) const { const int L = i * G + c; if (L >= 4 * 2 * 4) return false;
        const int g = L >> 3, rem = L & 7; u.pm = rem & 1; u.pn = 64 + (rem >> 1); u.aux = g; u.nt = 4;
        u.A = A1 + (size_t)u.pm * 256 * 512; u.B0 = ACT + (size_t)u.pn * 256 * 2048 + g * 512; return true; }
};
struct F2Sched {
    static constexpr bool HOOKS = false;
    const char* AL; const char* G2; int G, c;
    __device__ bool next(int i, Unit& u) const { const int L = i * G + c; if (L >= 256) return false;
        constexpr int EB = FP8_F2 ? 1 : 2;
        const int b = L >> 6, rem = L & 63, r = rem >> 3; u.pm = (rem >> 2) & 1; u.pn = rem & 3; u.aux = b * 4096 + r; u.nt = FP8_F2 ? 8 : 16;
        u.A = AL + ((size_t)r * 512 * 1024 + (size_t)u.pm * 256 * 1024) * EB; u.B0 = G2 + (((size_t)b * 1024 + u.pn * 256) * 8192 + (size_t)r * 1024) * EB; return true; }
};
struct EpiF2 {
    static constexpr bool PERM = true;
    bf16* O;
    __device__ __forceinline__ void operator()(const f32x4 (&acc_)[2][2][4][2], const Unit& u, int wr, int wc, int fr, int fq) const {
        f32x4 acc[2][2][4][2];
#pragma unroll
        for (int i0 = 0; i0 < 2; ++i0)
#pragma unroll
            for (int i1 = 0; i1 < 2; ++i1)
#pragma unroll
                for (int i2 = 0; i2 < 4; ++i2)
#pragma unroll
                    for (int i3 = 0; i3 < 2; ++i3) acc[i0][i1][i2][i3] = acc_[i0][i1][i2][i3] * (FP8_F2 ? (1.f / 256.f) : 1.f);
        const int r = u.aux & 7, rb = u.aux & ~7; const int r0 = u.pm * 256 + wr * 64 + fr, col0 = u.pn * 256 + wc * 32 + 8 * fq;
#pragma unroll
        for (int ai = 0; ai < 2; ++ai)
#pragma unroll
            for (int m = 0; m < 4; ++m) { bf16* rowp = O + (size_t)(rb + 8 * (r0 + ai * 128 + m * 16) + r) * D + col0;
#pragma unroll
                for (int bj = 0; bj < 2; ++bj) {
                    if (FP8_OUT2) { const f32x4 v0 = acc[ai][bj][m][0], v1 = acc[ai][bj][m][1];
                        int t0 = __builtin_amdgcn_cvt_pk_fp8_f32(v0[0], v0[1], 0, false); t0 = __builtin_amdgcn_cvt_pk_fp8_f32(v0[2], v0[3], t0, true);
                        int t1 = __builtin_amdgcn_cvt_pk_fp8_f32(v1[0], v1[1], 0, false); t1 = __builtin_amdgcn_cvt_pk_fp8_f32(v1[2], v1[3], t1, true);
                        *(u32x2*)((unsigned char*)O + (size_t)(rb + 8 * (r0 + ai * 128 + m * 16) + r) * D + col0 + bj * 128) = (u32x2){(unsigned)t0, (unsigned)t1}; }
                    else *(u32x4*)(rowp + bj * 128) = pack8(acc[ai][bj][m][0], acc[ai][bj][m][1]); } }
    }
};
struct F2cSched {
    const char* ALC; const char* G2C; int G, c;
    __device__ bool next(int i, Unit& u) const { const int L = i * G + c; if (L >= 16) return false;
        const int b = L >> 2; u.pm = 0; u.pn = L & 3; u.aux = NLAT + b * 256; u.nt = 8;
        u.A = ALC; u.B0 = G2C + ((size_t)b * 1024 + u.pn * 256) * 1024; return true; }
};
struct MoeSched {
    const volatile LAS int* tstart; const char* A; const char* W0; int nct, cstep, G, c;
    __device__ bool next(int i, Unit& u) const { const int L = i * G + c; const int rt = L / nct, ct = L % nct; if (rt >= tstart[16]) return false;
        int e = 0;
#pragma unroll
        for (int k = 1; k < 16; ++k) e += (rt >= tstart[k]) ? 1 : 0;
        e = __builtin_amdgcn_readfirstlane(e);
        u.pm = rt; u.pn = ct; u.aux = 0; u.nt = 8; u.A = A + (size_t)rt * 256 * 1024;
        u.B0 = W0 + (size_t)e * 1048576 + (size_t)ct * cstep; return true; }
};

__device__ __forceinline__ f32x4 mfma16(const bf16x8& a, const bf16x8& b, const f32x4& c) { return __builtin_amdgcn_mfma_f32_16x16x32_bf16(a, b, c, 0, 0, 0); }
__device__ __forceinline__ s16x4 lds_tr(const LAS unsigned char* p) { return __builtin_amdgcn_ds_read_tr16_b64_v4i16((s16x4 LAS*)p); }
__device__ __forceinline__ bf16x8 cat8(const s16x4& a, const s16x4& b) { return (bf16x8){a[0], a[1], a[2], a[3], b[0], b[1], b[2], b[3]}; }
__device__ __forceinline__ bf16x8 pack_acc8(const f32x4& a, const f32x4& b) { const u32x4 u = pack8(a, b); return __builtin_bit_cast(bf16x8, u); }
__device__ __forceinline__ float logsig(float x) { const float e = __expf(-x);
    return -e * (1.f + e * (-0.5f + e * (0.333333343f + e * (-0.25f + e * (0.2f + e * (-0.166666672f + e * (0.142857149f + e * -0.125f))))))); }

constexpr int SG_RS = 144;
template <bool BF8>
__device__ __forceinline__ void small_gemm_ctx(Frame& F, const bf16* A, int lda, const bf16* Bt, int ldb, int K, bf16* X, const float* gate) {
    int tid = tid_of(F.wv); asm volatile("" : "+v"(tid)); const int lane = tid & 63, wave = __builtin_amdgcn_readfirstlane(tid >> 6);
    LAS unsigned char* lds = F.lds;
    for (int t = F.vcu; t < 256; t += F.G) {
        const int tm = t >> 4, tn = t & 15;
        const int pr = tid >> 3, pc = tid & 7;
        const bf16* ag = A + (size_t)(NLAT + 64 * tm + pr) * lda + pc * 8;
        const bf16* bg = Bt + (size_t)(64 * tn + pr) * ldb + pc * 8;
        const unsigned char* bg8 = (const unsigned char*)Bt + (size_t)(64 * tn + pr) * ldb + pc * 8;
        auto ldb_piece = [&](int kt) -> u32x4 {
            if constexpr (BF8) { const u32x2 w = *(const u32x2*)(bg8 + kt * 64); u32x4 o;
                const f32x2 a0 = __builtin_amdgcn_cvt_pk_f32_fp8((int)w.x, false), a1 = __builtin_amdgcn_cvt_pk_f32_fp8((int)w.x, true), a2 = __builtin_amdgcn_cvt_pk_f32_fp8((int)w.y, false), a3 = __builtin_amdgcn_cvt_pk_f32_fp8((int)w.y, true);
                o.x = cvt_pk_bf16(a0.x, a0.y); o.y = cvt_pk_bf16(a1.x, a1.y); o.z = cvt_pk_bf16(a2.x, a2.y); o.w = cvt_pk_bf16(a3.x, a3.y); return o; }
            else return *(const u32x4*)(bg + kt * 64); };
        const int wm = wave >> 1, wn = wave & 1, l15 = lane & 15, quad = lane >> 4;
        f32x4 acc[2] = {(f32x4){0.f, 0.f, 0.f, 0.f}, (f32x4){0.f, 0.f, 0.f, 0.f}};
        const int nk = K / 64;
        u32x4 ra[8], rb[8];
#pragma unroll
        for (int i = 0; i < 8; ++i) { ra[i] = *(const u32x4*)(ag + i * 64); rb[i] = ldb_piece(i); }
        __syncthreads();
        for (int kt0 = 0; kt0 < nk; kt0 += 8) {
#pragma unroll
            for (int i = 0; i < 8; ++i) {
                const int kt = kt0 + i;
                LAS unsigned char* sa = lds + (i & 1) * (2 * 64 * SG_RS); LAS unsigned char* sb = sa + 64 * SG_RS;
                *(LAS u32x4*)(sa + pr * SG_RS + pc * 16) = ra[i]; *(LAS u32x4*)(sb + pr * SG_RS + pc * 16) = rb[i];
                if (kt + 8 < nk) { ra[i] = *(const u32x4*)(ag + (kt + 8) * 64); rb[i] = ldb_piece(kt + 8); }
                __syncthreads();
#pragma unroll
                for (int ks = 0; ks < 2; ++ks) {
                    const bf16x8 af = *(const LAS bf16x8*)(sa + (16 * wm + l15) * SG_RS + (32 * ks + 8 * quad) * 2);
#pragma unroll
                    for (int n = 0; n < 2; ++n) { const bf16x8 bf = *(const LAS bf16x8*)(sb + (32 * wn + 16 * n + l15) * SG_RS + (32 * ks + 8 * quad) * 2);
                        acc[n] = mfma16(bf, af, acc[n]); }
                }
            }
        }
        bf16* xr = X + (size_t)(NLAT + 64 * tm + 16 * wm + l15) * D + 64 * tn + 32 * wn + 4 * quad;
        const float* gp = gate + 64 * tn + 32 * wn + 4 * quad;
#pragma unroll
        for (int n = 0; n < 2; ++n) { const f32x4 gv = *(const f32x4*)(gp + 16 * n) * (BF8 ? pg8::FP8_WSCALE : 1.f); const u32x2 xv = *(const u32x2*)(xr + 16 * n); const f32x4 y = gv * acc[n]; u32x2 o;
            o.x = cvt_pk_bf16(bflo(xv.x) + y[0], bfhi(xv.x) + y[1]); o.y = cvt_pk_bf16(bflo(xv.y) + y[2], bfhi(xv.y) + y[3]); *(u32x2*)(xr + 16 * n) = o; }
    }
    __syncthreads();
}

constexpr int SC_QS = 528, SC_KS = 576, SC_VS = 144, SC_QT = 0, SC_KT = 128 * 528, SC_VT = SC_KT + 128 * 576;
static_assert(SC_VT + 128 * SC_VS <= MISC_OFF, "scan LDS map");
__device__ __forceinline__ int scan_rowbase(int dir, int b, int n) {
    if (dir == 0) return (n < 2) ? NLAT + b * 256 + n * 128 : b * 4096 + (n - 2) * 128;
    return (n < 2) ? NLAT + b * 256 + (1 - n) * 128 : b * 4096 + (33 - n) * 128;
}
__device__ __forceinline__ void p_ret_scan(Frame& F, const Args& a, int j) {
    int tid = tid_of(F.wv); asm volatile("" : "+v"(tid)); const int lane = tid & 63, wave = __builtin_amdgcn_readfirstlane(tid >> 6);
    GAS unsigned char* wsg_ = (GAS unsigned char*)F.ws; asm volatile("" : "+s"(wsg_)); unsigned char* wso = (unsigned char*)wsg_;
    const bf16* Q = (const bf16*)(wso + WS_RQ); const bf16* K = (const bf16*)(wso + WS_RK); const bf16* V = (const bf16*)(wso + WS_RV);
    LAS unsigned char* lds = F.lds;
    for (int u = F.vcu; u < 256; u += F.G) {
        const int dir = u & 1, slice = (u >> 1) & 7, bh = u >> 4, b = bh >> 2, h = bh & 3;
        __syncthreads();
        if (wave >= 4) {
            const int lt = tid - 256;
            const int qr = lt >> 5, qc = lt & 31, vr = lt >> 3, vc = lt & 7; const bool kswz = (qr & 4) != 0;
            const bf16* Qg = Q + (size_t)qr * 1024 + h * 256 + qc * 8;
            const bf16* Kg = K + (size_t)qr * 1024 + h * 256 + qc * 8;
            const bf16* Vg = V + (size_t)vr * 2048 + h * 512 + slice * 64 + vc * 8;
            LAS unsigned char* qd = lds + SC_QT + qr * SC_QS + qc * 16;
            LAS unsigned char* kd = lds + SC_KT + qr * SC_KS + qc * 16;
            LAS unsigned char* vd = lds + SC_VT + vr * SC_VS + vc * 16;
            u32x4 rq[16], rk[16], rv[4];
            { const size_t rb = (size_t)scan_rowbase(dir, b, 0), rb1 = (size_t)scan_rowbase(dir, b, 1);
#pragma unroll
              for (int i = 0; i < 16; ++i) { rq[i] = *(const u32x4*)(Qg + (rb + 8 * i) * 1024); rk[i] = *(const u32x4*)(Kg + (rb + 8 * i) * 1024); }
#pragma unroll
              for (int i = 0; i < 4; ++i) rv[i] = *(const u32x4*)(Vg + (rb + 32 * i) * 2048);
#pragma unroll
              for (int i = 0; i < 16; ++i) *(LAS u32x4*)(qd + i * 8 * SC_QS) = rq[i];
#pragma unroll
              for (int i = 0; i < 16; ++i) rq[i] = *(const u32x4*)(Qg + (rb1 + 8 * i) * 1024); }
            __syncthreads();
            for (int n = 0; n < 34; ++n) {
#pragma unroll
                for (int i = 0; i < 16; ++i) *(LAS u32x4*)(kd + i * 8 * SC_KS) = kswz ? (u32x4){rk[i].z, rk[i].w, rk[i].x, rk[i].y} : rk[i];
#pragma unroll
                for (int i = 0; i < 4; ++i) *(LAS u32x4*)(vd + i * 32 * SC_VS) = rv[i];
                { const size_t rbn = (size_t)scan_rowbase(dir, b, n < 33 ? n + 1 : n);
#pragma unroll
                  for (int i = 0; i < 16; ++i) rk[i] = *(const u32x4*)(Kg + (rbn + 8 * i) * 1024);
#pragma unroll
                  for (int i = 0; i < 4; ++i) rv[i] = *(const u32x4*)(Vg + (rbn + 32 * i) * 2048); }
                __syncthreads();
#pragma unroll
                for (int i = 0; i < 16; ++i) *(LAS u32x4*)(qd + i * 8 * SC_QS) = rq[i];
                { const size_t rbn2 = (size_t)scan_rowbase(dir, b, n < 32 ? n + 2 : n);
#pragma unroll
                  for (int i = 0; i < 16; ++i) rq[i] = *(const u32x4*)(Qg + (rbn2 + 8 * i) * 1024); }
                __syncthreads();
            }
        } else {
            const int w = wave, l15 = lane & 15, quad = lane >> 4, tq = l15 >> 2, tp = l15 & 3;
            bf16* O = (bf16*)(wso + (dir ? WS_ROB : WS_ROF));
            const float lg = logsig(a.in[I_RDEC][(j * 2 + dir) * 4 + h]);
            const float lg2 = lg * 1.44269504f;
            const float cdec = exp2f(128.f * lg2);
            f32x4 S[16];
#pragma unroll
            for (int m = 0; m < 16; ++m) S[m] = (f32x4){0.f, 0.f, 0.f, 0.f};
            __syncthreads();
            for (int n = 0; n < 34; ++n) {
                const size_t rb = (size_t)scan_rowbase(dir, b, n);
                int lane_s = lane; asm volatile("" : "+v"(lane_s)); const int l15s = lane_s & 15, quads = lane_s >> 4;
                {
                    bf16x8 Sf[8];
#pragma unroll
                    for (int s = 0; s < 8; ++s) Sf[s] = pack_acc8(S[2 * s], S[2 * s + 1]);
                    bf16x8 qf[3][8];
                    const LAS unsigned char* qbase = lds + SC_QT + l15 * SC_QS + quad * 16;
#pragma unroll
                    for (int s = 0; s < 8; ++s) { qf[0][s] = *(const LAS bf16x8*)(qbase + s * 64); qf[1][s] = *(const LAS bf16x8*)(qbase + 16 * SC_QS + s * 64); }
#pragma unroll
                    for (int tt = 0; tt < 8; ++tt) {
                        if (tt + 2 < 8) {
#pragma unroll
                            for (int s = 0; s < 8; ++s) qf[(tt + 2) % 3][s] = *(const LAS bf16x8*)(qbase + (16 * (tt + 2)) * SC_QS + s * 64);
                        }
                        __builtin_amdgcn_sched_barrier(0);
                        f32x4 acc0 = (f32x4){0.f, 0.f, 0.f, 0.f}, acc1 = acc0;
#pragma unroll
                        for (int s = 0; s < 8; s += 2) { acc0 = mfma16(Sf[s], qf[tt % 3][s], acc0); acc1 = mfma16(Sf[s + 1], qf[tt % 3][s + 1], acc1); }
                        const int i0 = 16 * tt + l15; const int j0 = 16 * tt + l15s;
                        const float qd0 = __builtin_amdgcn_exp2f(lg2 * (dir == 0 ? (float)(j0 + 1) : (float)(128 - j0)));
#if FP8_RETSTORE
                        { int t8 = __builtin_amdgcn_cvt_pk_fp8_f32((acc0[0] + acc1[0]) * qd0, (acc0[1] + acc1[1]) * qd0, 0, false); t8 = __builtin_amdgcn_cvt_pk_fp8_f32((acc0[2] + acc1[2]) * qd0, (acc0[3] + acc1[3]) * qd0, t8, true);
                          *(int*)((unsigned char*)O + ((rb + i0) * 2048 + h * 512 + slice * 64 + 16 * w + 4 * quad)) = t8; }
#else
                        u32x2 o0; o0.x = cvt_pk_bf16((acc0[0] + acc1[0]) * qd0, (acc0[1] + acc1[1]) * qd0); o0.y = cvt_pk_bf16((acc0[2] + acc1[2]) * qd0, (acc0[3] + acc1[3]) * qd0);
                        *(u32x2*)(O + (rb + i0) * 2048 + h * 512 + slice * 64 + 16 * w + 4 * quad) = o0;
#endif
                        __builtin_amdgcn_sched_barrier(0);
                    }
                }
                __syncthreads();
#pragma unroll
                for (int m = 0; m < 16; ++m) S[m] = S[m] * cdec;
                {
                    const int ksw = (quad & 1) << 3;
                    const LAS unsigned char* kb0 = lds + SC_KT + (4 * quad + tq) * SC_KS + 16 * tp;
                    const LAS unsigned char* vb0 = lds + SC_VT + (4 * quad + tq) * SC_VS + (16 * w + 4 * tp) * 2;
                    s16x4 kf[3][16], vf[4][2];
#pragma unroll
                    for (int s = 0; s < 4; ++s) { vf[s][0] = lds_tr(vb0 + 32 * s * SC_VS); vf[s][1] = lds_tr(vb0 + (32 * s + 16) * SC_VS); }
#define SC_LDK(dst, g) do { const LAS unsigned char* kb_ = kb0 + 32 * ((g) >> 1) * SC_KS + 256 * ((g) & 1); _Pragma("unroll") for (int q_ = 0; q_ < 4; ++q_) { \
        dst[4 * q_ + 0] = lds_tr(kb_ + q_ * 64 + ksw); dst[4 * q_ + 1] = lds_tr(kb_ + q_ * 64 + ksw + 16 * SC_KS); dst[4 * q_ + 2] = lds_tr(kb_ + q_ * 64 + (8 ^ ksw)); dst[4 * q_ + 3] = lds_tr(kb_ + q_ * 64 + (8 ^ ksw) + 16 * SC_KS); } } while (0)
                    SC_LDK(kf[0], 0); SC_LDK(kf[1], 1);
                    bf16x8 Bv = (bf16x8){0, 0, 0, 0, 0, 0, 0, 0};
#pragma unroll
                    for (int g = 0; g < 8; ++g) {
                        if (g + 2 < 8) SC_LDK(kf[(g + 2) % 3], g + 2);
                        __builtin_amdgcn_sched_barrier(0);
                        if ((g & 1) == 0) {
                            const int s = g >> 1; float vs[8];
#pragma unroll
                            for (int e = 0; e < 4; ++e) { const int t0 = 32 * s + 4 * quads + e, t1 = t0 + 16;
                                const float k0 = __builtin_amdgcn_exp2f(lg2 * (dir == 0 ? (float)(127 - t0) : (float)t0)), k1 = __builtin_amdgcn_exp2f(lg2 * (dir == 0 ? (float)(127 - t1) : (float)t1));
                                vs[e] = bf2f((unsigned short)vf[s][0][e]) * k0; vs[4 + e] = bf2f((unsigned short)vf[s][1][e]) * k1; }
                            u32x4 vb; vb.x = cvt_pk_bf16(vs[0], vs[1]); vb.y = cvt_pk_bf16(vs[2], vs[3]); vb.z = cvt_pk_bf16(vs[4], vs[5]); vb.w = cvt_pk_bf16(vs[6], vs[7]);
                            Bv = __builtin_bit_cast(bf16x8, vb);
                        }
#pragma unroll
                        for (int q = 0; q < 4; ++q) { const int sp = 4 * (g & 1) + q;
                            S[2 * sp] = mfma16(cat8(kf[g % 3][4 * q + 0], kf[g % 3][4 * q + 1]), Bv, S[2 * sp]); S[2 * sp + 1] = mfma16(cat8(kf[g % 3][4 * q + 2], kf[g % 3][4 * q + 3]), Bv, S[2 * sp + 1]); }
                        __builtin_amdgcn_sched_barrier(0);
                    }
#undef SC_LDK
                }
                __syncthreads();
            }
        }
    }
    __syncthreads();
}

constexpr int IN_KS = 544, IN_VQ = 128 * 288, IN_VS = 288;
__device__ __forceinline__ int intra_rowbase(int nchunks, int u) {
    const int bh = u / nchunks, cn = u % nchunks, b = bh >> 2;
    if (nchunks == 34) return (cn < 2) ? NLAT + b * 256 + cn * 128 : b * 4096 + (cn - 2) * 128;
    return b * 4096 + cn * 128;
}
#if FP8_RETSTORE
typedef u32x2 RPiece;
__device__ __forceinline__ void rp_unpack(const RPiece& p, float (&v)[8]) { const f32x2 a0 = __builtin_amdgcn_cvt_pk_f32_fp8((int)p.x, false), a1 = __builtin_amdgcn_cvt_pk_f32_fp8((int)p.x, true), a2 = __builtin_amdgcn_cvt_pk_f32_fp8((int)p.y, false), a3 = __builtin_amdgcn_cvt_pk_f32_fp8((int)p.y, true);
    v[0] = a0.x; v[1] = a0.y; v[2] = a1.x; v[3] = a1.y; v[4] = a2.x; v[5] = a2.y; v[6] = a3.x; v[7] = a3.y; }
#define RP_OFF(bytes_bf16) ((bytes_bf16) >> 1)
#else
typedef u32x4 RPiece;
__device__ __forceinline__ void rp_unpack(const RPiece& p, float (&v)[8]) { v[0] = bflo(p.x); v[1] = bfhi(p.x); v[2] = bflo(p.y); v[3] = bfhi(p.y); v[4] = bflo(p.z); v[5] = bfhi(p.z); v[6] = bflo(p.w); v[7] = bfhi(p.w); }
#define RP_OFF(bytes_bf16) (bytes_bf16)
#endif
__device__ __forceinline__ void p_ret_intra(Frame& F, const Args& a, int j, int nchunks) {
    int tid0 = tid_of(F.wv); asm volatile("" : "+v"(tid0)); const int wave = __builtin_amdgcn_readfirstlane(tid0 >> 6);
    GAS unsigned char* wsg_ = (GAS unsigned char*)F.ws; asm volatile("" : "+s"(wsg_)); unsigned char* wso = (unsigned char*)wsg_;
    const bf16* Q = (const bf16*)(wso + WS_RQ); const bf16* K = (const bf16*)(wso + WS_RK); const bf16* V = (const bf16*)(wso + WS_RV);
    const bf16* OF = (const bf16*)(wso + WS_ROF); const bf16* OB = (const bf16*)(wso + WS_ROB); const bf16* Gt = (const bf16*)(wso + WS_RG); bf16* OG = (bf16*)(wso + WS_ROG);
    const int w = wave;
    int vcu = F.vcu; asm volatile("" : "+s"(vcu));
    LAS unsigned char* lds = F.lds;
    const int nunits = 16 * nchunks;
    u32x4 rk[8];
    if (vcu < nunits) { const int rb0 = intra_rowbase(nchunks, vcu), h0 = (vcu / nchunks) & 3;
#pragma unroll
        for (int i = 0; i < 8; ++i) rk[i] = *(const u32x4*)(K + (size_t)(rb0 + (tid0 >> 5) + 16 * i) * 1024 + h0 * 256 + (tid0 & 31) * 8); }
    for (int u = vcu; u < nunits; u += F.G) {
        int tid_o = tid_of(F.wv); asm volatile("" : "+v"(tid_o));
        const int tid = tid_o, lane_o = tid_o & 63;
        const int l15 = lane_o & 15, quad = lane_o >> 4, tq = l15 >> 2, tp = l15 & 3;
        const int h = (u / nchunks) & 3;
        const int rowbase = intra_rowbase(nchunks, u);
        const float lgf = logsig(a.in[I_RDEC][(j * 2 + 0) * 4 + h]) * 1.44269504f, lgb = logsig(a.in[I_RDEC][(j * 2 + 1) * 4 + h]) * 1.44269504f;
        __syncthreads();
#pragma unroll
        for (int i = 0; i < 8; ++i) *(LAS u32x4*)(lds + ((tid >> 5) + 16 * i) * IN_KS + (tid & 31) * 16) = rk[i];
        bf16x8 Bq[8];
#pragma unroll
        for (int s = 0; s < 8; ++s) Bq[s] = *(const bf16x8*)(Q + (size_t)(rowbase + 16 * w + l15) * 1024 + h * 256 + 32 * s + 8 * quad);
        u32x4 rv[16];
#pragma unroll
        for (int i = 0; i < 16; ++i) rv[i] = *(const u32x4*)(V + (size_t)(rowbase + (tid >> 6) + 8 * i) * 2048 + h * 512 + (tid & 63) * 8);
        __syncthreads();
        bf16x8 Pf[4];
        {
            f32x4 sc[8];
#pragma unroll
            for (int kt = 0; kt < 8; ++kt) { sc[kt] = (f32x4){0.f, 0.f, 0.f, 0.f};
#pragma unroll
                for (int s = 0; s < 8; ++s) { const bf16x8 A = *(const LAS bf16x8*)(lds + (16 * kt + l15) * IN_KS + (32 * s + 8 * quad) * 2); sc[kt] = mfma16(A, Bq[s], sc[kt]); } }
            const int qi = 16 * w + l15;
#pragma unroll
            for (int kt = 0; kt < 8; ++kt)
#pragma unroll
                for (int e = 0; e < 4; ++e) { const int kj = 16 * kt + 4 * quad + e; const int d = qi - kj;
                    const float mk = (d == 0) ? 2.f : exp2f((d > 0 ? lgf : lgb) * fabsf((float)d)); sc[kt][e] *= mk; }
#pragma unroll
            for (int s2 = 0; s2 < 4; ++s2) Pf[s2] = pack_acc8(sc[2 * s2], sc[2 * s2 + 1]);
        }
        __syncthreads();
#pragma unroll
        for (int i = 0; i < 16; ++i) { const int row = (tid >> 6) + 8 * i, c16 = tid & 63;
            *(LAS u32x4*)(lds + (c16 >> 4) * IN_VQ + row * IN_VS + (c16 & 15) * 16) = rv[i]; }
        const unsigned ro = ((unsigned)(rowbase + 16 * w + l15) * 2048u + (unsigned)(h * 512 + 8 * quad)) * 2u;
#define ROW16(base, el) (*(const RPiece*)((const char*)(base) + (RP_OFF(ro + (unsigned)(el) * 2u) + (unsigned)dep)))
        RPiece pf[6], pb[6];
#pragma unroll
        for (int kp = 0; kp < 4; ++kp) { pf[kp] = *(const RPiece*)((const char*)OF + RP_OFF(ro + 64u * kp)); pb[kp] = *(const RPiece*)((const char*)OB + RP_OFF(ro + 64u * kp)); }
        __syncthreads();
        __builtin_amdgcn_sched_barrier(0);
        f32x4 o[32];
#pragma unroll
        for (int mt = 0; mt < 32; ++mt) {
            o[mt] = (f32x4){0.f, 0.f, 0.f, 0.f};
            const int kp = mt >> 1;
            const LAS unsigned char* vb = lds + (kp >> 2) * IN_VQ + (32 * (kp & 3) + 8 * tp + 4 * (mt & 1)) * 2;
#pragma unroll
            for (int s2 = 0; s2 < 4; ++s2) { const int r0 = 32 * s2 + 4 * quad + tq;
                const s16x4 v0 = lds_tr(vb + r0 * IN_VS), v1 = lds_tr(vb + (r0 + 16) * IN_VS);
                o[mt] = mfma16(cat8(v0, v1), Pf[s2], o[mt]); }
            if ((mt & 1) == 1) __builtin_amdgcn_sched_barrier(0);
        }
        int dep = 0; asm volatile("" : "+v"(dep), "+v"(o[31][3]));
        float sum = 0.f;
#pragma unroll
        for (int bt = 0; bt < 3; ++bt) {
            const int p0 = bt == 0 ? 0 : (bt == 1 ? 4 : 10), np = bt == 0 ? 4 : 6;
            if (bt > 0) {
                asm volatile("" : "+v"(dep), "+v"(sum));
#pragma unroll
                for (int kp = 0; kp < 6; ++kp) { pf[kp] = ROW16(OF, 32 * (p0 + kp)); pb[kp] = ROW16(OB, 32 * (p0 + kp)); }
            }
#pragma unroll
            for (int kp = 0; kp < 6; ++kp) { if (kp >= np) continue; const int m0 = 2 * (p0 + kp), m1 = m0 + 1; float f[8], bk[8]; rp_unpack(pf[kp], f); rp_unpack(pb[kp], bk);
                o[m0][0] += f[0] + bk[0]; o[m0][1] += f[1] + bk[1]; o[m0][2] += f[2] + bk[2]; o[m0][3] += f[3] + bk[3];
                o[m1][0] += f[4] + bk[4]; o[m1][1] += f[5] + bk[5]; o[m1][2] += f[6] + bk[6]; o[m1][3] += f[7] + bk[7];
                sum += ((o[m0][0] + o[m0][1]) + (o[m0][2] + o[m0][3])) + ((o[m1][0] + o[m1][1]) + (o[m1][2] + o[m1][3])); }
        }
        asm volatile("" : "+v"(dep), "+v"(sum));
        RPiece gg[8];
#pragma unroll
        for (int kp = 0; kp < 8; ++kp) gg[kp] = ROW16(Gt, 32 * kp);
        sum += shx(sum, 16, lane_o); sum += shx(sum, 32, lane_o);
        const float mu = sum * (1.f / 512.f);
        float sq = 0.f;
#pragma unroll
        for (int mt = 0; mt < 32; ++mt) { o[mt] = o[mt] - mu; sq += (o[mt][0] * o[mt][0] + o[mt][1] * o[mt][1]) + (o[mt][2] * o[mt][2] + o[mt][3] * o[mt][3]); }
        sq += shx(sq, 16, lane_o); sq += shx(sq, 32, lane_o);
        const float rstd = rsqrtf(sq * (1.f / 512.f) + EPS);
        const float* gn = a.in[I_RGN] + j * 2048 + h * 512 + 8 * quad;
#pragma unroll
        for (int hb = 0; hb < 2; ++hb) {
            if (hb == 1) {
#pragma unroll
                for (int kp = 0; kp < 8; ++kp) gg[kp] = ROW16(Gt, 32 * (8 + kp));
                { const int un = (u + F.G < nunits) ? u + F.G : u; const int rbn = intra_rowbase(nchunks, un), hn = (un / nchunks) & 3;
#pragma unroll
                    for (int i = 0; i < 8; ++i) rk[i] = *(const u32x4*)(K + (size_t)(rbn + (tid >> 5) + 16 * i) * 1024 + hn * 256 + (tid & 31) * 8 + dep); }
            }
#pragma unroll
            for (int kp = 0; kp < 8; ++kp) { const int m0 = 2 * (8 * hb + kp), m1 = m0 + 1; float gf[8]; rp_unpack(gg[kp], gf);
                const f32x4 w0 = *(const f32x4*)(gn + 32 * (8 * hb + kp)), w1 = *(const f32x4*)(gn + 32 * (8 * hb + kp) + 4);
                u32x4 r;
                if (FP8_OUTPROJ && rowbase < NLAT) {
                    const float v0 = o[m0][0] * rstd * w0[0] * silu_f(gf[0]), v1 = o[m0][1] * rstd * w0[1] * silu_f(gf[1]), v2 = o[m0][2] * rstd * w0[2] * silu_f(gf[2]), v3 = o[m0][3] * rstd * w0[3] * silu_f(gf[3]);
                    const float v4 = o[m1][0] * rstd * w1[0] * silu_f(gf[4]), v5 = o[m1][1] * rstd * w1[1] * silu_f(gf[5]), v6 = o[m1][2] * rstd * w1[2] * silu_f(gf[6]), v7 = o[m1][3] * rstd * w1[3] * silu_f(gf[7]);
                    int t0 = __builtin_amdgcn_cvt_pk_fp8_f32(v0, v1, 0, false); t0 = __builtin_amdgcn_cvt_pk_fp8_f32(v2, v3, t0, true);
                    int t1 = __builtin_amdgcn_cvt_pk_fp8_f32(v4, v5, 0, false); t1 = __builtin_amdgcn_cvt_pk_fp8_f32(v6, v7, t1, true);
                    *(u32x2*)((char*)OG + ((ro >> 1) + 32u * (8 * hb + kp))) = (u32x2){(unsigned)t0, (unsigned)t1}; r.w = (unsigned)t1;
                } else {
                r.x = cvt_pk_bf16(o[m0][0] * rstd * w0[0] * silu_f(gf[0]), o[m0][1] * rstd * w0[1] * silu_f(gf[1]));
                r.y = cvt_pk_bf16(o[m0][2] * rstd * w0[2] * silu_f(gf[2]), o[m0][3] * rstd * w0[3] * silu_f(gf[3]));
                r.z = cvt_pk_bf16(o[m1][0] * rstd * w1[0] * silu_f(gf[4]), o[m1][1] * rstd * w1[1] * silu_f(gf[5]));
                r.w = cvt_pk_bf16(o[m1][2] * rstd * w1[2] * silu_f(gf[6]), o[m1][3] * rstd * w1[3] * silu_f(gf[7]));
                *(u32x4*)((char*)OG + (FP8_OUTPROJ ? (size_t)36 * MiB - (size_t)NLAT * 4096 : (size_t)0) + (ro + 64u * (8 * hb + kp))) = r; }
                if (kp == 7) asm volatile("" : "+v"(dep), "+v"(r.w)); }
        }
    }
#undef ROW16
    __syncthreads();
}

constexpr int NA_VS = 144, NA_CTX = 576 * 144, NA_RPB = 832 * 144;
struct NaUnit { int b, h, r0, rsu, band; size_t ctxrow; };
__device__ __forceinline__ NaUnit na_unit(int u) {
    NaUnit n;
    if (u < 2048) { n.b = u >> 9; const int rem = u & 511; n.h = rem & 15; n.r0 = 2 * (rem >> 4); n.rsu = min(max(n.r0 - 4, 0), 56); n.band = 1; }
    else { const int uc = u - 2048; n.b = uc >> 5; n.h = (uc >> 1) & 15; n.r0 = (uc & 1) * 128; n.rsu = 0; n.band = 0; }
    n.ctxrow = (size_t)(NLAT + n.b * 256);
    return n;
}
__device__ __forceinline__ void na_load_img(const bf16* T, const NaUnit& n, int tid, u32x4 (&r)[13]) {
    const int c8 = tid & 7, k0 = tid >> 3;
    if (n.band) {
#pragma unroll
        for (int i = 0; i < 9; ++i) { const int kb = k0 + 64 * i; const int tok = min((n.rsu + i) * 64 + k0, 4095);
            r[i] = *(const u32x4*)(T + (size_t)(n.b * 4096 + tok) * 1024 + n.h * 64 + c8 * 8); (void)kb; }
    }
#pragma unroll
    for (int i = 0; i < 4; ++i) r[9 + i] = *(const u32x4*)(T + (n.ctxrow + k0 + 64 * i) * 1024 + n.h * 64 + c8 * 8);
}
__device__ __forceinline__ void na_store_img(LAS unsigned char* lds, const NaUnit& n, int tid, const u32x4 (&r)[13]) {
    const int c8 = tid & 7, k0 = tid >> 3;
    if (n.band) {
#pragma unroll
        for (int i = 0; i < 9; ++i) *(LAS u32x4*)(lds + (k0 + 64 * i) * NA_VS + c8 * 16) = r[i];
    }
#pragma unroll
    for (int i = 0; i < 4; ++i) *(LAS u32x4*)(lds + NA_CTX + (k0 + 64 * i) * NA_VS + c8 * 16) = r[9 + i];
}
__device__ __forceinline__ void p_na_attn(Frame& F, const Args& a) {
    int tid0 = tid_of(F.wv); asm volatile("" : "+v"(tid0)); const int wave = __builtin_amdgcn_readfirstlane(tid0 >> 6);
    GAS unsigned char* wsg_ = (GAS unsigned char*)F.ws; asm volatile("" : "+s"(wsg_)); unsigned char* wso = (unsigned char*)wsg_;
    const bf16* Q = (const bf16*)(wso + WS_NQ); const bf16* K = (const bf16*)(wso + WS_NK); const bf16* V = (const bf16*)(wso + WS_NV); bf16* O = (bf16*)(wso + WS_NO);
    const int w = wave;
    int vcu = F.vcu; asm volatile("" : "+s"(vcu));
    LAS unsigned char* lds = F.lds;
    constexpr int NU = 2048 + 128;
    u32x4 rimg[13];
    bf16x8 Bq0n = (bf16x8){0, 0, 0, 0, 0, 0, 0, 0}, Bq1n = Bq0n;
    auto qrow_of = [&](const NaUnit& n, int lane_o) -> size_t { const int l15 = lane_o & 15; const bool band = n.band != 0;
        const int r = band ? n.r0 + (w >> 2) : 0, jb = w & 3;
        return band ? (size_t)(n.b * 4096 + r * 64 + 16 * jb + l15) * 1024 + n.h * 64 : (n.ctxrow + n.r0 + 16 * w + l15) * 1024 + n.h * 64; };
    if (vcu < NU) { const NaUnit n0 = na_unit(vcu); na_load_img(K, n0, tid0, rimg);
        const size_t q0 = qrow_of(n0, tid0 & 63); Bq0n = *(const bf16x8*)(Q + q0 + 8 * ((tid0 & 63) >> 4)); Bq1n = *(const bf16x8*)(Q + q0 + 32 + 8 * ((tid0 & 63) >> 4)); }
    int hcur = -1;
    for (int u = vcu; u < NU; u += F.G) {
        int tid_o = tid_of(F.wv); asm volatile("" : "+v"(tid_o));
        const int tid = tid_o, lane_o = tid_o & 63;
        const int l15 = lane_o & 15, quad = lane_o >> 4, tq = l15 >> 2, tp = l15 & 3;
        const NaUnit n = na_unit(u);
        const bool band = n.band != 0;
        const int r = band ? n.r0 + (w >> 2) : 0, jb = w & 3, rs = min(max(r - 4, 0), 56);
        const int cb = band ? min(max(16 * jb - 8, 0), 32) : 0;
        const size_t qrow = qrow_of(n, lane_o);
        const bf16x8 Bq0 = Bq0n, Bq1 = Bq1n;
        __syncthreads();
        na_store_img(lds, n, tid, rimg);
        if (band && n.h != hcur) { hcur = n.h; if (tid < 465) ((LAS float*)(lds + NA_RPB))[tid] = a.in[I_NARPB][n.h * 465 + tid]; }
        na_load_img(V, n, tid, rimg);
        __syncthreads();
        constexpr float LOG2E = 1.44269504f;
        bf16x8 Pf[16];
        float m1 = -1e30f, sum1 = 0.f, m2 = -1e30f, sum2 = 0.f;
        if (band) {
            f32x4 sc[16];
#pragma unroll
            for (int t = 0; t < 16; ++t) { const int kk = 16 * t + l15, krow = kk >> 5, kc = kk & 31;
                const LAS unsigned char* kp = lds + ((rs - n.rsu + krow) * 64 + cb + kc) * NA_VS + quad * 16;
                const bf16x8 k0 = *(const LAS bf16x8*)kp, k1 = *(const LAS bf16x8*)(kp + 64);
                f32x4 acc = (f32x4){0.f, 0.f, 0.f, 0.f}; acc = mfma16(k0, Bq0, acc); acc = mfma16(k1, Bq1, acc); sc[t] = acc; }
            const LAS float* rpb = (const LAS float*)(lds + NA_RPB);
            const int qcol = 16 * jb + l15, cstart = min(max(qcol - 8, 0), 48);
            const int rel0 = cb + 4 * quad - qcol;
            const int drb = (rs - r + 7) * 31 + 15;
#pragma unroll
            for (int t = 0; t < 16; ++t)
#pragma unroll
                for (int e = 0; e < 4; ++e) { const int rel = rel0 + (t & 1) * 16 + e;
                    const int kcol = rel + qcol; const bool valid = (kcol >= cstart) && (kcol < cstart + 16);
                    const int idx = drb + (t >> 1) * 31 + min(max(rel, -15), 15);
                    const float v = valid ? sc[t][e] + rpb[idx] : -1e30f; sc[t][e] = v; m1 = fmaxf(m1, v); }
            m1 = fmaxf(m1, shx(m1, 16, lane_o)); m1 = fmaxf(m1, shx(m1, 32, lane_o));
            const float m1l = m1 * LOG2E;
#pragma unroll
            for (int s2 = 0; s2 < 8; ++s2) { f32x4 p0, p1;
#pragma unroll
                for (int e = 0; e < 4; ++e) { p0[e] = __builtin_amdgcn_exp2f(sc[2 * s2][e] * LOG2E - m1l); p1[e] = __builtin_amdgcn_exp2f(sc[2 * s2 + 1][e] * LOG2E - m1l); }
                sum1 += (p0[0] + p0[1]) + (p0[2] + p0[3]) + (p1[0] + p1[1]) + (p1[2] + p1[3]);
                Pf[s2] = pack_acc8(p0, p1); }
        } else {
#pragma unroll
            for (int s2 = 0; s2 < 8; ++s2) Pf[s2] = (bf16x8){0, 0, 0, 0, 0, 0, 0, 0};
        }
        {
            f32x4 sc[16];
#pragma unroll
            for (int t = 0; t < 16; ++t) { const LAS unsigned char* kp = lds + NA_CTX + (16 * t + l15) * NA_VS + quad * 16;
                const bf16x8 k0 = *(const LAS bf16x8*)kp, k1 = *(const LAS bf16x8*)(kp + 64);
                f32x4 acc = (f32x4){0.f, 0.f, 0.f, 0.f}; acc = mfma16(k0, Bq0, acc); acc = mfma16(k1, Bq1, acc); sc[t] = acc; }
#pragma unroll
            for (int t = 0; t < 16; ++t)
#pragma unroll
                for (int e = 0; e < 4; ++e) m2 = fmaxf(m2, sc[t][e]);
            m2 = fmaxf(m2, shx(m2, 16, lane_o)); m2 = fmaxf(m2, shx(m2, 32, lane_o));
            const float m2l = m2 * LOG2E;
#pragma unroll
            for (int s2 = 0; s2 < 8; ++s2) { f32x4 p0, p1;
#pragma unroll
                for (int e = 0; e < 4; ++e) { p0[e] = __builtin_amdgcn_exp2f(sc[2 * s2][e] * LOG2E - m2l); p1[e] = __builtin_amdgcn_exp2f(sc[2 * s2 + 1][e] * LOG2E - m2l); }
                sum2 += (p0[0] + p0[1]) + (p0[2] + p0[3]) + (p1[0] + p1[1]) + (p1[2] + p1[3]);
                Pf[8 + s2] = pack_acc8(p0, p1); }
        }
        sum1 += shx(sum1, 16, lane_o); sum1 += shx(sum1, 32, lane_o);
        sum2 += shx(sum2, 16, lane_o); sum2 += shx(sum2, 32, lane_o);
        const float mm = fmaxf(m1, m2);
        const float a1 = __builtin_amdgcn_exp2f((m1 - mm) * LOG2E), a2 = __builtin_amdgcn_exp2f((m2 - mm) * LOG2E);
        const float inv = 1.f / (sum1 * a1 + sum2 * a2);
        const float f1 = a1 * inv, f2 = a2 * inv;
        __syncthreads();
        na_store_img(lds, n, tid, rimg);
        { const int un = (u + F.G < NU) ? u + F.G : u; const NaUnit nn = na_unit(un); na_load_img(K, nn, tid, rimg);
          const size_t qn = qrow_of(nn, lane_o); Bq0n = *(const bf16x8*)(Q + qn + 8 * quad); Bq1n = *(const bf16x8*)(Q + qn + 32 + 8 * quad); }
        __syncthreads();
        f32x4 o[4], oc[4];
#pragma unroll
        for (int dt = 0; dt < 4; ++dt) { o[dt] = (f32x4){0.f, 0.f, 0.f, 0.f}; oc[dt] = (f32x4){0.f, 0.f, 0.f, 0.f}; }
        if (band) {
#pragma unroll
            for (int s2 = 0; s2 < 8; ++s2) {
                const LAS unsigned char* vp = lds + ((rs - n.rsu + s2) * 64 + cb + 4 * quad + tq) * NA_VS + 8 * tp;
#pragma unroll
                for (int dt = 0; dt < 4; ++dt) { const s16x4 v0 = lds_tr(vp + dt * 32), v1 = lds_tr(vp + 16 * NA_VS + dt * 32); o[dt] = mfma16(cat8(v0, v1), Pf[s2], o[dt]); } }
        }
#pragma unroll
        for (int s2 = 0; s2 < 8; ++s2) {
            const LAS unsigned char* vp = lds + NA_CTX + (32 * s2 + 4 * quad + tq) * NA_VS + 8 * tp;
#pragma unroll
            for (int dt = 0; dt < 4; ++dt) { const s16x4 v0 = lds_tr(vp + dt * 32), v1 = lds_tr(vp + 16 * NA_VS + dt * 32); oc[dt] = mfma16(cat8(v0, v1), Pf[8 + s2], oc[dt]); } }
#pragma unroll
        for (int dt = 0; dt < 4; ++dt) { const float y0 = o[dt][0] * f1 + oc[dt][0] * f2, y1 = o[dt][1] * f1 + oc[dt][1] * f2, y2 = o[dt][2] * f1 + oc[dt][2] * f2, y3 = o[dt][3] * f1 + oc[dt][3] * f2;
            if (FP8_OUT2 && band) { int t8 = __builtin_amdgcn_cvt_pk_fp8_f32(y0, y1, 0, false); t8 = __builtin_amdgcn_cvt_pk_fp8_f32(y2, y3, t8, true);
                *(int*)((unsigned char*)O + qrow + 16 * dt + 4 * quad) = t8; }
            else { u32x2 ov; ov.x = cvt_pk_bf16(y0, y1); ov.y = cvt_pk_bf16(y2, y3);
                *(u32x2*)((unsigned char*)O + (FP8_OUT2 ? CTX_SIDE - (size_t)NLAT * 2048 : (size_t)0) + 2 * (qrow + 16 * dt + 4 * quad)) = ov; } }
    }
    __syncthreads();
}

constexpr int NPHASES = 1 + 9 + 8 + 8 + 9 + 1;
#ifndef EN_MASK
#define EN_MASK 0xFFFF
#endif
#define EN(b) ((EN_MASK >> (b)) & 1)

__global__ void __launch_bounds__(512, 2) fwd_kernel(Args args) {
    extern __shared__ __attribute__((aligned(16))) unsigned char lds_raw[];
    Frame F;
    F.lds = (LAS unsigned char*)lds_raw;
    F.MISC = (volatile LAS unsigned*)(F.lds + MISC_OFF);
    const int tid = threadIdx.x;
    F.wv = __builtin_amdgcn_readfirstlane(tid >> 6);
    F.G = gridDim.x; { const int bx = blockIdx.x; F.vcu = (F.G % 8 == 0) ? (bx % 8) * (F.G / 8) + bx / 8 : bx; }
    F.ws = args.ws;
    if (tid < 256) F.MISC[tid] = 0u;
    __syncthreads();
    const int lo = args.ph_lo, hi = args.ph_hi;
    XcdBarrier bar; bar.bar = (unsigned*)(F.ws + WS_CTL); bar.x = 0; bar.st = F.MISC + 8;
    if (hi - lo > 1) bar = xcd_barrier_post((unsigned*)(F.ws + WS_CTL), F.MISC + 8);
    int ph = 0, need = BG_NEED_RIN0; bool bg_on = true;
#define PH_BEGIN if (ph >= lo && ph < hi) { GAS unsigned char* wsg_ = (GAS unsigned char*)F.ws; asm volatile("" : "+s"(wsg_)); unsigned char* wso = (unsigned char*)wsg_; bf16* WB = (bf16*)(wso + WS_W); (void)WB;
#define PH_END_BG(busy_expr) if (bg_on) { __syncthreads(); int t_ = tid_of(F.wv); asm volatile("" : "+v"(t_)); const bool bz_ = (busy_expr); if (bz_ && t_ == 0) bg_signal(wso, ph); \
        bg_work(args, wso, F.lds, F.MISC, __builtin_amdgcn_readfirstlane(t_ >> 6), t_ & 63, ph, bz_, need); } if (ph + 1 < hi) xcd_barrier(bar, F.wv); } ++ph;
#define PH_END PH_END_BG(true)
#define CNT_BUSY(nunits, c) ((((nunits) - (c) + F.G - 1) / F.G) == (((nunits) + F.G - 1) / F.G) && (c) < (nunits))
    const int cid = (int)blockIdx.x;

    PH_BEGIN for (int rep_ = 0; rep_ < NREP(0); ++rep_) { if (rep_) xcd_barrier(bar, F.wv); if (EN(0)) p_prologue(F, args); } PH_END

    for (int layer = 0; layer < NLAYER; ++layer) {
        const int kind = layer % 3, j = layer / 3;
        const bool need_ctx = layer < NLAYER - 1;
        const int mrows = need_ctx ? NTOK : NLAT;
        bg_on = (layer == 0);
        if (layer == 2) { need = BG_NEED_NQKV; bg_on = true; } if (layer == 3) { need = BG_NEED_RIN1; bg_on = true; }
        PH_BEGIN for (int rep_ = 0; rep_ < NREP(1); ++rep_) { if (rep_) xcd_barrier(bar, F.wv); if (EN(1)) { if (layer == 0) p_pre<0>(F, args, layer); else p_pre<1>(F, args, layer); } } PH_END
        bg_on = (layer == 0);
        if (kind == 0) {
            PH_BEGIN for (int rep_ = 0; rep_ < NREP(2); ++rep_) { if (rep_) xcd_barrier(bar, F.wv); if (EN(2)) {
                pg8::StaticSched S; S.init(wso + WS_ACT, WB + WE_RIN + (size_t)j * 6144 * 1024, NTOK, 6144, FP8_INPROJ ? 512 : 1024, FP8_INPROJ ? 512 : 1024, FP8_INPROJ ? 512 : 1024, F.G, cid);
                LAS unsigned* ropel = (LAS unsigned*)(F.lds + pg8::STAGE_BYTES);
                { int t_o = tid_of(F.wv); asm volatile("" : "+v"(t_o)); typedef _Float16 h2 __attribute__((ext_vector_type(2)));
                  for (int i = t_o; i < 64 * 64; i += 512) { const f32x2 v = ((const f32x2*)(wso + WS_ROPE))[i]; const h2 hv = (h2){(_Float16)v.x, (_Float16)v.y}; ropel[i] = __builtin_bit_cast(unsigned, hv); } }
                __syncthreads();
                EpiRetIn E{(bf16*)(wso + WS_RQ), (bf16*)(wso + WS_RK), (bf16*)(wso + WS_RV), (bf16*)(wso + WS_RG), ropel};
                if (FP8_INPROJ) pg8::gemm_phase<EpiRetIn, pg8::StaticSched, true, true>(F.lds, S, E, 1024, 1024, (size_t)128 * 1024, F.wv);
                else pg8::gemm_phase<EpiRetIn, pg8::StaticSched, true>(F.lds, S, E, 2048, 2048, (size_t)128 * 2048, F.wv);
            } } PH_END_BG(CNT_BUSY(68 * 24, cid))
            PH_BEGIN for (int rep_ = 0; rep_ < NREP(3); ++rep_) { if (rep_) xcd_barrier(bar, F.wv); if (EN(3)) p_ret_scan(F, args, j); } PH_END
            need = (j == 0) ? BG_NEED_ROUT0 : BG_NEED_ROUT1; bg_on = true;
            PH_BEGIN for (int rep_ = 0; rep_ < NREP(4); ++rep_) { if (rep_) xcd_barrier(bar, F.wv); if (EN(4)) p_ret_intra(F, args, j, need_ctx ? 34 : 32); } PH_END_BG(CNT_BUSY(16 * (need_ctx ? 34 : 32), F.vcu))
            bg_on = (layer == 0);
            PH_BEGIN for (int rep_ = 0; rep_ < NREP(5); ++rep_) { if (rep_) xcd_barrier(bar, F.wv); if (EN(5)) {
                pg8::StaticSched S; S.init(wso + WS_ROG, WB + WE_ROUT + (size_t)j * 1024 * 2048, NLAT, 1024, FP8_OUTPROJ ? 1024 : 2048, FP8_OUTPROJ ? 1024 : 2048, FP8_OUTPROJ ? 1024 : 2048, F.G, cid);
                EpiResid E{(bf16*)(wso + WS_XALL), wso, layer, 2, FP8_OUTPROJ ? pg8::FP8_WSCALE : 1.f};
                if (FP8_OUTPROJ) pg8::gemm_phase<EpiResid, pg8::StaticSched, true, true>(F.lds, S, E, 2048, 2048, (size_t)128 * 2048, F.wv);
                else pg8::gemm_phase<EpiResid, pg8::StaticSched, true>(F.lds, S, E, 4096, 4096, (size_t)128 * 4096, F.wv);
                if (need_ctx) small_gemm_ctx<FP8_OUTPROJ != 0>(F, (const bf16*)(wso + WS_ROG + (FP8_OUTPROJ ? (size_t)36 * MiB - (size_t)NLAT * 4096 : (size_t)0)), 2048, WB + WE_ROUT + (size_t)j * 1024 * 2048, 2048, 2048, (bf16*)(wso + WS_XALL), modv(wso, layer, 4, 2));
            } } PH_END
        } else if (kind == 1) {
            PH_BEGIN for (int rep_ = 0; rep_ < NREP(6); ++rep_) { if (rep_) xcd_barrier(bar, F.wv); if (EN(6)) {
                { F1nSched S{(const char*)(wso + WS_A1N), (const char*)(wso + WS_ACT), F.G, F.vcu};
                  EpiF1n E{(bf16*)(wso + WS_G2)};
                  pg8::gemm_phase<EpiF1n, F1nSched, true>(F.lds, S, E, 512, 2048, (size_t)1024 * 2048, F.wv); }
                { F1Sched S{(const char*)(wso + WS_A1), (const char*)(wso + WS_ACT), F.G, F.vcu};
                  EpiF1 E{(bf16*)(wso + WS_G2), (bf16*)(wso + WS_G2C)};
                  pg8::gemm_phase<EpiF1, F1Sched, true>(F.lds, S, E, 512, 2048, (size_t)128 * 2048, F.wv); }
            } } PH_END_BG(CNT_BUSY(544, F.vcu))
            need = BG_NEED_FN; bg_on = true;
            PH_BEGIN for (int rep_ = 0; rep_ < NREP(7); ++rep_) { if (rep_) xcd_barrier(bar, F.wv); if (EN(7)) {
                { F2Sched S{(const char*)(wso + WS_AL), (const char*)(wso + WS_G2), F.G, F.vcu};
                  EpiF2 E{(bf16*)(wso + WS_FF)};
                  if (FP8_F2) pg8::gemm_phase<EpiF2, F2Sched, true, true>(F.lds, S, E, 1024, 8192, (size_t)128 * 8192, F.wv);
                  else pg8::gemm_phase<EpiF2, F2Sched, true>(F.lds, S, E, 2048, 16384, (size_t)128 * 16384, F.wv); }
                { F2cSched S{(const char*)(wso + WS_ALC), (const char*)(wso + WS_G2C), F.G, F.vcu};
                  EpiBf16 E{(bf16*)(wso + WS_FF + (FP8_OUT2 ? CTX_SIDE - (size_t)NLAT * 2048 : (size_t)0)), 1024, 1.f};
                  pg8::gemm_phase<EpiBf16, F2cSched, true>(F.lds, S, E, 1024, 1024, (size_t)128 * 1024, F.wv); }
            } } PH_END_BG(F.vcu < 16)
            bg_on = false;
            PH_BEGIN for (int rep_ = 0; rep_ < NREP(8); ++rep_) { if (rep_) xcd_barrier(bar, F.wv); if (EN(8)) {
                pg8::StaticSched S; S.init(wso + WS_FF, WB + WE_FN, NLAT, 1024, FP8_OUT2 ? 512 : 1024, FP8_OUT2 ? 512 : 1024, FP8_OUT2 ? 512 : 1024, F.G, cid);
                EpiResid E{(bf16*)(wso + WS_XALL), wso, layer, 2, FP8_OUT2 ? pg8::FP8_WSCALE : 1.f};
                if (FP8_OUT2) pg8::gemm_phase<EpiResid, pg8::StaticSched, true, true>(F.lds, S, E, 1024, 1024, (size_t)128 * 1024, F.wv);
                else pg8::gemm_phase<EpiResid, pg8::StaticSched, true>(F.lds, S, E, 2048, 2048, (size_t)128 * 2048, F.wv);
                small_gemm_ctx<FP8_OUT2 != 0>(F, (const bf16*)(wso + WS_FF + (FP8_OUT2 ? CTX_SIDE - (size_t)NLAT * 2048 : (size_t)0)), 1024, WB + WE_FN, 1024, 1024, (bf16*)(wso + WS_XALL), modv(wso, layer, 4, 2));
            } } PH_END
        } else {
            PH_BEGIN for (int rep_ = 0; rep_ < NREP(9); ++rep_) { if (rep_) xcd_barrier(bar, F.wv); if (EN(9)) {
                pg8::StaticSched S; S.init(wso + WS_ACT, WB + WE_NQKV, NTOK, 3072, FP8_INPROJ ? 512 : 1024, FP8_INPROJ ? 512 : 1024, FP8_INPROJ ? 512 : 1024, F.G, cid);
                EpiQKV E{(bf16*)(wso + WS_NQ), (bf16*)(wso + WS_NK), (bf16*)(wso + WS_NV), 0.125f * (FP8_INPROJ ? pg8::FP8_WSCALE : 1.f), FP8_INPROJ ? pg8::FP8_WSCALE : 1.f};
                if (FP8_INPROJ) pg8::gemm_phase<EpiQKV, pg8::StaticSched, true, true>(F.lds, S, E, 1024, 1024, (size_t)128 * 1024, F.wv);
                else pg8::gemm_phase<EpiQKV, pg8::StaticSched, true>(F.lds, S, E, 2048, 2048, (size_t)128 * 2048, F.wv);
            } } PH_END_BG(CNT_BUSY(68 * 12, cid))
            need = BG_NEED_NOUT; bg_on = true;
            PH_BEGIN for (int rep_ = 0; rep_ < NREP(10); ++rep_) { if (rep_) xcd_barrier(bar, F.wv); if (EN(10)) p_na_attn(F, args); } PH_END_BG(CNT_BUSY(2048 + 128, F.vcu))
            bg_on = false;
            PH_BEGIN for (int rep_ = 0; rep_ < NREP(11); ++rep_) { if (rep_) xcd_barrier(bar, F.wv); if (EN(11)) {
                pg8::StaticSched S; S.init(wso + WS_NO, WB + WE_NOUT, NLAT, 1024, FP8_OUT2 ? 512 : 1024, FP8_OUT2 ? 512 : 1024, FP8_OUT2 ? 512 : 1024, F.G, cid);
                EpiResid E{(bf16*)(wso + WS_XALL), wso, layer, 2, FP8_OUT2 ? pg8::FP8_WSCALE : 1.f};
                if (FP8_OUT2) pg8::gemm_phase<EpiResid, pg8::StaticSched, true, true>(F.lds, S, E, 1024, 1024, (size_t)128 * 1024, F.wv);
                else pg8::gemm_phase<EpiResid, pg8::StaticSched, true>(F.lds, S, E, 2048, 2048, (size_t)128 * 2048, F.wv);
                small_gemm_ctx<FP8_OUT2 != 0>(F, (const bf16*)(wso + WS_NO + (FP8_OUT2 ? CTX_SIDE - (size_t)NLAT * 2048 : (size_t)0)), 1024, WB + WE_NOUT, 1024, 1024, (bf16*)(wso + WS_XALL), modv(wso, layer, 4, 2));
            } } PH_END
        }
        PH_BEGIN for (int rep_ = 0; rep_ < NREP(12); ++rep_) { if (rep_) xcd_barrier(bar, F.wv); if (EN(12)) p_mid(F, args, layer, mrows); } PH_END
        need = (layer == 0) ? BG_NEED_MOE0 : (layer == 1) ? BG_NEED_MOE1 : (layer == 2) ? BG_NEED_MOE2 : BG_TOTAL; bg_on = true;
        PH_BEGIN for (int rep_ = 0; rep_ < NREP(13); ++rep_) { if (rep_) xcd_barrier(bar, F.wv); if (EN(13)) p_perm(F, mrows); } PH_END
        bg_on = (layer == 0);
        PH_BEGIN for (int rep_ = 0; rep_ < NREP(14); ++rep_) { if (rep_) xcd_barrier(bar, F.wv); if (EN(14)) {
            volatile LAS int* ts = (volatile LAS int*)(F.MISC + 32);
            { int t_o = tid_of(F.wv); asm volatile("" : "+v"(t_o)); if (t_o < 17) ts[t_o] = ((const int*)(wso + WS_MOETAB))[t_o]; }
            __syncthreads();
            MoeSched S{ts, (const char*)(wso + WS_XP), (const char*)(wso + WS_W) + WE_MG * 2 + (size_t)layer * 16 * 1048576, 8, 131072, F.G, F.vcu};
            EpiMoe1 E{(unsigned char*)(wso + WS_H)};
            pg8::gemm_phase<EpiMoe1, MoeSched, true, true>(F.lds, S, E, 1024, 1024, (size_t)(WE_MU - WE_MG) * 2, F.wv);
        } } PH_END_BG(CNT_BUSY(((volatile LAS int*)(F.MISC + 32))[16] * 8, F.vcu))
        PH_BEGIN for (int rep_ = 0; rep_ < NREP(15); ++rep_) { if (rep_) xcd_barrier(bar, F.wv); if (EN(15)) {
            volatile LAS int* ts = (volatile LAS int*)(F.MISC + 32);
            { int t_o = tid_of(F.wv); asm volatile("" : "+v"(t_o)); if (t_o < 17) ts[t_o] = ((const int*)(wso + WS_MOETAB))[t_o]; }
            __syncthreads();
            MoeSched S{ts, (const char*)(wso + WS_H), (const char*)(wso + WS_W) + WE_MD * 2 + (size_t)layer * 16 * 1048576, 4, 262144, F.G, F.vcu};
#if FP8_YB
            EpiFp8N E{(unsigned char*)(wso + WS_YB)};
            pg8::gemm_phase<EpiFp8N, MoeSched, true, true>(F.lds, S, E, 1024, 1024, (size_t)128 * 1024, F.wv);
#else
            EpiBf16N E{(bf16*)(wso + WS_YB), 1024, pg8::FP8_WSCALE};
            pg8::gemm_phase<EpiBf16N, MoeSched, true, true>(F.lds, S, E, 1024, 1024, (size_t)128 * 1024, F.wv);
#endif
        } } PH_END_BG(CNT_BUSY(((volatile LAS int*)(F.MISC + 32))[16] * 4, F.vcu))
    }
    PH_BEGIN p_pre<2>(F, args, 4); PH_END
#undef PH_BEGIN
#undef PH_END
#undef PH_END_BG
#undef CNT_BUSY
}

extern "C" void kernel_launch(void* const* d_in, const int* in_sizes, int n_in, void* d_out, int out_size, void* d_ws, size_t ws_size, hipStream_t stream) {
    static int grid = 0;
    if (grid == 0) {
        if (n_in != 22 || out_size != NLAT * D || ws_size < WS_END) { fprintf(stderr, "kernel_launch: unexpected shapes (n_in %d out %d ws %zu)\n", n_in, out_size, ws_size); grid = -1; return; }
        int dev = 0, cus = 0, per_cu = 0;
        if (hipGetDevice(&dev) != hipSuccess || hipDeviceGetAttribute(&cus, hipDeviceAttributeMultiprocessorCount, dev) != hipSuccess) { grid = -1; return; }
        if (hipFuncSetAttribute((const void*)fwd_kernel, hipFuncAttributeMaxDynamicSharedMemorySize, LDS_BYTES) != hipSuccess) { fprintf(stderr, "kernel_launch: hipFuncSetAttribute failed\n"); grid = -1; return; }
        if (hipOccupancyMaxActiveBlocksPerMultiprocessor(&per_cu, (const void*)fwd_kernel, 512, LDS_BYTES) != hipSuccess || per_cu < 1) fprintf(stderr, "kernel_launch: occupancy query reports %d\n", per_cu);
        (void)hipGetLastError();
        grid = cus;
    }
    if (grid < 0) return;
    (void)hipMemsetAsync((char*)d_ws + WS_CTL, 0, CTL_ZERO_BYTES, stream);
    Args a{};
    for (int i = 0; i < 22; ++i) a.in[i] = (const float*)d_in[i];
    a.out = (float*)d_out; a.ws = (unsigned char*)d_ws;
#if MK_PER_PHASE
    for (int p = 0; p < NPHASES; ++p) { a.ph_lo = p; a.ph_hi = p + 1; hipLaunchKernelGGL(fwd_kernel, dim3(grid), dim3(512), LDS_BYTES, stream, a); }
#else
    a.ph_lo = 0; a.ph_hi = NPHASES; hipLaunchKernelGGL(fwd_kernel, dim3(grid), dim3(512), LDS_BYTES, stream, a);
#endif
}
```

```cpp
#include <hip/hip_runtime.h>
#include <cstdio>
#include <cstdint>
#include <type_traits>

#define LAS __attribute__((address_space(3)))
#define GAS __attribute__((address_space(1)))
typedef unsigned short bf16;
typedef short bf16x8 __attribute__((ext_vector_type(8)));
typedef short s16x4 __attribute__((ext_vector_type(4)));
typedef float f32x4 __attribute__((ext_vector_type(4)));
typedef float f32x2 __attribute__((ext_vector_type(2)));
typedef unsigned u32x4 __attribute__((ext_vector_type(4)));
typedef unsigned u32x2 __attribute__((ext_vector_type(2)));

#ifndef FP8_INPROJ
#define FP8_INPROJ 1
#endif
#ifndef FP8_OUTPROJ
#define FP8_OUTPROJ 1
#endif
#ifndef FP8_RETSTORE
#define FP8_RETSTORE 1
#endif
#ifndef FP8_YB
#define FP8_YB 1
#endif
#ifndef FP8_OUT2
#define FP8_OUT2 1
#endif
constexpr size_t CTX_SIDE = 20u << 20;
#ifndef FP8_F2
#define FP8_F2 1
#endif
#ifndef MK_PER_PHASE
#define MK_PER_PHASE 0
#endif

constexpr int D = 1024, NB = 4, SEQ = 4096, LCTX = 256, NLAT = NB * SEQ, NCTX = NB * LCTX, NTOK = NLAT + NCTX;
constexpr int NLAYER = 4, NMOD = 6, NEXP = 16;
constexpr float EPS = 1e-6f;
constexpr int RH = 4, RDK = 256, RDV = 512, RCH = 128;
constexpr int NAH = 16, NAHD = 64;
constexpr int PMAX = 2 * NTOK + NEXP * 256;

constexpr size_t MiB = 1u << 20;
constexpr size_t WS_CTL = 0, CTL_ZERO_BYTES = 64 * 1024;
constexpr size_t WS_MOD = 1 * MiB;
constexpr size_t WS_ROPE = 2 * MiB;
constexpr size_t WS_A1 = WS_ROPE + 64 * 1024;
constexpr size_t WS_ALC = WS_A1 + 512 * 256 * 2;
constexpr size_t WS_A1N = WS_ALC + 256 * 512 * 2;
constexpr size_t WS_BLKCNT = 3 * MiB;
constexpr size_t WS_MOETAB = WS_BLKCNT + 64 * 1024;
constexpr size_t WS_ROUTE = 4 * MiB;
constexpr size_t WS_DEST = 5 * MiB;
constexpr size_t WS_W = 8 * MiB;
constexpr size_t WE_RIN = 0, WE_ROUT = WE_RIN + 2ull * 6144 * 1024, WE_FN = WE_ROUT + 2ull * 1024 * 2048, WE_NQKV = WE_FN + 1024ull * 1024,
                 WE_NOUT = WE_NQKV + 3072ull * 1024, WE_MG = WE_NOUT + 1024ull * 1024, WE_MU = WE_MG + 64ull * 1024 * 1024, WE_MD = WE_MU + 64ull * 1024 * 1024,
                 WE_END = WE_MD + 64ull * 1024 * 1024;
static_assert(WE_END * 2 <= 426 * MiB, "weights");
constexpr size_t WS_AL = 434 * MiB;
constexpr size_t WS_XALL = 498 * MiB;
constexpr size_t WS_ACT = 566 * MiB;
constexpr size_t WS_S = 600 * MiB;
constexpr size_t WS_RQ = WS_S, WS_RK = WS_S + 34 * MiB, WS_RV = WS_S + 68 * MiB, WS_RG = WS_S + 136 * MiB, WS_ROF = WS_S + 204 * MiB, WS_ROB = WS_S + 272 * MiB;
constexpr size_t WS_G2 = WS_S, WS_G2C = WS_S + 64 * MiB, WS_FF = WS_S + 68 * MiB;
constexpr size_t WS_NQ = WS_S, WS_NK = WS_S + 34 * MiB, WS_NV = WS_S + 68 * MiB, WS_NO = WS_S + 102 * MiB;
constexpr size_t WS_XP = WS_S, WS_H = WS_S + 76 * MiB, WS_YB = WS_S + 152 * MiB;
constexpr size_t WS_ROG = 940 * MiB;
constexpr size_t WS_END = 1008 * MiB;
static_assert((size_t)PMAX * 2048 <= 76 * MiB, "moe rows");

constexpr int LDS_BYTES = 159 * 1024;
constexpr int MISC_OFF = 158 * 1024;

__device__ __forceinline__ unsigned f2bf(float f) { unsigned u = __builtin_bit_cast(unsigned, f); return (u + 0x7fffu + ((u >> 16) & 1u)) >> 16; }
__device__ __forceinline__ unsigned pk2(float lo, float hi) { return f2bf(lo) | (f2bf(hi) << 16); }
__device__ __forceinline__ float bf2f(unsigned short b) { return __builtin_bit_cast(float, ((unsigned)b) << 16); }
__device__ __forceinline__ float bflo(unsigned u) { return __builtin_bit_cast(float, u << 16); }
__device__ __forceinline__ float bfhi(unsigned u) { return __builtin_bit_cast(float, u & 0xffff0000u); }
__device__ __forceinline__ float silu_f(float v) { return v * __builtin_amdgcn_rcpf(1.f + __expf(-v)); }
__device__ __forceinline__ float shx(float v, int o, int lane) { return __builtin_bit_cast(float, __builtin_amdgcn_ds_bpermute((lane ^ o) << 2, __builtin_bit_cast(int, v))); }
__device__ __forceinline__ float wave_sum(float v, int lane) {
#pragma unroll
    for (int o = 1; o < 64; o <<= 1) v += shx(v, o, lane);
    return v;
}
__device__ __forceinline__ int tid_of(int wave_sgpr) { int l; asm volatile("v_mbcnt_lo_u32_b32 %0, -1, 0\n\tv_mbcnt_hi_u32_b32 %0, -1, %0" : "=v"(l)); return wave_sgpr * 64 + l; }
#define LDS_WAIT() asm volatile("s_waitcnt lgkmcnt(0)" ::: "memory")
#define VM_WAIT() asm volatile("s_waitcnt vmcnt(0)" ::: "memory")

#define XB_TMO      128
#define XB_XCNT(j)  (256  + 64 * (j))
#define XB_XSUB(j)  (1280 + 64 * (j))
#define XB_XGEN(j)  (2304 + 64 * (j))
#define XB_TOP      3328
#define XB_TOPGEN   3392
#define XCD_BAR_WORDS 3456
#define XB_SPIN_CAP (1u << 18)
__device__ __forceinline__ unsigned xb_ld(unsigned* p)              { return __hip_atomic_load(p, __ATOMIC_RELAXED, __HIP_MEMORY_SCOPE_AGENT); }
__device__ __forceinline__ unsigned xb_add(unsigned* p, unsigned v) { return __hip_atomic_fetch_add(p, v, __ATOMIC_RELAXED, __HIP_MEMORY_SCOPE_AGENT); }
__device__ __forceinline__ unsigned xb_xcc_id() { return (unsigned)__builtin_amdgcn_s_getreg((3 << 11) | 20) & 0xFu; }
#define XB_SPIN(cond, bar) do { unsigned _sp = 0; while (cond) { __builtin_amdgcn_s_sleep(1); \
    if ((++_sp & 255u) == 0u) { if (xb_ld(&(bar)[XB_TMO])) break; if (_sp > XB_SPIN_CAP) { atomicAdd(&(bar)[XB_TMO], 1u); break; } } } } while (0)
struct XcdBarrier { unsigned* bar; unsigned x; volatile LAS unsigned* st; };
__device__ __forceinline__ XcdBarrier xcd_barrier_post(unsigned* bar, volatile LAS unsigned* st) {
    XcdBarrier b; b.bar = bar; b.x = xb_xcc_id(); b.st = st;
    if (threadIdx.x == 0) (void)xb_add(&bar[XB_XCNT(b.x)], 1u);
    return b;
}
__device__ __forceinline__ void xcd_barrier_complete(unsigned* bar, unsigned x, unsigned& nloc, unsigned& nx) {
    const unsigned G = gridDim.x * gridDim.y * gridDim.z;
    unsigned sum, cnt, mine, sp = 0u;
    for (;;) {
        sum = 0u; cnt = 0u; mine = 0u;
#pragma unroll
        for (unsigned j = 0; j < 16; ++j) { const unsigned c = xb_ld(&bar[XB_XCNT(j)]); sum += c; cnt += (c > 0u) ? 1u : 0u; mine = (j == x) ? c : mine; }
        if (sum == G) break;
        __builtin_amdgcn_s_sleep(1);
        if ((++sp & 255u) == 0u) { if (xb_ld(&bar[XB_TMO])) break; if (sp > XB_SPIN_CAP) { atomicAdd(&bar[XB_TMO], 1u); break; } }
    }
    nloc = mine > 0u ? mine : 1u; nx = cnt > 0u ? cnt : 1u;
}
__device__ __forceinline__ void xcd_barrier(const XcdBarrier& b, const int wave_sgpr) {
    asm volatile("s_waitcnt vmcnt(0)" ::: "memory");
    __syncthreads();
    if (tid_of(wave_sgpr) == 0) {
        unsigned* bar = b.bar;
        __builtin_amdgcn_s_waitcnt(0);
        unsigned nloc = b.st[0], nx = b.st[1];
        if (nloc == 0u) { xcd_barrier_complete(bar, b.x, nloc, nx); b.st[0] = nloc; b.st[1] = nx; }
        const unsigned old = xb_add(&bar[XB_XSUB(b.x)], 1u);
        const unsigned gen = old / nloc;
        if (old + 1u == (gen + 1u) * nloc) {
            __builtin_amdgcn_fence(__ATOMIC_RELEASE, "agent");
            asm volatile("s_waitcnt vmcnt(0)" ::: "memory");
            const unsigned og = xb_add(&bar[XB_TOP], 1u);
            const unsigned tg = og / nx;
            if (og + 1u == (tg + 1u) * nx) {
#pragma unroll
                for (unsigned jx = 0; jx < 16; ++jx) (void)xb_add(&bar[XB_XGEN(jx)], 1u);
                __builtin_amdgcn_fence(__ATOMIC_ACQUIRE, "agent");
                asm volatile("s_waitcnt vmcnt(0)" ::: "memory");
            } else {
                __builtin_amdgcn_fence(__ATOMIC_ACQUIRE, "agent");
                XB_SPIN(xb_ld(&bar[XB_XGEN(b.x)]) == gen, bar);
                asm volatile("s_waitcnt vmcnt(0)" ::: "memory");
            }
        } else {
            __builtin_amdgcn_fence(__ATOMIC_ACQUIRE, "agent");
            XB_SPIN(xb_ld(&bar[XB_XGEN(b.x)]) == gen, bar);
            asm volatile("s_waitcnt vmcnt(0)" ::: "memory");
        }
    }
    __syncthreads();
}

namespace pg8 {
constexpr int BM = 256, BK = 64, HALF = 128, HTB = HALF * BK * 2, STAGE_BYTES = 8 * HTB;
__host__ __device__ __forceinline__ int lds_byte(int r, int c) { const int pos = (c >> 3) ^ ((r >> 1) & 7); return r * 128 + pos * 16 + (c & 7) * 2; }
__host__ __device__ __forceinline__ void stage_rc(int b, int& R, int& C) { R = b >> 7; const int pos = (b >> 4) & 7; C = (pos ^ ((R >> 1) & 7)) * 8 + ((b & 15) >> 1); }
__host__ __device__ __forceinline__ int perm32(int rho) { const int n = rho >> 4, i = rho & 15; return 8 * (i >> 2) + 4 * n + (i & 3); }

struct Unit { const char* A; const char* B0; int pm, pn, aux, nt; };

typedef int i32x8 __attribute__((ext_vector_type(8)));
__device__ __forceinline__ i32x8 cat_i8(const bf16x8& lo, const bf16x8& hi) { const u32x4 a = __builtin_bit_cast(u32x4, lo), b = __builtin_bit_cast(u32x4, hi); return (i32x8){(int)a.x, (int)a.y, (int)a.z, (int)a.w, (int)b.x, (int)b.y, (int)b.z, (int)b.w}; }
constexpr int FP8_SCALE_A = 0x7F7F7F7F, FP8_SCALE_B = 0x7F7F7F7F;
constexpr float FP8_WSCALE = 1.f / 32.f;
template <class E, class = void> struct has_brow : std::false_type {};
template <class E> struct has_brow<E, std::void_t<decltype(E::brow(0))>> : std::true_type {};
template <class E, class = void> struct has_lds_store : std::false_type {};
template <class E> struct has_lds_store<E, std::void_t<decltype(E::LDS_STORE)>> : std::true_type {};
template <class Epi, class Sched, bool ALIGN_EPI, bool FP8 = false>
__device__ __forceinline__ void gemm_phase(LAS unsigned char* lds, const Sched& S, const Epi& E, const int ldaB  , const int ldbB, const size_t hstepB  , const int wave_sgpr) {
    int tid = tid_of(wave_sgpr); asm volatile("" : "+v"(tid));
    const int wid = __builtin_amdgcn_readfirstlane(tid >> 6), lane = tid & 63, wr = wid >> 2, wc = wid & 3, fr = lane & 15, fq = lane >> 4;
    unsigned voffA[2], voffB[2];
#pragma unroll
    for (int i = 0; i < 2; ++i) { int R, C; stage_rc(tid * 16 + i * 8192, R, C); int Rb = Epi::PERM ? ((R & ~31) + perm32(R & 31)) : R;
        if constexpr (has_brow<Epi>::value) Rb = Epi::brow(R);
        voffA[i] = (unsigned)(R * ldaB + C * 2); voffB[i] = (unsigned)(Rb * ldbB + C * 2); }
    const size_t kstep = (size_t)(BK * 2);
    const size_t hstepA = (size_t)HALF * ldaB;
    const unsigned ldsw = (unsigned)wid * 1024u;
    const unsigned ldsbase = (unsigned)(size_t)lds + ldsw;
    const int aoff = lds_byte(wr * 64 + fr, fq * 8), boff = lds_byte(wc * 32 + fr, fq * 8);
#define PG8_SA(b, h) (((b) * 2 + (h)) * HTB)
#define PG8_SB(b, h) ((4 + (b) * 2 + (h)) * HTB)
#define PG8_STAGE(bufoff, gbase, voff) do { _Pragma("unroll") for (int _i = 0; _i < 2; ++_i) { \
        if constexpr (FP8) { unsigned keep_; asm volatile("s_mov_b32 %0, m0\n\ts_mov_b32 m0, %2\n\ts_nop 0\n\tglobal_load_lds_dwordx4 %1, %3\n\ts_mov_b32 m0, %0" : "=&s"(keep_) \
            : "v"((voff)[_i]), "s"(ldsbase + (unsigned)((bufoff) + _i * 8192)), "s"((const char*)(gbase)) : "memory"); } \
        else __builtin_amdgcn_global_load_lds((const unsigned*)((const char*)(gbase) + (voff)[_i]), (LAS unsigned*)(lds + (bufoff) + ldsw + _i * 8192), 16, 0, 0); } } while (0)
#define PG8_LDA(dst, b, h) do { int ao1_ = aoff ^ 64; asm volatile("" : "+v"(ao1_)); _Pragma("unroll") for (int m = 0; m < 4; ++m) { dst[m][0] = *(const LAS bf16x8*)(lds + PG8_SA(b, h) + aoff + m * 2048); dst[m][1] = *(const LAS bf16x8*)(lds + PG8_SA(b, h) + ao1_ + m * 2048); } } while (0)
#define PG8_LDB(dst, b, h) do { int bo1_ = boff ^ 64; asm volatile("" : "+v"(bo1_)); _Pragma("unroll") for (int n = 0; n < 2; ++n) { dst[n][0] = *(const LAS bf16x8*)(lds + PG8_SB(b, h) + boff + n * 2048); dst[n][1] = *(const LAS bf16x8*)(lds + PG8_SB(b, h) + bo1_ + n * 2048); } } while (0)
#define PG8_MMA(ai, bj, At, Bt) do { __builtin_amdgcn_s_setprio(1); _Pragma("unroll") for (int m = 0; m < 4; ++m) _Pragma("unroll") for (int n = 0; n < 2; ++n) { \
        if constexpr (FP8) acc[ai][bj][m][n] = __builtin_amdgcn_mfma_scale_f32_16x16x128_f8f6f4(cat_i8(Bt[n][0], Bt[n][1]), cat_i8(At[m][0], At[m][1]), acc[ai][bj][m][n], 0, 0, 0, FP8_SCALE_B, 0, FP8_SCALE_A); \
        else { _Pragma("unroll") for (int k = 0; k < 2; ++k) acc[ai][bj][m][n] = __builtin_amdgcn_mfma_f32_16x16x32_bf16(Bt[n][k], At[m][k], acc[ai][bj][m][n], 0, 0, 0); } } __builtin_amdgcn_s_setprio(0); } while (0)
#define PG8_WAIT_V(n) asm volatile("s_waitcnt vmcnt(" #n ")" ::: "memory")
#define PG8_WAIT_L(n) asm volatile("s_waitcnt lgkmcnt(" #n ")" ::: "memory")
#define PG8_BAR __builtin_amdgcn_s_barrier()
#define PG8_SCHED __builtin_amdgcn_sched_barrier(0)
    Unit cur, nxt; int ui = 0;
    if (!S.next(0, cur)) return;
    f32x4 acc[2][2][4][2];
#pragma unroll
    for (int a = 0; a < 2; ++a)
#pragma unroll
        for (int b = 0; b < 2; ++b)
#pragma unroll
            for (int m = 0; m < 4; ++m)
#pragma unroll
                for (int n = 0; n < 2; ++n) acc[a][b][m][n] = (f32x4){0.f, 0.f, 0.f, 0.f};
    bf16x8 At[4][2], B0[2][2], B1[2][2];
    const char* cA = cur.A; const char* cB0 = cur.B0;
    PG8_STAGE(PG8_SB(0, 0), cB0, voffB); PG8_STAGE(PG8_SB(0, 1), cB0 + hstepB, voffB); PG8_STAGE(PG8_SA(0, 0), cA, voffA); PG8_STAGE(PG8_SA(0, 1), cA + hstepA, voffA);
    if (wr == 1) PG8_BAR;
    PG8_WAIT_V(2); PG8_BAR;
    PG8_STAGE(PG8_SB(1, 0), cB0 + kstep, voffB); PG8_STAGE(PG8_SA(1, 0), cA + kstep, voffA); PG8_STAGE(PG8_SB(1, 1), cB0 + hstepB + kstep, voffB);
    PG8_WAIT_V(6); PG8_BAR;
    for (;;) {
        const bool has_next = S.next(ui + 1, nxt);
        const char* nA = has_next ? nxt.A : cA; const char* nB0 = has_next ? nxt.B0 : cB0;
        int nt = cur.nt; asm volatile("" : "+s"(nt));
        for (int t = 0; t < nt; t += 2) {
            const bool last = (t == nt - 2);
            const char* a1 = cA + (size_t)(t + 1) * kstep;
            const char* a2 = last ? nA : cA + (size_t)(t + 2) * kstep;
            const char* b20 = last ? nB0 : cB0 + (size_t)(t + 2) * kstep;
            const char* a3 = a2 + kstep; const char* b30 = b20 + kstep;
            PG8_LDB(B0, 0, 0); PG8_LDB(B1, 0, 1); PG8_SCHED; PG8_LDA(At, 0, 0); PG8_STAGE(PG8_SA(1, 1), a1 + hstepA, voffA);
            PG8_WAIT_V(8); PG8_WAIT_L(0); PG8_BAR; PG8_MMA(0, 0, At, B0); PG8_MMA(0, 1, At, B1); PG8_BAR; PG8_SCHED;
            PG8_LDA(At, 0, 1); PG8_STAGE(PG8_SB(0, 0), b20, voffB); PG8_STAGE(PG8_SB(0, 1), b20 + hstepB, voffB); PG8_STAGE(PG8_SA(0, 0), a2, voffA);
            PG8_WAIT_V(8); PG8_WAIT_L(0); PG8_BAR; PG8_MMA(1, 0, At, B0); PG8_MMA(1, 1, At, B1); PG8_BAR; PG8_SCHED;
            PG8_LDB(B0, 1, 0); PG8_LDB(B1, 1, 1); PG8_SCHED; PG8_LDA(At, 1, 0); PG8_STAGE(PG8_SA(0, 1), a2 + hstepA, voffA);
            PG8_WAIT_V(8); PG8_WAIT_L(0); PG8_BAR; PG8_MMA(0, 0, At, B0); PG8_MMA(0, 1, At, B1); PG8_BAR; PG8_SCHED;
            PG8_LDA(At, 1, 1); PG8_STAGE(PG8_SB(1, 0), b30, voffB); PG8_STAGE(PG8_SB(1, 1), b30 + hstepB, voffB); PG8_STAGE(PG8_SA(1, 0), a3, voffA);
            PG8_WAIT_V(8); PG8_WAIT_L(0); PG8_BAR; PG8_MMA(1, 0, At, B0); PG8_MMA(1, 1, At, B1); PG8_BAR; PG8_SCHED;
        }
        if constexpr (ALIGN_EPI) { if (wr == 0) PG8_BAR; }
        { int t_e = tid_of(wave_sgpr); asm volatile("" : "+v"(t_e)); const int fr_e = t_e & 15, fq_e = (t_e >> 4) & 3;
          if constexpr (has_lds_store<Epi>::value) { static_assert(ALIGN_EPI, "LDS-staged epilogues use workgroup barriers"); E.lds_store(acc, cur, wr, wc, fr_e, fq_e, lds + STAGE_BYTES, t_e); }
          else E(acc, cur, wr, wc, fr_e, fq_e); }
        if (!has_next) break;
#pragma unroll
        for (int a = 0; a < 2; ++a)
#pragma unroll
            for (int b = 0; b < 2; ++b)
#pragma unroll
                for (int m = 0; m < 4; ++m)
#pragma unroll
                    for (int n = 0; n < 2; ++n) acc[a][b][m][n] = (f32x4){0.f, 0.f, 0.f, 0.f};
        cur = nxt; cA = nA; cB0 = nB0; ++ui;
        if constexpr (ALIGN_EPI) { if (wr == 1) PG8_BAR; }
    }
    PG8_WAIT_V(0);
    if constexpr (!ALIGN_EPI) { if (wr == 0) PG8_BAR; }
    PG8_BAR;
#undef PG8_SA
#undef PG8_SB
#undef PG8_STAGE
#undef PG8_LDA
#undef PG8_LDB
#undef PG8_MMA
#undef PG8_WAIT_V
#undef PG8_WAIT_L
#undef PG8_BAR
#undef PG8_SCHED
}

constexpr int NXCD = 8, WGM = 8;
struct StaticSched {
    const char* A; const char* Bt; size_t ldaB, ldbB; int nM, nN, nwg, G, c, nt;
    __device__ void init(const void* A_, const void* Bt_, int M, int N, int K, int lda, int ldb, int G_, int c_) { A = (const char*)A_; Bt = (const char*)Bt_; ldaB = (size_t)lda * 2; ldbB = (size_t)ldb * 2; nM = M / BM; nN = N / BM; nwg = nM * nN; G = G_; c = c_; nt = K / BK; }
    __device__ bool next(int i, Unit& u) const {
        const long L = (long)i * G + c; if (L >= nwg) return false;
        int wgid = (int)L; { const int q = nwg / NXCD, r = nwg % NXCD, xcd = wgid % NXCD, off = wgid / NXCD; wgid = (xcd < r ? xcd * (q + 1) : r * (q + 1) + (xcd - r) * q) + off; }
        const int nig = WGM * nN, gid = wgid / nig, fm = gid * WGM, gsz = (nM - fm) < WGM ? (nM - fm) : WGM;
        u.pm = fm + ((wgid % nig) % gsz); u.pn = (wgid % nig) / gsz; u.aux = 0; u.nt = nt;
        u.A = A + (size_t)u.pm * BM * ldaB; u.B0 = Bt + (size_t)u.pn * BM * ldbB; return true;
    }
};
}

struct Args { const float* in[22]; float* out; unsigned char* ws; int ph_lo, ph_hi; };
struct Frame {
    LAS unsigned char* lds; volatile LAS unsigned* MISC;
    int vcu, G, wv;
    unsigned char* ws;
};
enum { I_X = 0, I_C, I_CTX, I_CCTX, I_WMOD, I_BMOD, I_NMIX, I_NFFN, I_NFIN, I_RWIN, I_RDEC, I_RGN, I_RWOUT, I_FNW, I_NAQKV, I_NARPB, I_NAOUT, I_RTW, I_RTB, I_MG, I_MU, I_MD };

__device__ __forceinline__ const float* modv(const unsigned char* ws, int layer, int bidx, int which) { return (const float*)(ws + WS_MOD) + ((size_t)(layer * 5 + bidx) * NMOD + which) * D; }
__device__ __forceinline__ int bidx_of_row(int row) { return row < NLAT ? (row >> 12) : 4; }

#ifndef REP_MASK
#define REP_MASK 0
#endif
#define NREP(b) (1 + ((REP_MASK >> (b)) & 1))
__device__ __forceinline__ int rope_perm(int n) {
    if (n >= 2048) return n;
    const int head = n >> 8, c = n & 255, qd = c >> 6, i = c & 63;
    const int j = (qd == 0) ? i : (qd == 2) ? 64 + i : (qd == 1) ? 128 + i : 192 + i;
    return head * 256 + j;
}
struct TItem { const float* W; bf16* WT; int K, N, item; bool rp; bool f8; };
__device__ __forceinline__ void titem_load(const TItem& t, f32x4 (&v)[16], int lane) {
    const int nblk = t.N / 64, kb = t.item / nblk, nb = t.item % nblk, k0 = 64 * kb, n0 = 64 * nb;
    const float* src = t.W + (size_t)(k0 + (lane >> 4)) * t.N + n0 + (lane & 15) * 4;
#pragma unroll
    for (int r = 0; r < 16; ++r) v[r] = *(const f32x4*)(src + (size_t)(4 * r) * t.N);
}
__device__ __forceinline__ void titem_store(const TItem& t, const f32x4 (&v)[16], LAS float* scr, int lane) {
    const int nblk = t.N / 64, kb = t.item / nblk, nb = t.item % nblk, k0 = 64 * kb, n0 = 64 * nb;
#pragma unroll
    for (int r = 0; r < 16; ++r) { const int kk = 4 * r + (lane >> 4), n4 = (lane & 15) * 4;
        scr[kk * 65 + n4 + 0] = v[r][0]; scr[kk * 65 + n4 + 1] = v[r][1]; scr[kk * 65 + n4 + 2] = v[r][2]; scr[kk * 65 + n4 + 3] = v[r][3]; }
    LDS_WAIT(); asm volatile("" ::: "memory");
    const int c = lane & 7;
#pragma unroll 2
    for (int j = 0; j < 8; ++j) { const int n = 8 * j + (lane >> 3); const LAS float* s = scr + (8 * c) * 65 + n;
        float x[8];
#pragma unroll
        for (int q = 0; q < 8; ++q) x[q] = s[q * 65];
        const int nd = t.rp ? rope_perm(n0 + n) : (n0 + n);
        if (t.f8) { u32x2 o8; int q = __builtin_amdgcn_cvt_pk_fp8_f32(x[0] * 32.f, x[1] * 32.f, 0, false); q = __builtin_amdgcn_cvt_pk_fp8_f32(x[2] * 32.f, x[3] * 32.f, q, true); o8.x = (unsigned)q;
            q = __builtin_amdgcn_cvt_pk_fp8_f32(x[4] * 32.f, x[5] * 32.f, 0, false); q = __builtin_amdgcn_cvt_pk_fp8_f32(x[6] * 32.f, x[7] * 32.f, q, true); o8.y = (unsigned)q;
            *(u32x2*)((unsigned char*)t.WT + (size_t)nd * t.K + k0 + 8 * c) = o8; }
        else { u32x4 o; o.x = pk2(x[0], x[1]); o.y = pk2(x[2], x[3]); o.z = pk2(x[4], x[5]); o.w = pk2(x[6], x[7]); *(u32x4*)(t.WT + (size_t)nd * t.K + k0 + 8 * c) = o; } }
    LDS_WAIT(); asm volatile("" ::: "memory");
}
__device__ __forceinline__ int seg_items(int seg) { return seg < 2 ? 16 * 96 : seg < 4 ? 32 * 16 : seg == 4 ? 256 : seg == 5 ? 16 * 48 : seg == 6 ? 256 : 16 * 256; }
template <int NSEG>
__device__ __forceinline__ TItem titem_decode(const Args& a, bf16* WB, const int (&segs)[NSEG], int it) {
    int seg = segs[0], before = 0, accn = 0; bool found = false;
#pragma unroll
    for (int i = 0; i < NSEG; ++i) { const int n = seg_items(segs[i]); if (!found && it < accn + n) { seg = segs[i]; before = accn; found = true; } accn += n; }
    const int li = it - before;
    TItem t; t.rp = false; t.f8 = false; t.item = li;
    if (seg < 2) { t.W = a.in[I_RWIN] + (size_t)seg * 1024 * 6144; t.K = 1024; t.N = 6144; t.WT = WB + WE_RIN + (size_t)seg * 6144 * 1024; t.rp = true; t.f8 = FP8_INPROJ != 0; }
    else if (seg < 4) { const int j = seg - 2; t.W = a.in[I_RWOUT] + (size_t)j * 2048 * 1024; t.K = 2048; t.N = 1024; t.WT = WB + WE_ROUT + (size_t)j * 1024 * 2048; t.f8 = FP8_OUTPROJ != 0; }
    else if (seg == 4) { t.W = a.in[I_FNW]; t.K = 1024; t.N = 1024; t.WT = WB + WE_FN; t.f8 = FP8_OUT2 != 0; }
    else if (seg == 5) { t.W = a.in[I_NAQKV]; t.K = 1024; t.N = 3072; t.WT = WB + WE_NQKV; t.f8 = FP8_INPROJ != 0; }
    else if (seg == 6) { t.W = a.in[I_NAOUT]; t.K = 1024; t.N = 1024; t.WT = WB + WE_NOUT; t.f8 = FP8_OUT2 != 0; }
    else { const int l = (seg - 7) / 3, which = (seg - 7) % 3, mi = l * 16 + (li >> 8); t.item = li & 255; t.K = 1024; t.N = 1024;
        t.W = a.in[which == 0 ? I_MG : which == 1 ? I_MU : I_MD] + (size_t)mi * 1048576; t.f8 = true;
        t.WT = (bf16*)((unsigned char*)(WB + (which == 0 ? WE_MG : which == 1 ? WE_MU : WE_MD)) + (size_t)mi * 1048576); }
    return t;
}
constexpr int BG_NSEG = 19;
constexpr int BG_NEED_RIN0 = 1536, BG_NEED_ROUT0 = BG_NEED_RIN0 + 512, BG_NEED_MOE0 = BG_NEED_ROUT0 + 3 * 4096, BG_NEED_FN = BG_NEED_MOE0 + 256, BG_NEED_MOE1 = BG_NEED_FN + 3 * 4096,
              BG_NEED_NQKV = BG_NEED_MOE1 + 768, BG_NEED_NOUT = BG_NEED_NQKV + 256, BG_NEED_MOE2 = BG_NEED_NOUT + 3 * 4096, BG_NEED_RIN1 = BG_NEED_MOE2 + 1536, BG_NEED_ROUT1 = BG_NEED_RIN1 + 512,
              BG_TOTAL = BG_NEED_ROUT1 + 3 * 4096;
constexpr int CW_QHEAD = 4096, CW_PHDONE = 8192;
__device__ __forceinline__ TItem bg_decode(const Args& a, bf16* WB, int it) {
    const int segs[BG_NSEG] = {0, 2, 7, 8, 9, 4, 10, 11, 12, 5, 6, 13, 14, 15, 1, 3, 16, 17, 18};
    return titem_decode<BG_NSEG>(a, WB, segs, it);
}
__device__ __forceinline__ void bg_work(const Args& a, unsigned char* wso, LAS unsigned char* lds, volatile LAS unsigned* misc, int wave, int lane, int ph, bool busy, int need) {
    unsigned* ctl = (unsigned*)(wso + WS_CTL);
    bf16* WB = (bf16*)(wso + WS_W);
    LAS float* scr = (LAS float*)lds + wave * (64 * 65);
    for (;;) {
        __syncthreads();
        if (wave == 0 && lane == 0) {
            const unsigned h = __hip_atomic_load(ctl + CW_QHEAD, __ATOMIC_RELAXED, __HIP_MEMORY_SCOPE_AGENT);
            unsigned base = (unsigned)BG_TOTAL;
            bool go = h < (unsigned)BG_TOTAL;
            if (go && h >= (unsigned)need) { if (busy) go = false; else if (__hip_atomic_load(ctl + CW_PHDONE + 64 * ph, __ATOMIC_RELAXED, __HIP_MEMORY_SCOPE_AGENT) != 0u) go = false; }
            if (go) base = __hip_atomic_fetch_add(ctl + CW_QHEAD, 64u, __ATOMIC_RELAXED, __HIP_MEMORY_SCOPE_AGENT);
            misc[64] = base;
        }
        __syncthreads();
        const int base = (int)misc[64];
        if (base >= BG_TOTAL) break;
        f32x4 va[16], vb[16];
        TItem ta = bg_decode(a, WB, min(base + wave, BG_TOTAL - 1)), tb = ta;
        bool oka = base + wave < BG_TOTAL, okb = false;
        if (oka) titem_load(ta, va, lane);
#pragma unroll 1
        for (int i = 0; i < 8; i += 2) {
            const int ib = base + wave + 8 * (i + 1), ia2 = base + wave + 8 * (i + 2);
            okb = ib < BG_TOTAL; if (okb) { tb = bg_decode(a, WB, ib); titem_load(tb, vb, lane); }
            if (oka) titem_store(ta, va, scr, lane);
            oka = (i + 2 < 8) && ia2 < BG_TOTAL; if (oka) { ta = bg_decode(a, WB, ia2); titem_load(ta, va, lane); }
            if (okb) titem_store(tb, vb, scr, lane);
        }
    }
}
__device__ __forceinline__ void bg_signal(unsigned char* wso, int ph) {
    __hip_atomic_fetch_add((unsigned*)(wso + WS_CTL) + CW_PHDONE + 64 * ph, 1u, __ATOMIC_RELAXED, __HIP_MEMORY_SCOPE_AGENT);
}

__device__ __forceinline__ void p_prologue(Frame& F, const Args& a) {
    int tid = tid_of(F.wv); asm volatile("" : "+v"(tid)); const int lane = tid & 63, wave = __builtin_amdgcn_readfirstlane(tid >> 6); (void)lane; (void)wave;
    GAS unsigned char* wsg_ = (GAS unsigned char*)F.ws; asm volatile("" : "+s"(wsg_)); unsigned char* wso = (unsigned char*)wsg_;
    for (int rr_ = 0; rr_ < NREP(16); ++rr_) if ((int)blockIdx.x < NLAYER * 48) {
        LAS float* act = (LAS float*)F.lds;
        LAS float* red = act + 5 * 1024;
        for (int idx = tid; idx < 5 * 1024; idx += 512) { const int r = idx >> 10, k = idx & 1023; const float v = (r < 4) ? a.in[I_C][r * 1024 + k] : a.in[I_CCTX][k]; act[idx] = silu_f(v); }
        __syncthreads();
        {
            const int u = (int)blockIdx.x;
            const int layer = u / 48, n0 = (u % 48) * 128;
            const float* w = a.in[I_WMOD] + (size_t)layer * 1024 * 6144 + n0 + 2 * lane;
            f32x2 s0 = (f32x2){0.f, 0.f}, s1 = s0, s2 = s0, s3 = s0, s4 = s0;
            const int kb = wave * 128;
#pragma unroll 16
            for (int k = 0; k < 128; ++k) { const f32x2 wv = *(const f32x2*)(w + (size_t)(kb + k) * 6144);
                s0 += wv * act[kb + k]; s1 += wv * act[1024 + kb + k]; s2 += wv * act[2048 + kb + k]; s3 += wv * act[3072 + kb + k]; s4 += wv * act[4096 + kb + k]; }
            *(LAS f32x2*)(red + (wave * 5 + 0) * 128 + 2 * lane) = s0; *(LAS f32x2*)(red + (wave * 5 + 1) * 128 + 2 * lane) = s1; *(LAS f32x2*)(red + (wave * 5 + 2) * 128 + 2 * lane) = s2;
            *(LAS f32x2*)(red + (wave * 5 + 3) * 128 + 2 * lane) = s3; *(LAS f32x2*)(red + (wave * 5 + 4) * 128 + 2 * lane) = s4;
            __syncthreads();
            for (int o = tid; o < 5 * 128; o += 512) { const int r = o >> 7, l = o & 127; float sm = 0.f;
#pragma unroll
                for (int w8 = 0; w8 < 8; ++w8) sm += red[(w8 * 5 + r) * 128 + l];
                const int nn = n0 + l; sm += a.in[I_BMOD][layer * 6144 + nn];
                ((float*)(wso + WS_MOD))[((size_t)(layer * 5 + r) * NMOD + nn / 1024) * D + (nn & 1023)] = sm; }
            __syncthreads();
        }
    }
    __syncthreads();
    for (int rr_ = 0; rr_ < NREP(17); ++rr_) {
        bf16* AL = (bf16*)(wso + WS_AL);
        const int nchunk = 8 * 512 * 1024 / 8;
        for (int ch = F.vcu * 512 + tid; ch < nchunk; ch += F.G * 512) {
            const int r = ch >> 16, m = (ch >> 7) & 511, k0 = (ch & 127) * 8;
            const int mul = 8 * m + r;
            float v[8];
#pragma unroll
            for (int e = 0; e < 8; ++e) { const int l = 4 * (k0 >> 3) + (e & 3); const float x = (float)((mul * l) & 4095) * (1.f / 4096.f);
                v[e] = (e < 4) ? __builtin_amdgcn_cosf(x) * (1.f / 64.f) : -__builtin_amdgcn_sinf(x) * (1.f / 64.f); }
            if (FP8_F2) { int t0 = __builtin_amdgcn_cvt_pk_fp8_f32(v[0] * 256.f, v[1] * 256.f, 0, false); t0 = __builtin_amdgcn_cvt_pk_fp8_f32(v[2] * 256.f, v[3] * 256.f, t0, true);
                int t1 = __builtin_amdgcn_cvt_pk_fp8_f32(v[4] * 256.f, v[5] * 256.f, 0, false); t1 = __builtin_amdgcn_cvt_pk_fp8_f32(v[6] * 256.f, v[7] * 256.f, t1, true);
                *(u32x2*)((unsigned char*)AL + (size_t)r * 512 * 1024 + (size_t)m * 1024 + k0) = (u32x2){(unsigned)t0, (unsigned)t1}; }
            else {
            u32x4 o; o.x = pk2(v[0], v[1]); o.y = pk2(v[2], v[3]); o.z = pk2(v[4], v[5]); o.w = pk2(v[6], v[7]);
            *(u32x4*)(AL + (size_t)r * 512 * 1024 + (size_t)m * 1024 + k0) = o; }
        }
        if (F.vcu == 4 % F.G) {
            bf16* A1N = (bf16*)(wso + WS_A1N);
            for (int idx = tid; idx < 512 * 256; idx += 512) { const int row = idx >> 8, c = idx & 255, chh = row >> 8, sgn = (row >> 7) & 1, cp = chh * 128 + (row & 127); const float x = (float)((c * cp) & 255) * (1.f / 256.f);
                const float v = (sgn == 0) ? __builtin_amdgcn_cosf(x) : __builtin_amdgcn_sinf(x); A1N[idx] = (bf16)f2bf(v * (1.f / 16.f)); }
        }
        if (F.vcu == 2 % F.G) {
            bf16* A1 = (bf16*)(wso + WS_A1);
            for (int idx = tid; idx < 512 * 256; idx += 512) { const int row = idx >> 8, c = idx & 255, sgn = row >> 8, cp = row & 255; const float x = (float)((c * cp) & 255) * (1.f / 256.f);
                const float v = (sgn == 0) ? __builtin_amdgcn_cosf(x) : __builtin_amdgcn_sinf(x); A1[idx] = (bf16)f2bf(v * (1.f / 16.f)); }
        }
        if (F.vcu == 3 % F.G) {
            bf16* ALC = (bf16*)(wso + WS_ALC);
            for (int idx = tid; idx < 256 * 512; idx += 512) { const int lp = idx >> 9, k = idx & 511, kk = k & 255; const float x = (float)((lp * kk) & 255) * (1.f / 256.f);
                const float v = (k < 256) ? __builtin_amdgcn_cosf(x) : -__builtin_amdgcn_sinf(x); ALC[idx] = (bf16)f2bf(v * (1.f / 16.f)); }
        }
        if (F.vcu == 1 % F.G) {
            f32x2* rt = (f32x2*)(wso + WS_ROPE);
            for (int idx = tid; idx < 64 * 64; idx += 512) { const int pos = idx >> 6, f = idx & 63; const float inv = powf(10000.f, -(float)f / 64.f); const float ang = (float)pos * inv;
                rt[idx] = (f32x2){cosf(ang), sinf(ang)}; }
        }
        __syncthreads();
    }
    bg_work(a, wso, F.lds, F.MISC, wave, lane, 0, true, BG_NEED_RIN0);
}

struct Row16 { f32x4 v[4]; };
__device__ __forceinline__ Row16 ld_row_f32(const float* p, int lane) { Row16 r;
#pragma unroll
    for (int j = 0; j < 4; ++j) r.v[j] = *(const f32x4*)(p + 256 * j + 4 * lane);
    return r; }
__device__ __forceinline__ void st_row_f32(float* p, int lane, const Row16& r) {
#pragma unroll
    for (int j = 0; j < 4; ++j) *(f32x4*)(p + 256 * j + 4 * lane) = r.v[j]; }
__device__ __forceinline__ Row16 ld_row_bf16(const bf16* p, int lane) { Row16 r;
#pragma unroll
    for (int j = 0; j < 4; ++j) { const u32x2 u = *(const u32x2*)(p + 256 * j + 4 * lane); r.v[j] = (f32x4){bflo(u.x), bfhi(u.x), bflo(u.y), bfhi(u.y)}; }
    return r; }
__device__ __forceinline__ void st_row_bf16(bf16* p, int lane, const Row16& r) {
#pragma unroll
    for (int j = 0; j < 4; ++j) { u32x2 u; u.x = pk2(r.v[j][0], r.v[j][1]); u.y = pk2(r.v[j][2], r.v[j][3]); *(u32x2*)(p + 256 * j + 4 * lane) = u; } }
__device__ __forceinline__ float row_rstd(const Row16& r, int lane) { float s = 0.f;
#pragma unroll
    for (int j = 0; j < 4; ++j) s += (r.v[j][0] * r.v[j][0] + r.v[j][1] * r.v[j][1]) + (r.v[j][2] * r.v[j][2] + r.v[j][3] * r.v[j][3]);
    return rsqrtf(wave_sum(s, lane) * (1.f / D) + EPS); }

#define PRE_NPF 3
__device__ __forceinline__ void st_row_fp8(unsigned char* p, int lane, const Row16& r) {
#pragma unroll
    for (int j = 0; j < 4; ++j) { int t = __builtin_amdgcn_cvt_pk_fp8_f32(r.v[j][0], r.v[j][1], 0, false); t = __builtin_amdgcn_cvt_pk_fp8_f32(r.v[j][2], r.v[j][3], t, true); *(int*)(p + 256 * j + 4 * lane) = t; } }
template <int MODE>
__device__ __forceinline__ void p_pre(Frame& F, const Args& a, int layer) {
    int tid = tid_of(F.wv); asm volatile("" : "+v"(tid)); const int lane = tid & 63, wave = __builtin_amdgcn_readfirstlane(tid >> 6); (void)lane; (void)wave;
    GAS unsigned char* wsg_ = (GAS unsigned char*)F.ws; asm volatile("" : "+s"(wsg_)); unsigned char* wso = (unsigned char*)wsg_;
    int vcu_o = F.vcu; asm volatile("" : "+s"(vcu_o));
    const int gw = vcu_o * 8 + wave, NGW = F.G * 8;
    bf16* XALL = (bf16*)(wso + WS_XALL); bf16* ACT = (bf16*)(wso + WS_ACT);
    const bf16* YB = (const bf16*)(wso + WS_YB); const int* DEST = (const int*)(wso + WS_DEST); const float* ROUTE = (const float*)(wso + WS_ROUTE);
    const int nrows = (MODE == 2) ? NLAT : NTOK;
    const bool fold = (MODE == 1) && (layer == 1);
    const bool f8act = FP8_INPROJ && (MODE == 0 || (MODE == 1 && layer != 1));
    const int nitems = fold ? (NLAT / 4 + NCTX) : nrows;
    const int it0 = (int)((unsigned)(gw * nitems) / (unsigned)NGW), it1 = (int)((unsigned)((gw + 1) * nitems) / (unsigned)NGW);
    const int nseq = (it1 - it0) << (fold ? 2 : 0);
    auto row_of = [&](int p) -> int {
        if (!fold) return it0 + p;
        const int item = it0 + (p >> 2), q = p & 3;
        if (item < NLAT / 4) return (item >> 10) * 4096 + (item & 1023) + ((q & 1) * 2 + (q >> 1)) * 1024;
        return q ? -1 : NLAT + (item - NLAT / 4); };
    const Row16 nw = ld_row_f32((MODE < 2 ? a.in[I_NMIX] + layer * D : a.in[I_NFIN]), lane);
    int dd0 = 0, dd1 = 0, ww0 = 0, ww1 = 0;
    if (MODE > 0) { const int r = row_of(lane); if (lane < nseq && r >= 0) { const u32x2 dv = *(const u32x2*)(DEST + r * 2); const u32x2 wv = *(const u32x2*)(ROUTE + r * 8 + 4); dd0 = (int)dv.x; dd1 = (int)dv.y; ww0 = (int)wv.x; ww1 = (int)wv.y; } }
    struct Slot { f32x4 xf[MODE == 0 ? 4 : 1]; u32x2 x[MODE == 0 ? 1 : 4], y0[MODE == 0 ? 1 : 4], y1[MODE == 0 ? 1 : 4]; };
    auto issue = [&](Slot& S, int p) {
        int pc = p < nseq ? p : nseq - 1; int r = row_of(pc); if (r < 0) { pc &= ~3; r = row_of(pc); }
        if (MODE == 0) { const float* src = r < NLAT ? a.in[I_X] + (size_t)r * D : a.in[I_CTX] + (size_t)(r - NLAT) * D;
#pragma unroll
            for (int j = 0; j < 4; ++j) S.xf[j] = *(const f32x4*)(src + 256 * j + 4 * lane);
        } else {
            const int d0 = __builtin_amdgcn_readlane(dd0, pc), d1 = __builtin_amdgcn_readlane(dd1, pc);
            const bf16* px = XALL + (size_t)r * D; const bf16* p0 = YB + (size_t)d0 * D; const bf16* p1 = YB + (size_t)d1 * D;
#pragma unroll
            for (int j = 0; j < 4; ++j) S.x[j] = *(const u32x2*)(px + 256 * j + 4 * lane);
#pragma unroll
            for (int j = 0; j < 4; ++j) { if (FP8_YB) S.y0[j].x = *(const unsigned*)((const unsigned char*)YB + (size_t)d0 * D + 256 * j + 4 * lane); else S.y0[j] = *(const u32x2*)(p0 + 256 * j + 4 * lane); }
#pragma unroll
            for (int j = 0; j < 4; ++j) { if (FP8_YB) S.y1[j].x = *(const unsigned*)((const unsigned char*)YB + (size_t)d1 * D + 256 * j + 4 * lane); else S.y1[j] = *(const u32x2*)(p1 + 256 * j + 4 * lane); }
        } };
    int cur_bi = -1; Row16 gp, sh, sc, hA, hB;
    auto consume = [&](const Slot& S, int p) {
        const int row = row_of(p);
        if (row < 0) return;
        const int bi = bidx_of_row(row);
        if (bi != cur_bi) { cur_bi = bi;
            if (MODE > 0) gp = ld_row_f32(modv(wso, layer - 1, bi, 5), lane);
            if (MODE < 2) { sh = ld_row_f32(modv(wso, layer, bi, 0), lane); sc = ld_row_f32(modv(wso, layer, bi, 1), lane); } }
        Row16 x;
        if (MODE == 0) {
#pragma unroll
            for (int j = 0; j < 4; ++j) x.v[j] = S.xf[j];
        } else {
            const float ysc = FP8_YB ? pg8::FP8_WSCALE : 1.f;
            const float w0 = __builtin_bit_cast(float, __builtin_amdgcn_readlane(ww0, p)) * ysc, w1 = __builtin_bit_cast(float, __builtin_amdgcn_readlane(ww1, p)) * ysc;
#pragma unroll
            for (int j = 0; j < 4; ++j) {
                const f32x4 xv = {bflo(S.x[j].x), bfhi(S.x[j].x), bflo(S.x[j].y), bfhi(S.x[j].y)};
                f32x4 a0, a1;
                if (FP8_YB) { const f32x2 l0 = __builtin_amdgcn_cvt_pk_f32_fp8((int)S.y0[j].x, false), h0 = __builtin_amdgcn_cvt_pk_f32_fp8((int)S.y0[j].x, true), l1 = __builtin_amdgcn_cvt_pk_f32_fp8((int)S.y1[j].x, false), h1 = __builtin_amdgcn_cvt_pk_f32_fp8((int)S.y1[j].x, true);
                    a0 = (f32x4){l0.x, l0.y, h0.x, h0.y}; a1 = (f32x4){l1.x, l1.y, h1.x, h1.y}; }
                else { a0 = (f32x4){bflo(S.y0[j].x), bfhi(S.y0[j].x), bflo(S.y0[j].y), bfhi(S.y0[j].y)}; a1 = (f32x4){bflo(S.y1[j].x), bfhi(S.y1[j].x), bflo(S.y1[j].y), bfhi(S.y1[j].y)}; }
                x.v[j] = xv + gp.v[j] * (a0 * w0 + a1 * w1); }
        }
        Row16 h;
        const float rs = row_rstd(x, lane);
        if (MODE < 2) {
            st_row_bf16(XALL + (size_t)row * D, lane, x);
#pragma unroll
            for (int j = 0; j < 4; ++j) h.v[j] = (x.v[j] * rs) * nw.v[j] * (sc.v[j] + 1.f) + sh.v[j];
            if (fold && row < NLAT) {
                const int q = p & 3;
                bf16* ab = ACT + (size_t)((row & ~4095) + (row & 1023)) * D;
                if (q == 0) hA = h;
                else if (q == 1) { Row16 o2;
#pragma unroll
                    for (int j = 0; j < 4; ++j) { o2.v[j] = hA.v[j] - h.v[j]; hA.v[j] = hA.v[j] + h.v[j]; }
                    st_row_bf16(ab + (size_t)2048 * D, lane, o2); }
                else if (q == 2) hB = h;
                else { Row16 o0, o1, o3;
#pragma unroll
                    for (int j = 0; j < 4; ++j) { const f32x4 od = hB.v[j] + h.v[j]; o0.v[j] = hA.v[j] + od; o1.v[j] = hA.v[j] - od; o3.v[j] = h.v[j] - hB.v[j]; }
                    st_row_bf16(ab, lane, o0); st_row_bf16(ab + (size_t)1024 * D, lane, o1); st_row_bf16(ab + (size_t)3072 * D, lane, o3); }
            } else if (f8act) st_row_fp8((unsigned char*)ACT + (size_t)row * D, lane, h);
            else st_row_bf16(ACT + (size_t)row * D, lane, h);
        } else {
#pragma unroll
            for (int j = 0; j < 4; ++j) h.v[j] = (x.v[j] * rs) * nw.v[j];
            st_row_f32(a.out + (size_t)row * D, lane, h);
        } };
    Slot ring[PRE_NPF];
#pragma unroll
    for (int u = 0; u < PRE_NPF; ++u) issue(ring[u], u);
    for (int pb = 0; pb < nseq; pb += PRE_NPF) {
#pragma unroll
        for (int u = 0; u < PRE_NPF; ++u) { const int p = pb + u; if (p < nseq) consume(ring[u], p); issue(ring[u], p + PRE_NPF); }
    }
}

#define MID_RS 2064
__device__ __forceinline__ void p_mid(Frame& F, const Args& a, int layer, int nrows) {
    int tid = tid_of(F.wv); asm volatile("" : "+v"(tid)); const int lane = tid & 63, wave = __builtin_amdgcn_readfirstlane(tid >> 6); (void)lane; (void)wave;
    GAS unsigned char* wsg_ = (GAS unsigned char*)F.ws; asm volatile("" : "+s"(wsg_)); unsigned char* wso = (unsigned char*)wsg_;
    int vcu_o = F.vcu; asm volatile("" : "+s"(vcu_o));
    const int gw = vcu_o * 8 + wave, NGW = F.G * 8;
    const bf16* XALL = (const bf16*)(wso + WS_XALL); unsigned char* ACT8 = wso + WS_ACT;
    LAS unsigned char* wh = F.lds; LAS unsigned char* wl = F.lds + 16 * MID_RS;
    LAS int* cnt = (LAS int*)(F.lds + 66048);
    LAS float* stage = (LAS float*)(F.lds + 66560) + wave * 256;
    LAS float* ps = (LAS float*)(F.lds + 75776) + wave * 2048;
    const int ngroups = nrows >> 4;
    const int g0 = (int)((unsigned)(gw * ngroups) / (unsigned)NGW), g1 = (int)((unsigned)((gw + 1) * ngroups) / (unsigned)NGW);
    const int n = lane & 15, kg = lane >> 4;
    for (int c = tid; c < 4096; c += 512) { const f32x4 v = *(const f32x4*)(a.in[I_RTW] + 4 * c); const int k = c >> 2, e4 = (c & 3) * 4;
#pragma unroll
        for (int i = 0; i < 4; ++i) { const unsigned hb = f2bf(v[i]); const float rem = v[i] - __builtin_bit_cast(float, hb << 16);
            *(LAS unsigned short*)(wh + (e4 + i) * MID_RS + 2 * k) = (unsigned short)hb; *(LAS unsigned short*)(wl + (e4 + i) * MID_RS + 2 * k) = (unsigned short)f2bf(rem); } }
    if (tid < 16) cnt[tid] = 0;
    __syncthreads();
    float rbias[16];
#pragma unroll
    for (int e = 0; e < 16; ++e) rbias[e] = a.in[I_RTB][e];
    int cur_bi = -1;
    for (int g = g0; g < g1; ++g) {
        const int row = 16 * g + n;
        u32x4 ring[8];
        const bf16* px = XALL + (size_t)row * D + 8 * kg;
#pragma unroll
        for (int c = 0; c < 8; ++c) ring[c] = *(const u32x4*)(px + 32 * c);
        const int bi = bidx_of_row(16 * g);
        if (bi != cur_bi) { cur_bi = bi;
            const float* nwp = a.in[I_NFFN] + layer * D; const float* shp = modv(wso, layer, bi, 3); const float* scp = modv(wso, layer, bi, 4);
#pragma unroll
            for (int i = 0; i < 4; ++i) { const int o = 4 * (lane + 64 * i); const f32x4 nwv = *(const f32x4*)(nwp + o), scv = *(const f32x4*)(scp + o), shv = *(const f32x4*)(shp + o);
                *(LAS f32x4*)(ps + o) = nwv * (scv + 1.f); *(LAS f32x4*)(ps + 1024 + o) = shv; } }
        float ss = 0.f;
#pragma unroll
        for (int c = 0; c < 32; ++c) { const u32x4 xv = ring[c & 7];
            ring[c & 7] = *(const u32x4*)(px + 32 * ((c + 8) & 31));
#pragma unroll
            for (int i = 0; i < 4; ++i) { const float v0 = bflo(xv[i]), v1 = bfhi(xv[i]); ss += v0 * v0 + v1 * v1; } }
        ss += shx(ss, 16, lane); ss += shx(ss, 32, lane);
        const float rs = rsqrtf(ss * (1.f / D) + EPS);
        f32x4 acc = (f32x4){0.f, 0.f, 0.f, 0.f};
        unsigned char* arow = ACT8 + (size_t)row * D + 8 * kg;
        const LAS unsigned char* whp = wh + n * MID_RS + 16 * kg; const LAS unsigned char* wlp = wl + n * MID_RS + 16 * kg;
        const LAS float* psp = ps + 8 * kg;
#pragma unroll
        for (int c = 0; c < 32; ++c) {
            const f32x4 P0 = *(const LAS f32x4*)(psp + 32 * c), P1 = *(const LAS f32x4*)(psp + 32 * c + 4), S0 = *(const LAS f32x4*)(psp + 1024 + 32 * c), S1 = *(const LAS f32x4*)(psp + 1024 + 32 * c + 4);
            const u32x4 xv = ring[c & 7];
            if (c + 8 < 32) ring[c & 7] = *(const u32x4*)(px + 32 * (c + 8));
            const f32x4 x0 = {bflo(xv[0]), bfhi(xv[0]), bflo(xv[1]), bfhi(xv[1])}, x1 = {bflo(xv[2]), bfhi(xv[2]), bflo(xv[3]), bfhi(xv[3])};
            const f32x4 f0 = (x0 * rs) * P0 + S0, f1 = (x1 * rs) * P1 + S1;
            { int t0 = __builtin_amdgcn_cvt_pk_fp8_f32(f0[0], f0[1], 0, false); t0 = __builtin_amdgcn_cvt_pk_fp8_f32(f0[2], f0[3], t0, true);
              int t1 = __builtin_amdgcn_cvt_pk_fp8_f32(f1[0], f1[1], 0, false); t1 = __builtin_amdgcn_cvt_pk_fp8_f32(f1[2], f1[3], t1, true);
              *(u32x2*)(arow + 32 * c) = (u32x2){(unsigned)t0, (unsigned)t1}; }
            u32x4 hb, lb;
            hb[0] = pk2(f0[0], f0[1]); hb[1] = pk2(f0[2], f0[3]); hb[2] = pk2(f1[0], f1[1]); hb[3] = pk2(f1[2], f1[3]);
            lb[0] = pk2(f0[0] - bflo(hb[0]), f0[1] - bfhi(hb[0])); lb[1] = pk2(f0[2] - bflo(hb[1]), f0[3] - bfhi(hb[1]));
            lb[2] = pk2(f1[0] - bflo(hb[2]), f1[1] - bfhi(hb[2])); lb[3] = pk2(f1[2] - bflo(hb[3]), f1[3] - bfhi(hb[3]));
            const bf16x8 bh = __builtin_bit_cast(bf16x8, hb), bl = __builtin_bit_cast(bf16x8, lb);
            const bf16x8 ah = *(const LAS bf16x8*)(whp + 64 * c), al = *(const LAS bf16x8*)(wlp + 64 * c);
            acc = __builtin_amdgcn_mfma_f32_16x16x32_bf16(ah, bh, acc, 0, 0, 0); acc = __builtin_amdgcn_mfma_f32_16x16x32_bf16(ah, bl, acc, 0, 0, 0); acc = __builtin_amdgcn_mfma_f32_16x16x32_bf16(al, bh, acc, 0, 0, 0);
            __builtin_amdgcn_sched_barrier(0);
        }
        *(LAS f32x4*)(stage + n * 16 + 4 * kg) = acc;
        {
            const bool act = lane < 16;
            const int rl = lane & 15;
            float sel[16], sco[16];
#pragma unroll
            for (int e4 = 0; e4 < 4; ++e4) { const f32x4 v = *(const LAS f32x4*)(stage + rl * 16 + 4 * e4);
#pragma unroll
                for (int i = 0; i < 4; ++i) { const int e = 4 * e4 + i; sco[e] = __builtin_amdgcn_rcpf(1.f + __expf(-v[i])); sel[e] = sco[e] + rbias[e]; } }
            int gbest = 0; float gbs = -1e30f;
#pragma unroll
            for (int gq = 0; gq < 4; ++gq) { float m1 = -1e30f, m2 = -1e30f;
#pragma unroll
                for (int l = 0; l < 4; ++l) { const float v = sel[4 * gq + l]; if (v > m1) { m2 = m1; m1 = v; } else if (v > m2) m2 = v; }
                const float gs = m1 + m2; if (gs > gbs) { gbs = gs; gbest = gq; } }
            float gsel[4], gsco[4];
#pragma unroll
            for (int l = 0; l < 4; ++l) { gsel[l] = sel[0 * 4 + l]; gsco[l] = sco[0 * 4 + l]; }
#pragma unroll
            for (int gq = 1; gq < 4; ++gq) if (gbest == gq) {
#pragma unroll
                for (int l = 0; l < 4; ++l) { gsel[l] = sel[gq * 4 + l]; gsco[l] = sco[gq * 4 + l]; } }
            int l0 = 0; float b0 = gsel[0];
#pragma unroll
            for (int l = 1; l < 4; ++l) if (gsel[l] > b0) { b0 = gsel[l]; l0 = l; }
            int l1 = -1; float b1 = -1e30f;
#pragma unroll
            for (int l = 0; l < 4; ++l) if (l != l0 && gsel[l] > b1) { b1 = gsel[l]; l1 = l; }
            float s0 = gsco[0], s1 = gsco[0];
#pragma unroll
            for (int l = 1; l < 4; ++l) { if (l0 == l) s0 = gsco[l]; if (l1 == l) s1 = gsco[l]; }
            const int e0 = gbest * 4 + l0, e1 = gbest * 4 + l1;
            const float inv = 1.f / (s0 + s1);
            if (act) {
                const int r0 = atomicAdd((int*)&cnt[e0], 1), r1 = atomicAdd((int*)&cnt[e1], 1);
                int* R = (int*)(wso + WS_ROUTE) + (size_t)(16 * g + lane) * 8;
                *(u32x4*)R = (u32x4){(unsigned)e0, (unsigned)e1, (unsigned)r0, (unsigned)r1}; *(f32x2*)(R + 4) = (f32x2){s0 * inv, s1 * inv};
            }
        }
    }
    __syncthreads();
    if (tid < 16) ((int*)(wso + WS_BLKCNT))[blockIdx.x * 16 + tid] = cnt[tid];
    __syncthreads();
}

__device__ __forceinline__ void p_perm(Frame& F, int nrows) {
    int tid = tid_of(F.wv); asm volatile("" : "+v"(tid)); const int lane = tid & 63, wave = __builtin_amdgcn_readfirstlane(tid >> 6); (void)lane; (void)wave;
    GAS unsigned char* wsg_ = (GAS unsigned char*)F.ws; asm volatile("" : "+s"(wsg_)); unsigned char* wso = (unsigned char*)wsg_;
    int vcu_o = F.vcu; asm volatile("" : "+s"(vcu_o));
    const int gw = vcu_o * 8 + wave, NGW = F.G * 8;
    LAS int* tab = (LAS int*)F.lds;
    LAS int* base = tab + 256 * 16;
    LAS int* part = base + 64;
    const int* BC = (const int*)(wso + WS_BLKCNT);
    const unsigned char* ACT = (const unsigned char*)(wso + WS_ACT); unsigned char* XP = (unsigned char*)(wso + WS_XP); int* DEST = (int*)(wso + WS_DEST);
    const int ngroups = nrows >> 4;
    const int r0w = 16 * (int)((unsigned)(gw * ngroups) / (unsigned)NGW), r1w = 16 * (int)((unsigned)((gw + 1) * ngroups) / (unsigned)NGW);
    const int nmine = r1w - r0w;
    constexpr int PERM_MAXR = 16;
    u32x4 rt = {0u, 0u, 0u, 0u};
    if (lane < nmine) rt = *(const u32x4*)((const int*)(wso + WS_ROUTE) + (size_t)(r0w + lane) * 8);
    u32x4 rowv[PERM_MAXR];
#pragma unroll
    for (int i = 0; i < PERM_MAXR; ++i) { const int row = min(r0w + i, r1w - 1); rowv[i] = *(const u32x4*)(ACT + (size_t)row * D + 16 * lane); }
    for (int idx = tid; idx < F.G * 16; idx += 512) tab[idx] = BC[idx];
    __syncthreads();
    {
        const int e = tid & 15, pt = tid >> 4; const int per = (F.G + 31) >> 5; const int b0 = pt * per, b1 = min(b0 + per, F.G);
        int t = 0, m = 0;
        for (int b = b0; b < b1; ++b) { const int v = tab[b * 16 + e]; m += (b < (int)blockIdx.x) ? v : 0; t += v; }
        part[(pt * 16 + e) * 2] = t; part[(pt * 16 + e) * 2 + 1] = m;
    }
    __syncthreads();
    if (tid < 16) {
        int t = 0, m = 0;
#pragma unroll 4
        for (int pt = 0; pt < 32; ++pt) { t += part[(pt * 16 + tid) * 2]; m += part[(pt * 16 + tid) * 2 + 1]; }
        const int padded = (t + 255) & ~255;
        int incl = padded;
#pragma unroll
        for (int o = 1; o < 16; o <<= 1) { const int up = __builtin_amdgcn_ds_bpermute(((lane - o) & 63) << 2, incl); if (tid >= o) incl += up; }
        const int ps = incl - padded;
        base[tid] = ps + m;
        if (blockIdx.x == 0) { ((int*)(wso + WS_MOETAB))[tid] = ps >> 8; if (tid == 15) ((int*)(wso + WS_MOETAB))[16] = incl >> 8; }
    }
    __syncthreads();
    const int e0 = (int)rt.x, e1 = (int)rt.y;
    const int d0 = base[e0 & 15] + (int)rt.z, d1 = base[e1 & 15] + (int)rt.w;
    if (lane < nmine) *(u32x2*)(DEST + (size_t)(r0w + lane) * 2) = (u32x2){(unsigned)d0, (unsigned)d1};
#pragma unroll
    for (int i = 0; i < PERM_MAXR; ++i) if (i < nmine) {
        const int q0 = __builtin_amdgcn_readlane(d0, i), q1 = __builtin_amdgcn_readlane(d1, i);
        *(u32x4*)(XP + (size_t)q0 * D + 16 * lane) = rowv[i]; *(u32x4*)(XP + (size_t)q1 * D + 16 * lane) = rowv[i];
    }
}

using pg8::Unit;
__device__ __forceinline__ unsigned cvt_pk_bf16(float lo, float hi) { unsigned r; asm volatile("v_cvt_pk_bf16_f32 %0, %1, %2" : "=v"(r) : "v"(lo), "v"(hi)); return r; }
__device__ __forceinline__ u32x4 pack8(const f32x4& v0, const f32x4& v1) { u32x4 o; o.x = cvt_pk_bf16(v0[0], v0[1]); o.y = cvt_pk_bf16(v0[2], v0[3]); o.z = cvt_pk_bf16(v1[0], v1[1]); o.w = cvt_pk_bf16(v1[2], v1[3]); return o; }

struct EpiResid {
    static constexpr bool PERM = false;
    bf16* X; const unsigned char* ws; int layer, which; float scale = 1.f;
    __device__ __forceinline__ void operator()(const f32x4 (&acc)[2][2][4][2], const Unit& u, int wr, int wc, int fr, int fq) const {
        const int row0 = u.pm * 256 + wr * 64 + fr, col0 = u.pn * 256 + wc * 32 + 4 * fq;
        const float* g = modv(ws, layer, bidx_of_row(u.pm * 256), which);
        f32x4 gv[2][2];
#pragma unroll
        for (int bj = 0; bj < 2; ++bj)
#pragma unroll
            for (int n = 0; n < 2; ++n) gv[bj][n] = *(const f32x4*)(g + col0 + bj * 128 + n * 16) * scale;
#pragma unroll
        for (int ai = 0; ai < 2; ++ai)
#pragma unroll
            for (int m = 0; m < 4; ++m) { bf16* rowp = X + (size_t)(row0 + ai * 128 + m * 16) * D + col0;
                u32x2 xv[2][2];
#pragma unroll
                for (int bj = 0; bj < 2; ++bj)
#pragma unroll
                    for (int n = 0; n < 2; ++n) xv[bj][n] = *(const u32x2*)(rowp + bj * 128 + n * 16);
#pragma unroll
                for (int bj = 0; bj < 2; ++bj)
#pragma unroll
                    for (int n = 0; n < 2; ++n) { const f32x4 y = gv[bj][n] * acc[ai][bj][m][n]; const u32x2 x = xv[bj][n]; u32x2 o;
                        o.x = cvt_pk_bf16(bflo(x.x) + y[0], bfhi(x.x) + y[1]); o.y = cvt_pk_bf16(bflo(x.y) + y[2], bfhi(x.y) + y[3]); *(u32x2*)(rowp + bj * 128 + n * 16) = o; } }
    }
};
struct EpiBf16 {
    static constexpr bool PERM = true;
    bf16* O; int ldc; float scale;
    __device__ __forceinline__ void operator()(const f32x4 (&acc)[2][2][4][2], const Unit& u, int wr, int wc, int fr, int fq) const {
        const int row0 = u.aux + u.pm * 256 + wr * 64 + fr, col0 = u.pn * 256 + wc * 32 + 8 * fq;
#pragma unroll
        for (int ai = 0; ai < 2; ++ai)
#pragma unroll
            for (int m = 0; m < 4; ++m) { bf16* rowp = O + (size_t)(row0 + ai * 128 + m * 16) * ldc + col0;
#pragma unroll
                for (int bj = 0; bj < 2; ++bj) *(u32x4*)(rowp + bj * 128) = pack8(acc[ai][bj][m][0] * scale, acc[ai][bj][m][1] * scale); }
    }
};
struct EpiQKV {
    static constexpr bool PERM = true;
    bf16* Q; bf16* K; bf16* V; float qscale, kvscale;
    __device__ __forceinline__ void operator()(const f32x4 (&acc)[2][2][4][2], const Unit& u, int wr, int wc, int fr, int fq) const {
        const int which = u.pn >> 2; bf16* base = Q + (size_t)which * ((WS_NK - WS_NQ) / 2); const float sc = which == 0 ? qscale : kvscale;
        const int row0 = u.pm * 256 + wr * 64 + fr, col0 = (u.pn & 3) * 256 + wc * 32 + 8 * fq;
#pragma unroll
        for (int ai = 0; ai < 2; ++ai)
#pragma unroll
            for (int m = 0; m < 4; ++m) { bf16* rowp = base + (size_t)(row0 + ai * 128 + m * 16) * D + col0;
#pragma unroll
                for (int bj = 0; bj < 2; ++bj) *(u32x4*)(rowp + bj * 128) = pack8(acc[ai][bj][m][0] * sc, acc[ai][bj][m][1] * sc); }
    }
};
struct EpiRetIn {
    static constexpr bool PERM = true;
    bf16* Q; bf16* K; bf16* V; bf16* Gt; const LAS unsigned* rope;
    __device__ __forceinline__ void operator()(const f32x4 (&acc)[2][2][4][2], const Unit& u, int wr, int wc, int fr, int fq) const {
        const int row0 = u.pm * 256 + wr * 64 + fr;
        if (u.pn < 8) {
            const int head = u.pn & 3; const bool isK = u.pn >= 4; bf16* base = isK ? K : Q; const float sc = (isK ? 0.0625f : 1.f) * (FP8_INPROJ ? pg8::FP8_WSCALE : 1.f);
            const int jt = wc * 32 + 8 * fq;
            const int nat_a = jt < 64 ? jt : 64 + jt;
            const int f0 = jt & 63;
#pragma unroll
            for (int ai = 0; ai < 2; ++ai)
#pragma unroll
                for (int m = 0; m < 4; ++m) {
                    const int row = row0 + ai * 128 + m * 16;
                    f32x4 a0 = acc[ai][0][m][0], a1 = acc[ai][0][m][1], b0 = acc[ai][1][m][0], b1 = acc[ai][1][m][1];
                    if (u.pm * 256 < NLAT) {
                        const int t = row & 4095; const int pos = jt < 64 ? (t >> 6) : (t & 63);
                        const LAS unsigned* cs = rope + pos * 64 + f0;
#pragma unroll
                        for (int e = 0; e < 4; ++e) { typedef _Float16 h2 __attribute__((ext_vector_type(2))); const h2 p0 = __builtin_bit_cast(h2, cs[e]), p1 = __builtin_bit_cast(h2, cs[4 + e]);
                            const f32x2 c0 = (f32x2){(float)p0[0], (float)p0[1]}, c1 = (f32x2){(float)p1[0], (float)p1[1]};
                            const float x0 = a0[e], y0 = b0[e], x1 = a1[e], y1 = b1[e];
                            a0[e] = x0 * c0.x - y0 * c0.y; b0[e] = x0 * c0.y + y0 * c0.x; a1[e] = x1 * c1.x - y1 * c1.y; b1[e] = x1 * c1.y + y1 * c1.x; }
                    }
                    bf16* rowp = base + (size_t)row * D + head * 256 + nat_a;
                    *(u32x4*)(rowp) = pack8(a0 * sc, a1 * sc); *(u32x4*)(rowp + 64) = pack8(b0 * sc, b1 * sc);
                }
        } else {
            bf16* base = u.pn < 16 ? V : Gt; const int col0 = ((u.pn - 8) & 7) * 256 + wc * 32 + 8 * fq;
#pragma unroll
            for (int ai = 0; ai < 2; ++ai)
#pragma unroll
                for (int m = 0; m < 4; ++m) { bf16* rowp = base + (size_t)(row0 + ai * 128 + m * 16) * 2048 + col0;
#pragma unroll
                    for (int bj = 0; bj < 2; ++bj) { const float ws_ = FP8_INPROJ ? pg8::FP8_WSCALE : 1.f; const f32x4 v0 = acc[ai][bj][m][0] * ws_, v1 = acc[ai][bj][m][1] * ws_;
                        if (FP8_RETSTORE && u.pn >= 16) {
                            int t0 = __builtin_amdgcn_cvt_pk_fp8_f32(v0[0], v0[1], 0, false); t0 = __builtin_amdgcn_cvt_pk_fp8_f32(v0[2], v0[3], t0, true);
                            int t1 = __builtin_amdgcn_cvt_pk_fp8_f32(v1[0], v1[1], 0, false); t1 = __builtin_amdgcn_cvt_pk_fp8_f32(v1[2], v1[3], t1, true);
                            *(u32x2*)((unsigned char*)Gt + (size_t)(row0 + ai * 128 + m * 16) * 2048 + col0 + bj * 128) = (u32x2){(unsigned)t0, (unsigned)t1};
                        } else *(u32x4*)(rowp + bj * 128) = pack8(v0, v1); } }
        }
    }
};
struct EpiF1 {
    static constexpr bool PERM = true;
    bf16* G2; bf16* G2c;
    __device__ __forceinline__ void operator()(const f32x4 (&acc)[2][2][4][2], const Unit& u, int wr, int wc, int fr, int fq) const {
        const int g = u.aux, s = u.pm; const int tok0 = u.pn * 256;
        char* base; unsigned ldrB; int lcol;
        if (tok0 < NLAT) { const int b = tok0 >> 12, par = (tok0 >> 11) & 1; base = (char*)(G2 + (size_t)(b * 1024 + g * 256) * 8192 + par * 4096 + s * 2048); ldrB = 16384u; lcol = tok0 & 2047; }
        else { const int b = (tok0 - NLAT) >> 8; base = (char*)(G2c + (size_t)(b * 1024 + g * 256) * 512 + s * 256); ldrB = 1024u; lcol = 0; }
        const unsigned off0 = (unsigned)(wr * 64 + fr) * ldrB + (unsigned)(lcol + wc * 32 + 8 * fq) * 2u;
#pragma unroll
        for (int ai = 0; ai < 2; ++ai)
#pragma unroll
            for (int m = 0; m < 4; ++m) { const unsigned off = off0 + (unsigned)(ai * 128 + m * 16) * ldrB;
#pragma unroll
                for (int bj = 0; bj < 2; ++bj) *(u32x4*)(base + off + bj * 256) = pack8(acc[ai][bj][m][0], acc[ai][bj][m][1]); }
    }
};
struct EpiF1n {
    static constexpr bool PERM = false;
    __host__ __device__ static constexpr int brow(int R) { return ((R >> 4) & 1) * 512 + (R >> 5) * 16 + (R & 15); }
    bf16* G2;
    static constexpr int EB = FP8_F2 ? 1 : 2;
    __device__ __forceinline__ static void st8(char* p, const f32x4& uq, const f32x4& vq) {
        if (FP8_F2) { int t0 = __builtin_amdgcn_cvt_pk_fp8_f32(uq[0], uq[1], 0, false); t0 = __builtin_amdgcn_cvt_pk_fp8_f32(uq[2], uq[3], t0, true);
            int t1 = __builtin_amdgcn_cvt_pk_fp8_f32(vq[0], vq[1], 0, false); t1 = __builtin_amdgcn_cvt_pk_fp8_f32(vq[2], vq[3], t1, true); *(u32x2*)p = (u32x2){(unsigned)t0, (unsigned)t1}; }
        else { u32x4 o; o.x = cvt_pk_bf16(uq[0], uq[1]); o.y = cvt_pk_bf16(uq[2], uq[3]); o.z = cvt_pk_bf16(vq[0], vq[1]); o.w = cvt_pk_bf16(vq[2], vq[3]); *(u32x4*)p = o; } }
    __device__ __forceinline__ void operator()(const f32x4 (&acc)[2][2][4][2], const Unit& u, int wr, int wc, int fr, int fq) const {
        const int g = u.aux >> 1, grp = u.aux & 1, b = u.pn >> 3, lt = u.pn & 7;
        char* base = (char*)G2 + ((size_t)(b * 1024 + g * 256 + u.pm * 128) * 8192 + lt * 128) * EB;
        const unsigned off0 = ((unsigned)(wr * 64 + fr) * 8192u + (unsigned)(wc * 32 + 8 * fq)) * (unsigned)EB;
        constexpr float cs = 0.70710678118654752f;
#define F1_ST(R_, U_, V_) st8(base + off + (R_) * 1024 * EB, (U_), (V_))
#pragma unroll
        for (int m = 0; m < 4; ++m) { const unsigned off = off0 + (unsigned)(m * 16) * 8192u * (unsigned)EB;
            const f32x4 C0 = acc[0][0][m][0], C1 = acc[0][0][m][1], C2 = acc[0][1][m][0], C3 = acc[0][1][m][1];
            const f32x4 S0 = acc[1][0][m][0], S1 = acc[1][0][m][1], S2 = acc[1][1][m][0], S3 = acc[1][1][m][1];
            if (grp == 0) {
                F1_ST(0, C0 + C1, S0 + S1); F1_ST(4, C0 - C1, S0 - S1);
                F1_ST(2, C2 - S3, S2 + C3); F1_ST(6, C2 + S3, S2 - C3);
            } else {
                const f32x4 tc = (C1 + C3) * cs, ts = (S1 + S3) * cs, dc = (C3 - C1) * cs, ds = (S3 - S1) * cs;
                const f32x4 Ec = C0 + tc, Es = S0 + ts, Fc = C2 + dc, Fs = S2 + ds, Gc = C0 - tc, Gs = S0 - ts, Hc = C2 - dc, Hs = S2 - ds;
                F1_ST(1, Ec + Fs, Es - Fc); F1_ST(7, Ec - Fs, Es + Fc);
                F1_ST(5, Gc + Hs, Gs - Hc); F1_ST(3, Gc - Hs, Gs + Hc);
            }
        }
#undef F1_ST
    }
};
struct EpiMoe1 {
    static constexpr bool PERM = false;
    unsigned char* H;
    __device__ __forceinline__ void operator()(const f32x4 (&acc)[2][2][4][2], const Unit& u, int wr, int wc, int fr, int fq) const {
        const int row0 = u.pm * 256 + wr * 64 + fr, col0 = u.pn * 128 + wc * 32 + 4 * fq;
#pragma unroll
        for (int ai = 0; ai < 2; ++ai)
#pragma unroll
            for (int m = 0; m < 4; ++m) {
#pragma unroll
                for (int n = 0; n < 2; ++n) { f32x4 h;
#pragma unroll
                    for (int e = 0; e < 4; ++e) h[e] = silu_f(acc[ai][0][m][n][e] * pg8::FP8_WSCALE) * (acc[ai][1][m][n][e] * pg8::FP8_WSCALE);
                    int t = __builtin_amdgcn_cvt_pk_fp8_f32(h[0], h[1], 0, false); t = __builtin_amdgcn_cvt_pk_fp8_f32(h[2], h[3], t, true);
                    *(int*)(H + (size_t)(row0 + ai * 128 + m * 16) * D + col0 + 16 * n) = t; } }
    }
};
struct EpiFp8N {
    static constexpr bool PERM = false;
    static constexpr bool LDS_STORE = true;
    static constexpr int RS = 272;
    unsigned char* O;
    __device__ __forceinline__ void lds_store(const f32x4 (&acc)[2][2][4][2], const Unit& u, int wr, int wc, int fr, int fq, LAS unsigned char* buf, int tid) const {
#pragma unroll
        for (int p = 0; p < 4; ++p) {
            if (wr == (p & 1)) {
#pragma unroll
                for (int m = 0; m < 4; ++m)
#pragma unroll
                    for (int bj = 0; bj < 2; ++bj)
#pragma unroll
                        for (int n = 0; n < 2; ++n) { const f32x4 v = acc[p >> 1][bj][m][n]; int t = __builtin_amdgcn_cvt_pk_fp8_f32(v[0], v[1], 0, false); t = __builtin_amdgcn_cvt_pk_fp8_f32(v[2], v[3], t, true);
                            *(LAS int*)(buf + (m * 16 + fr) * RS + bj * 128 + wc * 32 + n * 16 + 4 * fq) = t; }
            }
            asm volatile("s_waitcnt lgkmcnt(0)" ::: "memory"); __builtin_amdgcn_s_barrier(); asm volatile("" ::: "memory");
#pragma unroll
            for (int k = 0; k < 2; ++k) { const int row = (tid >> 4) + 32 * k, ch = tid & 15;
                const u32x4 v = *(const LAS u32x4*)(buf + row * RS + ch * 16);
                *(u32x4*)(O + (size_t)(u.pm * 256 + 64 * p + row) * D + u.pn * 256 + ch * 16) = v; }
            asm volatile("s_waitcnt lgkmcnt(0)" ::: "memory"); __builtin_amdgcn_s_barrier(); asm volatile("" ::: "memory");
        }
    }
    __device__ __forceinline__ void operator()(const f32x4 (&acc)[2][2][4][2], const Unit& u, int wr, int wc, int fr, int fq) const {
        const int row0 = u.pm * 256 + wr * 64 + fr, col0 = u.pn * 256 + wc * 32 + 4 * fq;
#pragma unroll
        for (int ai = 0; ai < 2; ++ai)
#pragma unroll
            for (int m = 0; m < 4; ++m) { unsigned char* rowp = O + (size_t)(row0 + ai * 128 + m * 16) * D + col0;
#pragma unroll
                for (int bj = 0; bj < 2; ++bj)
#pragma unroll
                    for (int n = 0; n < 2; ++n) { const f32x4 v = acc[ai][bj][m][n]; int t = __builtin_amdgcn_cvt_pk_fp8_f32(v[0], v[1], 0, false); t = __builtin_amdgcn_cvt_pk_fp8_f32(v[2], v[3], t, true); *(int*)(rowp + bj * 128 + n * 16) = t; } }
    }
};
struct EpiBf16N {
    static constexpr bool PERM = false;
    bf16* O; int ldc; float scale;
    __device__ __forceinline__ void operator()(const f32x4 (&acc)[2][2][4][2], const Unit& u, int wr, int wc, int fr, int fq) const {
        const int row0 = u.aux + u.pm * 256 + wr * 64 + fr, col0 = u.pn * 256 + wc * 32 + 4 * fq;
#pragma unroll
        for (int ai = 0; ai < 2; ++ai)
#pragma unroll
            for (int m = 0; m < 4; ++m) { bf16* rowp = O + (size_t)(row0 + ai * 128 + m * 16) * ldc + col0;
#pragma unroll
                for (int bj = 0; bj < 2; ++bj)
#pragma unroll
                    for (int n = 0; n < 2; ++n) { const f32x4 v = acc[ai][bj][m][n] * scale; u32x2 o; o.x = cvt_pk_bf16(v[0], v[1]); o.y = cvt_pk_bf16(v[2], v[3]); *(u32x2*)(rowp + bj * 128 + n * 16) = o; } }
    }
};

struct F1nSched {
    static constexpr bool HOOKS = false;
    const char* A1N; const char* ACT; int G, c;
    __device__ bool next(int i, Unit& u) const { const int L = i * G + c; if (L >= 512) return false;
        const int b = L >> 7, g = (L >> 5) & 3, chh = (L >> 4) & 1, lt = (L >> 1) & 7, grp = L & 1; u.pm = chh; u.pn = b * 8 + lt; u.aux = 2 * g + grp; u.nt = 4;
        u.A = A1N + (size_t)chh * 256 * 512; u.B0 = ACT + (size_t)(b * 4096 + grp * 2048 + lt * 64) * 2048 + g * 512; return true; }
};
struct F1Sched {
    static constexpr bool HOOKS = false;
    const char* A1; const char* ACT; int G, c;
    __device__ bool next(int i, Unit& u) const { const int L = i * G + c; if (L >= 4 * 2 * 4) return false;
        const int g = L >> 3, rem = L & 7; u.pm = rem & 1; u.pn = 64 + (rem >> 1); u.aux = g; u.nt = 4;
        u.A = A1 + (size_t)u.pm * 256 * 512; u.B0 = ACT + (size_t)u.pn * 256 * 2048 + g * 512; return true; }
};
struct F2Sched {
    static constexpr bool HOOKS = false;
    const char* AL; const char* G2; int G, c;
    __device__ bool next(int i, Unit& u) const { const int L = i * G + c; if (L >= 256) return false;
        constexpr int EB = FP8_F2 ? 1 : 2;
        const int b = L >> 6, rem = L & 63, r = rem >> 3; u.pm = (rem >> 2) & 1; u.pn = rem & 3; u.aux = b * 4096 + r; u.nt = FP8_F2 ? 8 : 16;
        u.A = AL + ((size_t)r * 512 * 1024 + (size_t)u.pm * 256 * 1024) * EB; u.B0 = G2 + (((size_t)b * 1024 + u.pn * 256) * 8192 + (size_t)r * 1024) * EB; return true; }
};
struct EpiF2 {
    static constexpr bool PERM = true;
    bf16* O;
    __device__ __forceinline__ void operator()(const f32x4 (&acc_)[2][2][4][2], const Unit& u, int wr, int wc, int fr, int fq) const {
        f32x4 acc[2][2][4][2];
#pragma unroll
        for (int i0 = 0; i0 < 2; ++i0)
#pragma unroll
            for (int i1 = 0; i1 < 2; ++i1)
#pragma unroll
                for (int i2 = 0; i2 < 4; ++i2)
#pragma unroll
                    for (int i3 = 0; i3 < 2; ++i3) acc[i0][i1][i2][i3] = acc_[i0][i1][i2][i3] * (FP8_F2 ? (1.f / 256.f) : 1.f);
        const int r = u.aux & 7, rb = u.aux & ~7; const int r0 = u.pm * 256 + wr * 64 + fr, col0 = u.pn * 256 + wc * 32 + 8 * fq;
#pragma unroll
        for (int ai = 0; ai < 2; ++ai)
#pragma unroll
            for (int m = 0; m < 4; ++m) { bf16* rowp = O + (size_t)(rb + 8 * (r0 + ai * 128 + m * 16) + r) * D + col0;
#pragma unroll
                for (int bj = 0; bj < 2; ++bj) {
                    if (FP8_OUT2) { const f32x4 v0 = acc[ai][bj][m][0], v1 = acc[ai][bj][m][1];
                        int t0 = __builtin_amdgcn_cvt_pk_fp8_f32(v0[0], v0[1], 0, false); t0 = __builtin_amdgcn_cvt_pk_fp8_f32(v0[2], v0[3], t0, true);
                        int t1 = __builtin_amdgcn_cvt_pk_fp8_f32(v1[0], v1[1], 0, false); t1 = __builtin_amdgcn_cvt_pk_fp8_f32(v1[2], v1[3], t1, true);
                        *(u32x2*)((unsigned char*)O + (size_t)(rb + 8 * (r0 + ai * 128 + m * 16) + r) * D + col0 + bj * 128) = (u32x2){(unsigned)t0, (unsigned)t1}; }
                    else *(u32x4*)(rowp + bj * 128) = pack8(acc[ai][bj][m][0], acc[ai][bj][m][1]); } }
    }
};
struct F2cSched {
    const char* ALC; const char* G2C; int G, c;
    __device__ bool next(int i, Unit& u) const { const int L = i * G + c; if (L >= 16) return false;
        const int b = L >> 2; u.pm = 0; u.pn = L & 3; u.aux = NLAT + b * 256; u.nt = 8;
        u.A = ALC; u.B0 = G2C + ((size_t)b * 1024 + u.pn * 256) * 1024; return true; }
};
struct MoeSched {
    const volatile LAS int* tstart; const char* A; const char* W0; int nct, cstep, G, c;
    __device__ bool next(int i, Unit& u) const { const int L = i * G + c; const int rt = L / nct, ct = L % nct; if (rt >= tstart[16]) return false;
        int e = tstart[40 + rt];
        e = __builtin_amdgcn_readfirstlane(e);
        u.pm = rt; u.pn = ct; u.aux = 0; u.nt = 8; u.A = A + (size_t)rt * 256 * 1024;
        u.B0 = W0 + (size_t)e * 1048576 + (size_t)ct * cstep; return true; }
};

__device__ __forceinline__ f32x4 mfma16(const bf16x8& a, const bf16x8& b, const f32x4& c) { return __builtin_amdgcn_mfma_f32_16x16x32_bf16(a, b, c, 0, 0, 0); }
__device__ __forceinline__ s16x4 lds_tr(const LAS unsigned char* p) { return __builtin_amdgcn_ds_read_tr16_b64_v4i16((s16x4 LAS*)p); }
__device__ __forceinline__ bf16x8 cat8(const s16x4& a, const s16x4& b) { return (bf16x8){a[0], a[1], a[2], a[3], b[0], b[1], b[2], b[3]}; }
__device__ __forceinline__ bf16x8 pack_acc8(const f32x4& a, const f32x4& b) { const u32x4 u = pack8(a, b); return __builtin_bit_cast(bf16x8, u); }
__device__ __forceinline__ float logsig(float x) { const float e = __expf(-x);
    return -e * (1.f + e * (-0.5f + e * (0.333333343f + e * (-0.25f + e * (0.2f + e * (-0.166666672f + e * (0.142857149f + e * -0.125f))))))); }

constexpr int SG_RS = 144;
template <bool BF8>
__device__ __forceinline__ void small_gemm_ctx(Frame& F, const bf16* A, int lda, const bf16* Bt, int ldb, int K, bf16* X, const float* gate) {
    int tid = tid_of(F.wv); asm volatile("" : "+v"(tid)); const int lane = tid & 63, wave = __builtin_amdgcn_readfirstlane(tid >> 6);
    LAS unsigned char* lds = F.lds;
    for (int t = F.vcu; t < 256; t += F.G) {
        const int tm = t >> 4, tn = t & 15;
        const int pr = tid >> 3, pc = tid & 7;
        const bf16* ag = A + (size_t)(NLAT + 64 * tm + pr) * lda + pc * 8;
        const bf16* bg = Bt + (size_t)(64 * tn + pr) * ldb + pc * 8;
        const unsigned char* bg8 = (const unsigned char*)Bt + (size_t)(64 * tn + pr) * ldb + pc * 8;
        auto ldb_piece = [&](int kt) -> u32x4 {
            if constexpr (BF8) { const u32x2 w = *(const u32x2*)(bg8 + kt * 64); u32x4 o;
                const f32x2 a0 = __builtin_amdgcn_cvt_pk_f32_fp8((int)w.x, false), a1 = __builtin_amdgcn_cvt_pk_f32_fp8((int)w.x, true), a2 = __builtin_amdgcn_cvt_pk_f32_fp8((int)w.y, false), a3 = __builtin_amdgcn_cvt_pk_f32_fp8((int)w.y, true);
                o.x = cvt_pk_bf16(a0.x, a0.y); o.y = cvt_pk_bf16(a1.x, a1.y); o.z = cvt_pk_bf16(a2.x, a2.y); o.w = cvt_pk_bf16(a3.x, a3.y); return o; }
            else return *(const u32x4*)(bg + kt * 64); };
        const int wm = wave >> 1, wn = wave & 1, l15 = lane & 15, quad = lane >> 4;
        f32x4 acc[2] = {(f32x4){0.f, 0.f, 0.f, 0.f}, (f32x4){0.f, 0.f, 0.f, 0.f}};
        const int nk = K / 64;
        u32x4 ra[8], rb[8];
#pragma unroll
        for (int i = 0; i < 8; ++i) { ra[i] = *(const u32x4*)(ag + i * 64); rb[i] = ldb_piece(i); }
        __syncthreads();
        for (int kt0 = 0; kt0 < nk; kt0 += 8) {
#pragma unroll
            for (int i = 0; i < 8; ++i) {
                const int kt = kt0 + i;
                LAS unsigned char* sa = lds + (i & 1) * (2 * 64 * SG_RS); LAS unsigned char* sb = sa + 64 * SG_RS;
                *(LAS u32x4*)(sa + pr * SG_RS + pc * 16) = ra[i]; *(LAS u32x4*)(sb + pr * SG_RS + pc * 16) = rb[i];
                if (kt + 8 < nk) { ra[i] = *(const u32x4*)(ag + (kt + 8) * 64); rb[i] = ldb_piece(kt + 8); }
                __syncthreads();
#pragma unroll
                for (int ks = 0; ks < 2; ++ks) {
                    const bf16x8 af = *(const LAS bf16x8*)(sa + (16 * wm + l15) * SG_RS + (32 * ks + 8 * quad) * 2);
#pragma unroll
                    for (int n = 0; n < 2; ++n) { const bf16x8 bf = *(const LAS bf16x8*)(sb + (32 * wn + 16 * n + l15) * SG_RS + (32 * ks + 8 * quad) * 2);
                        acc[n] = mfma16(bf, af, acc[n]); }
                }
            }
        }
        bf16* xr = X + (size_t)(NLAT + 64 * tm + 16 * wm + l15) * D + 64 * tn + 32 * wn + 4 * quad;
        const float* gp = gate + 64 * tn + 32 * wn + 4 * quad;
#pragma unroll
        for (int n = 0; n < 2; ++n) { const f32x4 gv = *(const f32x4*)(gp + 16 * n) * (BF8 ? pg8::FP8_WSCALE : 1.f); const u32x2 xv = *(const u32x2*)(xr + 16 * n); const f32x4 y = gv * acc[n]; u32x2 o;
            o.x = cvt_pk_bf16(bflo(xv.x) + y[0], bfhi(xv.x) + y[1]); o.y = cvt_pk_bf16(bflo(xv.y) + y[2], bfhi(xv.y) + y[3]); *(u32x2*)(xr + 16 * n) = o; }
    }
    __syncthreads();
}

constexpr int SC_QS = 528, SC_KS = 576, SC_VS = 144, SC_QT = 0, SC_KT = 128 * 528, SC_VT = SC_KT + 128 * 576;
static_assert(SC_VT + 128 * SC_VS <= MISC_OFF, "scan LDS map");
__device__ __forceinline__ int scan_rowbase(int dir, int b, int n) {
    if (dir == 0) return (n < 2) ? NLAT + b * 256 + n * 128 : b * 4096 + (n - 2) * 128;
    return (n < 2) ? NLAT + b * 256 + (1 - n) * 128 : b * 4096 + (33 - n) * 128;
}
__device__ __forceinline__ void p_ret_scan(Frame& F, const Args& a, int j) {
    int tid = tid_of(F.wv); asm volatile("" : "+v"(tid)); const int lane = tid & 63, wave = __builtin_amdgcn_readfirstlane(tid >> 6);
    GAS unsigned char* wsg_ = (GAS unsigned char*)F.ws; asm volatile("" : "+s"(wsg_)); unsigned char* wso = (unsigned char*)wsg_;
    const bf16* Q = (const bf16*)(wso + WS_RQ); const bf16* K = (const bf16*)(wso + WS_RK); const bf16* V = (const bf16*)(wso + WS_RV);
    LAS unsigned char* lds = F.lds;
    for (int u = F.vcu; u < 256; u += F.G) {
        const int dir = u & 1, slice = (u >> 1) & 7, bh = u >> 4, b = bh >> 2, h = bh & 3;
        __syncthreads();
        if (wave >= 4) {
            const int lt = tid - 256;
            const int qr = lt >> 5, qc = lt & 31, vr = lt >> 3, vc = lt & 7; const bool kswz = (qr & 4) != 0;
            const bf16* Qg = Q + (size_t)qr * 1024 + h * 256 + qc * 8;
            const bf16* Kg = K + (size_t)qr * 1024 + h * 256 + qc * 8;
            const bf16* Vg = V + (size_t)vr * 2048 + h * 512 + slice * 64 + vc * 8;
            LAS unsigned char* qd = lds + SC_QT + qr * SC_QS + qc * 16;
            LAS unsigned char* kd = lds + SC_KT + qr * SC_KS + qc * 16;
            LAS unsigned char* vd = lds + SC_VT + vr * SC_VS + vc * 16;
            u32x4 rq[16], rk[16], rv[4];
            { const size_t rb = (size_t)scan_rowbase(dir, b, 0), rb1 = (size_t)scan_rowbase(dir, b, 1);
#pragma unroll
              for (int i = 0; i < 16; ++i) { rq[i] = *(const u32x4*)(Qg + (rb + 8 * i) * 1024); rk[i] = *(const u32x4*)(Kg + (rb + 8 * i) * 1024); }
#pragma unroll
              for (int i = 0; i < 4; ++i) rv[i] = *(const u32x4*)(Vg + (rb + 32 * i) * 2048);
#pragma unroll
              for (int i = 0; i < 16; ++i) *(LAS u32x4*)(qd + i * 8 * SC_QS) = rq[i];
#pragma unroll
              for (int i = 0; i < 16; ++i) rq[i] = *(const u32x4*)(Qg + (rb1 + 8 * i) * 1024); }
            __syncthreads();
            for (int n = 0; n < 34; ++n) {
#pragma unroll
                for (int i = 0; i < 16; ++i) *(LAS u32x4*)(kd + i * 8 * SC_KS) = kswz ? (u32x4){rk[i].z, rk[i].w, rk[i].x, rk[i].y} : rk[i];
#pragma unroll
                for (int i = 0; i < 4; ++i) *(LAS u32x4*)(vd + i * 32 * SC_VS) = rv[i];
                { const size_t rbn = (size_t)scan_rowbase(dir, b, n < 33 ? n + 1 : n);
#pragma unroll
                  for (int i = 0; i < 16; ++i) rk[i] = *(const u32x4*)(Kg + (rbn + 8 * i) * 1024);
#pragma unroll
                  for (int i = 0; i < 4; ++i) rv[i] = *(const u32x4*)(Vg + (rbn + 32 * i) * 2048); }
                __syncthreads();
#pragma unroll
                for (int i = 0; i < 16; ++i) *(LAS u32x4*)(qd + i * 8 * SC_QS) = rq[i];
                { const size_t rbn2 = (size_t)scan_rowbase(dir, b, n < 32 ? n + 2 : n);
#pragma unroll
                  for (int i = 0; i < 16; ++i) rq[i] = *(const u32x4*)(Qg + (rbn2 + 8 * i) * 1024); }
                __syncthreads();
            }
        } else {
            const int w = wave, l15 = lane & 15, quad = lane >> 4, tq = l15 >> 2, tp = l15 & 3;
            bf16* O = (bf16*)(wso + (dir ? WS_ROB : WS_ROF));
            const float lg = logsig(a.in[I_RDEC][(j * 2 + dir) * 4 + h]);
            const float lg2 = lg * 1.44269504f;
            const float cdec = exp2f(128.f * lg2);
            f32x4 S[16];
#pragma unroll
            for (int m = 0; m < 16; ++m) S[m] = (f32x4){0.f, 0.f, 0.f, 0.f};
            __syncthreads();
            for (int n = 0; n < 34; ++n) {
                const size_t rb = (size_t)scan_rowbase(dir, b, n);
                int lane_s = lane; asm volatile("" : "+v"(lane_s)); const int l15s = lane_s & 15, quads = lane_s >> 4;
                {
                    bf16x8 Sf[8];
#pragma unroll
                    for (int s = 0; s < 8; ++s) Sf[s] = pack_acc8(S[2 * s], S[2 * s + 1]);
                    bf16x8 qf[3][8];
                    const LAS unsigned char* qbase = lds + SC_QT + l15 * SC_QS + quad * 16;
#pragma unroll
                    for (int s = 0; s < 8; ++s) { qf[0][s] = *(const LAS bf16x8*)(qbase + s * 64); qf[1][s] = *(const LAS bf16x8*)(qbase + 16 * SC_QS + s * 64); }
#pragma unroll
                    for (int tt = 0; tt < 8; ++tt) {
                        if (tt + 2 < 8) {
#pragma unroll
                            for (int s = 0; s < 8; ++s) qf[(tt + 2) % 3][s] = *(const LAS bf16x8*)(qbase + (16 * (tt + 2)) * SC_QS + s * 64);
                        }
                        __builtin_amdgcn_sched_barrier(0);
                        f32x4 acc0 = (f32x4){0.f, 0.f, 0.f, 0.f}, acc1 = acc0;
#pragma unroll
                        for (int s = 0; s < 8; s += 2) { acc0 = mfma16(Sf[s], qf[tt % 3][s], acc0); acc1 = mfma16(Sf[s + 1], qf[tt % 3][s + 1], acc1); }
                        const int i0 = 16 * tt + l15; const int j0 = 16 * tt + l15s;
                        const float qd0 = __builtin_amdgcn_exp2f(lg2 * (dir == 0 ? (float)(j0 + 1) : (float)(128 - j0)));
#if FP8_RETSTORE
                        { int t8 = __builtin_amdgcn_cvt_pk_fp8_f32((acc0[0] + acc1[0]) * qd0, (acc0[1] + acc1[1]) * qd0, 0, false); t8 = __builtin_amdgcn_cvt_pk_fp8_f32((acc0[2] + acc1[2]) * qd0, (acc0[3] + acc1[3]) * qd0, t8, true);
                          *(int*)((unsigned char*)O + ((rb + i0) * 2048 + h * 512 + slice * 64 + 16 * w + 4 * quad)) = t8; }
#else
                        u32x2 o0; o0.x = cvt_pk_bf16((acc0[0] + acc1[0]) * qd0, (acc0[1] + acc1[1]) * qd0); o0.y = cvt_pk_bf16((acc0[2] + acc1[2]) * qd0, (acc0[3] + acc1[3]) * qd0);
                        *(u32x2*)(O + (rb + i0) * 2048 + h * 512 + slice * 64 + 16 * w + 4 * quad) = o0;
#endif
                        __builtin_amdgcn_sched_barrier(0);
                    }
                }
                __syncthreads();
#pragma unroll
                for (int m = 0; m < 16; ++m) S[m] = S[m] * cdec;
                {
                    const int ksw = (quad & 1) << 3;
                    const LAS unsigned char* kb0 = lds + SC_KT + (4 * quad + tq) * SC_KS + 16 * tp;
                    const LAS unsigned char* vb0 = lds + SC_VT + (4 * quad + tq) * SC_VS + (16 * w + 4 * tp) * 2;
                    s16x4 kf[3][16], vf[4][2];
#pragma unroll
                    for (int s = 0; s < 4; ++s) { vf[s][0] = lds_tr(vb0 + 32 * s * SC_VS); vf[s][1] = lds_tr(vb0 + (32 * s + 16) * SC_VS); }
#define SC_LDK(dst, g) do { const LAS unsigned char* kb_ = kb0 + 32 * ((g) >> 1) * SC_KS + 256 * ((g) & 1); _Pragma("unroll") for (int q_ = 0; q_ < 4; ++q_) { \
        dst[4 * q_ + 0] = lds_tr(kb_ + q_ * 64 + ksw); dst[4 * q_ + 1] = lds_tr(kb_ + q_ * 64 + ksw + 16 * SC_KS); dst[4 * q_ + 2] = lds_tr(kb_ + q_ * 64 + (8 ^ ksw)); dst[4 * q_ + 3] = lds_tr(kb_ + q_ * 64 + (8 ^ ksw) + 16 * SC_KS); } } while (0)
                    SC_LDK(kf[0], 0); SC_LDK(kf[1], 1);
                    bf16x8 Bv = (bf16x8){0, 0, 0, 0, 0, 0, 0, 0};
#pragma unroll
                    for (int g = 0; g < 8; ++g) {
                        if (g + 2 < 8) SC_LDK(kf[(g + 2) % 3], g + 2);
                        __builtin_amdgcn_sched_barrier(0);
                        if ((g & 1) == 0) {
                            const int s = g >> 1; float vs[8];
#pragma unroll
                            for (int e = 0; e < 4; ++e) { const int t0 = 32 * s + 4 * quads + e, t1 = t0 + 16;
                                const float k0 = __builtin_amdgcn_exp2f(lg2 * (dir == 0 ? (float)(127 - t0) : (float)t0)), k1 = __builtin_amdgcn_exp2f(lg2 * (dir == 0 ? (float)(127 - t1) : (float)t1));
                                vs[e] = bf2f((unsigned short)vf[s][0][e]) * k0; vs[4 + e] = bf2f((unsigned short)vf[s][1][e]) * k1; }
                            u32x4 vb; vb.x = cvt_pk_bf16(vs[0], vs[1]); vb.y = cvt_pk_bf16(vs[2], vs[3]); vb.z = cvt_pk_bf16(vs[4], vs[5]); vb.w = cvt_pk_bf16(vs[6], vs[7]);
                            Bv = __builtin_bit_cast(bf16x8, vb);
                        }
#pragma unroll
                        for (int q = 0; q < 4; ++q) { const int sp = 4 * (g & 1) + q;
                            S[2 * sp] = mfma16(cat8(kf[g % 3][4 * q + 0], kf[g % 3][4 * q + 1]), Bv, S[2 * sp]); S[2 * sp + 1] = mfma16(cat8(kf[g % 3][4 * q + 2], kf[g % 3][4 * q + 3]), Bv, S[2 * sp + 1]); }
                        __builtin_amdgcn_sched_barrier(0);
                    }
#undef SC_LDK
                }
                __syncthreads();
            }
        }
    }
    __syncthreads();
}

constexpr int IN_KS = 544, IN_VQ = 128 * 288, IN_VS = 288;
__device__ __forceinline__ int intra_rowbase(int nchunks, int u) {
    const int bh = u / nchunks, cn = u % nchunks, b = bh >> 2;
    if (nchunks == 34) return (cn < 2) ? NLAT + b * 256 + cn * 128 : b * 4096 + (cn - 2) * 128;
    return b * 4096 + cn * 128;
}
#if FP8_RETSTORE
typedef u32x2 RPiece;
__device__ __forceinline__ void rp_unpack(const RPiece& p, float (&v)[8]) { const f32x2 a0 = __builtin_amdgcn_cvt_pk_f32_fp8((int)p.x, false), a1 = __builtin_amdgcn_cvt_pk_f32_fp8((int)p.x, true), a2 = __builtin_amdgcn_cvt_pk_f32_fp8((int)p.y, false), a3 = __builtin_amdgcn_cvt_pk_f32_fp8((int)p.y, true);
    v[0] = a0.x; v[1] = a0.y; v[2] = a1.x; v[3] = a1.y; v[4] = a2.x; v[5] = a2.y; v[6] = a3.x; v[7] = a3.y; }
#define RP_OFF(bytes_bf16) ((bytes_bf16) >> 1)
#else
typedef u32x4 RPiece;
__device__ __forceinline__ void rp_unpack(const RPiece& p, float (&v)[8]) { v[0] = bflo(p.x); v[1] = bfhi(p.x); v[2] = bflo(p.y); v[3] = bfhi(p.y); v[4] = bflo(p.z); v[5] = bfhi(p.z); v[6] = bflo(p.w); v[7] = bfhi(p.w); }
#define RP_OFF(bytes_bf16) (bytes_bf16)
#endif
__device__ __forceinline__ void p_ret_intra(Frame& F, const Args& a, int j, int nchunks) {
    int tid0 = tid_of(F.wv); asm volatile("" : "+v"(tid0)); const int wave = __builtin_amdgcn_readfirstlane(tid0 >> 6);
    GAS unsigned char* wsg_ = (GAS unsigned char*)F.ws; asm volatile("" : "+s"(wsg_)); unsigned char* wso = (unsigned char*)wsg_;
    const bf16* Q = (const bf16*)(wso + WS_RQ); const bf16* K = (const bf16*)(wso + WS_RK); const bf16* V = (const bf16*)(wso + WS_RV);
    const bf16* OF = (const bf16*)(wso + WS_ROF); const bf16* OB = (const bf16*)(wso + WS_ROB); const bf16* Gt = (const bf16*)(wso + WS_RG); bf16* OG = (bf16*)(wso + WS_ROG);
    const int w = wave;
    int vcu = F.vcu; asm volatile("" : "+s"(vcu));
    LAS unsigned char* lds = F.lds;
    const int nunits = 16 * nchunks;
    u32x4 rk[8];
    if (vcu < nunits) { const int rb0 = intra_rowbase(nchunks, vcu), h0 = (vcu / nchunks) & 3;
#pragma unroll
        for (int i = 0; i < 8; ++i) rk[i] = *(const u32x4*)(K + (size_t)(rb0 + (tid0 >> 5) + 16 * i) * 1024 + h0 * 256 + (tid0 & 31) * 8); }
    for (int u = vcu; u < nunits; u += F.G) {
        int tid_o = tid_of(F.wv); asm volatile("" : "+v"(tid_o));
        const int tid = tid_o, lane_o = tid_o & 63;
        const int l15 = lane_o & 15, quad = lane_o >> 4, tq = l15 >> 2, tp = l15 & 3;
        const int h = (u / nchunks) & 3;
        const int rowbase = intra_rowbase(nchunks, u);
        const float lgf = logsig(a.in[I_RDEC][(j * 2 + 0) * 4 + h]) * 1.44269504f, lgb = logsig(a.in[I_RDEC][(j * 2 + 1) * 4 + h]) * 1.44269504f;
        __syncthreads();
#pragma unroll
        for (int i = 0; i < 8; ++i) *(LAS u32x4*)(lds + ((tid >> 5) + 16 * i) * IN_KS + (tid & 31) * 16) = rk[i];
        bf16x8 Bq[8];
#pragma unroll
        for (int s = 0; s < 8; ++s) Bq[s] = *(const bf16x8*)(Q + (size_t)(rowbase + 16 * w + l15) * 1024 + h * 256 + 32 * s + 8 * quad);
        u32x4 rv[16];
#pragma unroll
        for (int i = 0; i < 16; ++i) rv[i] = *(const u32x4*)(V + (size_t)(rowbase + (tid >> 6) + 8 * i) * 2048 + h * 512 + (tid & 63) * 8);
        __syncthreads();
        bf16x8 Pf[4];
        {
            f32x4 sc[8];
#pragma unroll
            for (int kt = 0; kt < 8; ++kt) { sc[kt] = (f32x4){0.f, 0.f, 0.f, 0.f};
#pragma unroll
                for (int s = 0; s < 8; ++s) { const bf16x8 A = *(const LAS bf16x8*)(lds + (16 * kt + l15) * IN_KS + (32 * s + 8 * quad) * 2); sc[kt] = mfma16(A, Bq[s], sc[kt]); } }
            const int qi = 16 * w + l15;
#pragma unroll
            for (int kt = 0; kt < 8; ++kt)
#pragma unroll
                for (int e = 0; e < 4; ++e) { const int kj = 16 * kt + 4 * quad + e; const int d = qi - kj;
                    const float mk = (d == 0) ? 2.f : exp2f((d > 0 ? lgf : lgb) * fabsf((float)d)); sc[kt][e] *= mk; }
#pragma unroll
            for (int s2 = 0; s2 < 4; ++s2) Pf[s2] = pack_acc8(sc[2 * s2], sc[2 * s2 + 1]);
        }
        __syncthreads();
#pragma unroll
        for (int i = 0; i < 16; ++i) { const int row = (tid >> 6) + 8 * i, c16 = tid & 63;
            *(LAS u32x4*)(lds + (c16 >> 4) * IN_VQ + row * IN_VS + (c16 & 15) * 16) = rv[i]; }
        const unsigned ro = ((unsigned)(rowbase + 16 * w + l15) * 2048u + (unsigned)(h * 512 + 8 * quad)) * 2u;
#define ROW16(base, el) (*(const RPiece*)((const char*)(base) + (RP_OFF(ro + (unsigned)(el) * 2u) + (unsigned)dep)))
        RPiece pf[6], pb[6];
#pragma unroll
        for (int kp = 0; kp < 4; ++kp) { pf[kp] = *(const RPiece*)((const char*)OF + RP_OFF(ro + 64u * kp)); pb[kp] = *(const RPiece*)((const char*)OB + RP_OFF(ro + 64u * kp)); }
        __syncthreads();
        __builtin_amdgcn_sched_barrier(0);
        f32x4 o[32];
#pragma unroll
        for (int mt = 0; mt < 32; ++mt) {
            o[mt] = (f32x4){0.f, 0.f, 0.f, 0.f};
            const int kp = mt >> 1;
            const LAS unsigned char* vb = lds + (kp >> 2) * IN_VQ + (32 * (kp & 3) + 8 * tp + 4 * (mt & 1)) * 2;
#pragma unroll
            for (int s2 = 0; s2 < 4; ++s2) { const int r0 = 32 * s2 + 4 * quad + tq;
                const s16x4 v0 = lds_tr(vb + r0 * IN_VS), v1 = lds_tr(vb + (r0 + 16) * IN_VS);
                o[mt] = mfma16(cat8(v0, v1), Pf[s2], o[mt]); }
            if ((mt & 1) == 1) __builtin_amdgcn_sched_barrier(0);
        }
        int dep = 0; asm volatile("" : "+v"(dep), "+v"(o[31][3]));
        float sum = 0.f;
#pragma unroll
        for (int bt = 0; bt < 3; ++bt) {
            const int p0 = bt == 0 ? 0 : (bt == 1 ? 4 : 10), np = bt == 0 ? 4 : 6;
            if (bt > 0) {
                asm volatile("" : "+v"(dep), "+v"(sum));
#pragma unroll
                for (int kp = 0; kp < 6; ++kp) { pf[kp] = ROW16(OF, 32 * (p0 + kp)); pb[kp] = ROW16(OB, 32 * (p0 + kp)); }
            }
#pragma unroll
            for (int kp = 0; kp < 6; ++kp) { if (kp >= np) continue; const int m0 = 2 * (p0 + kp), m1 = m0 + 1; float f[8], bk[8]; rp_unpack(pf[kp], f); rp_unpack(pb[kp], bk);
                o[m0][0] += f[0] + bk[0]; o[m0][1] += f[1] + bk[1]; o[m0][2] += f[2] + bk[2]; o[m0][3] += f[3] + bk[3];
                o[m1][0] += f[4] + bk[4]; o[m1][1] += f[5] + bk[5]; o[m1][2] += f[6] + bk[6]; o[m1][3] += f[7] + bk[7];
                sum += ((o[m0][0] + o[m0][1]) + (o[m0][2] + o[m0][3])) + ((o[m1][0] + o[m1][1]) + (o[m1][2] + o[m1][3])); }
        }
        asm volatile("" : "+v"(dep), "+v"(sum));
        RPiece gg[8];
#pragma unroll
        for (int kp = 0; kp < 8; ++kp) gg[kp] = ROW16(Gt, 32 * kp);
        sum += shx(sum, 16, lane_o); sum += shx(sum, 32, lane_o);
        const float mu = sum * (1.f / 512.f);
        float sq = 0.f;
#pragma unroll
        for (int mt = 0; mt < 32; ++mt) { o[mt] = o[mt] - mu; sq += (o[mt][0] * o[mt][0] + o[mt][1] * o[mt][1]) + (o[mt][2] * o[mt][2] + o[mt][3] * o[mt][3]); }
        sq += shx(sq, 16, lane_o); sq += shx(sq, 32, lane_o);
        const float rstd = rsqrtf(sq * (1.f / 512.f) + EPS);
        const float* gn = a.in[I_RGN] + j * 2048 + h * 512 + 8 * quad;
#pragma unroll
        for (int hb = 0; hb < 2; ++hb) {
            if (hb == 1) {
#pragma unroll
                for (int kp = 0; kp < 8; ++kp) gg[kp] = ROW16(Gt, 32 * (8 + kp));
                { const int un = (u + F.G < nunits) ? u + F.G : u; const int rbn = intra_rowbase(nchunks, un), hn = (un / nchunks) & 3;
#pragma unroll
                    for (int i = 0; i < 8; ++i) rk[i] = *(const u32x4*)(K + (size_t)(rbn + (tid >> 5) + 16 * i) * 1024 + hn * 256 + (tid & 31) * 8 + dep); }
            }
#pragma unroll
            for (int kp = 0; kp < 8; ++kp) { const int m0 = 2 * (8 * hb + kp), m1 = m0 + 1; float gf[8]; rp_unpack(gg[kp], gf);
                const f32x4 w0 = *(const f32x4*)(gn + 32 * (8 * hb + kp)), w1 = *(const f32x4*)(gn + 32 * (8 * hb + kp) + 4);
                u32x4 r;
                if (FP8_OUTPROJ && rowbase < NLAT) {
                    const float v0 = o[m0][0] * rstd * w0[0] * silu_f(gf[0]), v1 = o[m0][1] * rstd * w0[1] * silu_f(gf[1]), v2 = o[m0][2] * rstd * w0[2] * silu_f(gf[2]), v3 = o[m0][3] * rstd * w0[3] * silu_f(gf[3]);
                    const float v4 = o[m1][0] * rstd * w1[0] * silu_f(gf[4]), v5 = o[m1][1] * rstd * w1[1] * silu_f(gf[5]), v6 = o[m1][2] * rstd * w1[2] * silu_f(gf[6]), v7 = o[m1][3] * rstd * w1[3] * silu_f(gf[7]);
                    int t0 = __builtin_amdgcn_cvt_pk_fp8_f32(v0, v1, 0, false); t0 = __builtin_amdgcn_cvt_pk_fp8_f32(v2, v3, t0, true);
                    int t1 = __builtin_amdgcn_cvt_pk_fp8_f32(v4, v5, 0, false); t1 = __builtin_amdgcn_cvt_pk_fp8_f32(v6, v7, t1, true);
                    *(u32x2*)((char*)OG + ((ro >> 1) + 32u * (8 * hb + kp))) = (u32x2){(unsigned)t0, (unsigned)t1}; r.w = (unsigned)t1;
                } else {
                r.x = cvt_pk_bf16(o[m0][0] * rstd * w0[0] * silu_f(gf[0]), o[m0][1] * rstd * w0[1] * silu_f(gf[1]));
                r.y = cvt_pk_bf16(o[m0][2] * rstd * w0[2] * silu_f(gf[2]), o[m0][3] * rstd * w0[3] * silu_f(gf[3]));
                r.z = cvt_pk_bf16(o[m1][0] * rstd * w1[0] * silu_f(gf[4]), o[m1][1] * rstd * w1[1] * silu_f(gf[5]));
                r.w = cvt_pk_bf16(o[m1][2] * rstd * w1[2] * silu_f(gf[6]), o[m1][3] * rstd * w1[3] * silu_f(gf[7]));
                *(u32x4*)((char*)OG + (FP8_OUTPROJ ? (size_t)36 * MiB - (size_t)NLAT * 4096 : (size_t)0) + (ro + 64u * (8 * hb + kp))) = r; }
                if (kp == 7) asm volatile("" : "+v"(dep), "+v"(r.w)); }
        }
    }
#undef ROW16
    __syncthreads();
}

constexpr int NA_VS = 144, NA_CTX = 576 * 144, NA_RPB = 832 * 144;
struct NaUnit { int b, h, r0, rsu, band; size_t ctxrow; };
__device__ __forceinline__ NaUnit na_unit(int u) {
    NaUnit n;
    if (u < 2048) { n.b = u >> 9; const int rem = u & 511; n.h = rem & 15; n.r0 = 2 * (rem >> 4); n.rsu = min(max(n.r0 - 4, 0), 56); n.band = 1; }
    else { const int uc = u - 2048; n.b = uc >> 5; n.h = (uc >> 1) & 15; n.r0 = (uc & 1) * 128; n.rsu = 0; n.band = 0; }
    n.ctxrow = (size_t)(NLAT + n.b * 256);
    return n;
}
__device__ __forceinline__ void na_load_img(const bf16* T, const NaUnit& n, int tid, u32x4 (&r)[13]) {
    const int c8 = tid & 7, k0 = tid >> 3;
    if (n.band) {
#pragma unroll
        for (int i = 0; i < 9; ++i) { const int kb = k0 + 64 * i; const int tok = min((n.rsu + i) * 64 + k0, 4095);
            r[i] = *(const u32x4*)(T + (size_t)(n.b * 4096 + tok) * 1024 + n.h * 64 + c8 * 8); (void)kb; }
    }
#pragma unroll
    for (int i = 0; i < 4; ++i) r[9 + i] = *(const u32x4*)(T + (n.ctxrow + k0 + 64 * i) * 1024 + n.h * 64 + c8 * 8);
}
__device__ __forceinline__ void na_store_img(LAS unsigned char* lds, const NaUnit& n, int tid, const u32x4 (&r)[13]) {
    const int c8 = tid & 7, k0 = tid >> 3;
    if (n.band) {
#pragma unroll
        for (int i = 0; i < 9; ++i) *(LAS u32x4*)(lds + (k0 + 64 * i) * NA_VS + c8 * 16) = r[i];
    }
#pragma unroll
    for (int i = 0; i < 4; ++i) *(LAS u32x4*)(lds + NA_CTX + (k0 + 64 * i) * NA_VS + c8 * 16) = r[9 + i];
}
__device__ __forceinline__ void p_na_attn(Frame& F, const Args& a) {
    int tid0 = tid_of(F.wv); asm volatile("" : "+v"(tid0)); const int wave = __builtin_amdgcn_readfirstlane(tid0 >> 6);
    GAS unsigned char* wsg_ = (GAS unsigned char*)F.ws; asm volatile("" : "+s"(wsg_)); unsigned char* wso = (unsigned char*)wsg_;
    const bf16* Q = (const bf16*)(wso + WS_NQ); const bf16* K = (const bf16*)(wso + WS_NK); const bf16* V = (const bf16*)(wso + WS_NV); bf16* O = (bf16*)(wso + WS_NO);
    const int w = wave;
    int vcu = F.vcu; asm volatile("" : "+s"(vcu));
    LAS unsigned char* lds = F.lds;
    constexpr int NU = 2048 + 128;
    u32x4 rimg[13];
    bf16x8 Bq0n = (bf16x8){0, 0, 0, 0, 0, 0, 0, 0}, Bq1n = Bq0n;
    auto qrow_of = [&](const NaUnit& n, int lane_o) -> size_t { const int l15 = lane_o & 15; const bool band = n.band != 0;
        const int r = band ? n.r0 + (w >> 2) : 0, jb = w & 3;
        return band ? (size_t)(n.b * 4096 + r * 64 + 16 * jb + l15) * 1024 + n.h * 64 : (n.ctxrow + n.r0 + 16 * w + l15) * 1024 + n.h * 64; };
    if (vcu < NU) { const NaUnit n0 = na_unit(vcu); na_load_img(K, n0, tid0, rimg);
        const size_t q0 = qrow_of(n0, tid0 & 63); Bq0n = *(const bf16x8*)(Q + q0 + 8 * ((tid0 & 63) >> 4)); Bq1n = *(const bf16x8*)(Q + q0 + 32 + 8 * ((tid0 & 63) >> 4)); }
    int hcur = -1;
    for (int u = vcu; u < NU; u += F.G) {
        int tid_o = tid_of(F.wv); asm volatile("" : "+v"(tid_o));
        const int tid = tid_o, lane_o = tid_o & 63;
        const int l15 = lane_o & 15, quad = lane_o >> 4, tq = l15 >> 2, tp = l15 & 3;
        const NaUnit n = na_unit(u);
        const bool band = n.band != 0;
        const int r = band ? n.r0 + (w >> 2) : 0, jb = w & 3, rs = min(max(r - 4, 0), 56);
        const int cb = band ? min(max(16 * jb - 8, 0), 32) : 0;
        const size_t qrow = qrow_of(n, lane_o);
        const bf16x8 Bq0 = Bq0n, Bq1 = Bq1n;
        __syncthreads();
        na_store_img(lds, n, tid, rimg);
        if (band && n.h != hcur) { hcur = n.h; if (tid < 465) ((LAS float*)(lds + NA_RPB))[tid] = a.in[I_NARPB][n.h * 465 + tid]; }
        na_load_img(V, n, tid, rimg);
        __syncthreads();
        constexpr float LOG2E = 1.44269504f;
        bf16x8 Pf[16];
        float m1 = -1e30f, sum1 = 0.f, m2 = -1e30f, sum2 = 0.f;
        if (band) {
            f32x4 sc[16];
#pragma unroll
            for (int t = 0; t < 16; ++t) { const int kk = 16 * t + l15, krow = kk >> 5, kc = kk & 31;
                const LAS unsigned char* kp = lds + ((rs - n.rsu + krow) * 64 + cb + kc) * NA_VS + quad * 16;
                const bf16x8 k0 = *(const LAS bf16x8*)kp, k1 = *(const LAS bf16x8*)(kp + 64);
                f32x4 acc = (f32x4){0.f, 0.f, 0.f, 0.f}; acc = mfma16(k0, Bq0, acc); acc = mfma16(k1, Bq1, acc); sc[t] = acc; }
            const LAS float* rpb = (const LAS float*)(lds + NA_RPB);
            const int qcol = 16 * jb + l15, cstart = min(max(qcol - 8, 0), 48);
            const int rel0 = cb + 4 * quad - qcol;
            const int drb = (rs - r + 7) * 31 + 15;
#pragma unroll
            for (int t = 0; t < 16; ++t)
#pragma unroll
                for (int e = 0; e < 4; ++e) { const int rel = rel0 + (t & 1) * 16 + e;
                    const int kcol = rel + qcol; const bool valid = (kcol >= cstart) && (kcol < cstart + 16);
                    const int idx = drb + (t >> 1) * 31 + min(max(rel, -15), 15);
                    const float v = valid ? sc[t][e] + rpb[idx] : -1e30f; sc[t][e] = v; m1 = fmaxf(m1, v); }
            m1 = fmaxf(m1, shx(m1, 16, lane_o)); m1 = fmaxf(m1, shx(m1, 32, lane_o));
            const float m1l = m1 * LOG2E;
#pragma unroll
            for (int s2 = 0; s2 < 8; ++s2) { f32x4 p0, p1;
#pragma unroll
                for (int e = 0; e < 4; ++e) { p0[e] = __builtin_amdgcn_exp2f(sc[2 * s2][e] * LOG2E - m1l); p1[e] = __builtin_amdgcn_exp2f(sc[2 * s2 + 1][e] * LOG2E - m1l); }
                sum1 += (p0[0] + p0[1]) + (p0[2] + p0[3]) + (p1[0] + p1[1]) + (p1[2] + p1[3]);
                Pf[s2] = pack_acc8(p0, p1); }
        } else {
#pragma unroll
            for (int s2 = 0; s2 < 8; ++s2) Pf[s2] = (bf16x8){0, 0, 0, 0, 0, 0, 0, 0};
        }
        {
            f32x4 sc[16];
#pragma unroll
            for (int t = 0; t < 16; ++t) { const LAS unsigned char* kp = lds + NA_CTX + (16 * t + l15) * NA_VS + quad * 16;
                const bf16x8 k0 = *(const LAS bf16x8*)kp, k1 = *(const LAS bf16x8*)(kp + 64);
                f32x4 acc = (f32x4){0.f, 0.f, 0.f, 0.f}; acc = mfma16(k0, Bq0, acc); acc = mfma16(k1, Bq1, acc); sc[t] = acc; }
#pragma unroll
            for (int t = 0; t < 16; ++t)
#pragma unroll
                for (int e = 0; e < 4; ++e) m2 = fmaxf(m2, sc[t][e]);
            m2 = fmaxf(m2, shx(m2, 16, lane_o)); m2 = fmaxf(m2, shx(m2, 32, lane_o));
            const float m2l = m2 * LOG2E;
#pragma unroll
            for (int s2 = 0; s2 < 8; ++s2) { f32x4 p0, p1;
#pragma unroll
                for (int e = 0; e < 4; ++e) { p0[e] = __builtin_amdgcn_exp2f(sc[2 * s2][e] * LOG2E - m2l); p1[e] = __builtin_amdgcn_exp2f(sc[2 * s2 + 1][e] * LOG2E - m2l); }
                sum2 += (p0[0] + p0[1]) + (p0[2] + p0[3]) + (p1[0] + p1[1]) + (p1[2] + p1[3]);
                Pf[8 + s2] = pack_acc8(p0, p1); }
        }
        sum1 += shx(sum1, 16, lane_o); sum1 += shx(sum1, 32, lane_o);
        sum2 += shx(sum2, 16, lane_o); sum2 += shx(sum2, 32, lane_o);
        const float mm = fmaxf(m1, m2);
        const float a1 = __builtin_amdgcn_exp2f((m1 - mm) * LOG2E), a2 = __builtin_amdgcn_exp2f((m2 - mm) * LOG2E);
        const float inv = 1.f / (sum1 * a1 + sum2 * a2);
        const float f1 = a1 * inv, f2 = a2 * inv;
        __syncthreads();
        na_store_img(lds, n, tid, rimg);
        { const int un = (u + F.G < NU) ? u + F.G : u; const NaUnit nn = na_unit(un); na_load_img(K, nn, tid, rimg);
          const size_t qn = qrow_of(nn, lane_o); Bq0n = *(const bf16x8*)(Q + qn + 8 * quad); Bq1n = *(const bf16x8*)(Q + qn + 32 + 8 * quad); }
        __syncthreads();
        f32x4 o[4], oc[4];
#pragma unroll
        for (int dt = 0; dt < 4; ++dt) { o[dt] = (f32x4){0.f, 0.f, 0.f, 0.f}; oc[dt] = (f32x4){0.f, 0.f, 0.f, 0.f}; }
        if (band) {
#pragma unroll
            for (int s2 = 0; s2 < 8; ++s2) {
                const LAS unsigned char* vp = lds + ((rs - n.rsu + s2) * 64 + cb + 4 * quad + tq) * NA_VS + 8 * tp;
#pragma unroll
                for (int dt = 0; dt < 4; ++dt) { const s16x4 v0 = lds_tr(vp + dt * 32), v1 = lds_tr(vp + 16 * NA_VS + dt * 32); o[dt] = mfma16(cat8(v0, v1), Pf[s2], o[dt]); } }
        }
#pragma unroll
        for (int s2 = 0; s2 < 8; ++s2) {
            const LAS unsigned char* vp = lds + NA_CTX + (32 * s2 + 4 * quad + tq) * NA_VS + 8 * tp;
#pragma unroll
            for (int dt = 0; dt < 4; ++dt) { const s16x4 v0 = lds_tr(vp + dt * 32), v1 = lds_tr(vp + 16 * NA_VS + dt * 32); oc[dt] = mfma16(cat8(v0, v1), Pf[8 + s2], oc[dt]); } }
#pragma unroll
        for (int dt = 0; dt < 4; ++dt) { const float y0 = o[dt][0] * f1 + oc[dt][0] * f2, y1 = o[dt][1] * f1 + oc[dt][1] * f2, y2 = o[dt][2] * f1 + oc[dt][2] * f2, y3 = o[dt][3] * f1 + oc[dt][3] * f2;
            if (FP8_OUT2 && band) { int t8 = __builtin_amdgcn_cvt_pk_fp8_f32(y0, y1, 0, false); t8 = __builtin_amdgcn_cvt_pk_fp8_f32(y2, y3, t8, true);
                *(int*)((unsigned char*)O + qrow + 16 * dt + 4 * quad) = t8; }
            else { u32x2 ov; ov.x = cvt_pk_bf16(y0, y1); ov.y = cvt_pk_bf16(y2, y3);
                *(u32x2*)((unsigned char*)O + (FP8_OUT2 ? CTX_SIDE - (size_t)NLAT * 2048 : (size_t)0) + 2 * (qrow + 16 * dt + 4 * quad)) = ov; } }
    }
    __syncthreads();
}

constexpr int NPHASES = 1 + 9 + 8 + 8 + 9 + 1;
#ifndef EN_MASK
#define EN_MASK 0xFFFF
#endif
#define EN(b) ((EN_MASK >> (b)) & 1)

__global__ void __launch_bounds__(512, 2) fwd_kernel(Args args) {
    extern __shared__ __attribute__((aligned(16))) unsigned char lds_raw[];
    Frame F;
    F.lds = (LAS unsigned char*)lds_raw;
    F.MISC = (volatile LAS unsigned*)(F.lds + MISC_OFF);
    const int tid = threadIdx.x;
    F.wv = __builtin_amdgcn_readfirstlane(tid >> 6);
    F.G = gridDim.x; { const int bx = blockIdx.x; F.vcu = (F.G % 8 == 0) ? (bx % 8) * (F.G / 8) + bx / 8 : bx; }
    F.ws = args.ws;
    if (tid < 256) F.MISC[tid] = 0u;
    __syncthreads();
    const int lo = args.ph_lo, hi = args.ph_hi;
    XcdBarrier bar; bar.bar = (unsigned*)(F.ws + WS_CTL); bar.x = 0; bar.st = F.MISC + 8;
    if (hi - lo > 1) bar = xcd_barrier_post((unsigned*)(F.ws + WS_CTL), F.MISC + 8);
    int ph = 0, need = BG_NEED_RIN0; bool bg_on = true;
#define PH_BEGIN if (ph >= lo && ph < hi) { GAS unsigned char* wsg_ = (GAS unsigned char*)F.ws; asm volatile("" : "+s"(wsg_)); unsigned char* wso = (unsigned char*)wsg_; bf16* WB = (bf16*)(wso + WS_W); (void)WB;
#define PH_END_BG(busy_expr) if (bg_on) { __syncthreads(); int t_ = tid_of(F.wv); asm volatile("" : "+v"(t_)); const bool bz_ = (busy_expr); if (bz_ && t_ == 0) bg_signal(wso, ph); \
        bg_work(args, wso, F.lds, F.MISC, __builtin_amdgcn_readfirstlane(t_ >> 6), t_ & 63, ph, bz_, need); } if (ph + 1 < hi) xcd_barrier(bar, F.wv); } ++ph;
#define PH_END PH_END_BG(true)
#define CNT_BUSY(nunits, c) ((((nunits) - (c) + F.G - 1) / F.G) == (((nunits) + F.G - 1) / F.G) && (c) < (nunits))
    const int cid = (int)blockIdx.x;

    PH_BEGIN for (int rep_ = 0; rep_ < NREP(0); ++rep_) { if (rep_) xcd_barrier(bar, F.wv); if (EN(0)) p_prologue(F, args); } PH_END

    for (int layer = 0; layer < NLAYER; ++layer) {
        const int kind = layer % 3, j = layer / 3;
        const bool need_ctx = layer < NLAYER - 1;
        const int mrows = need_ctx ? NTOK : NLAT;
        bg_on = (layer == 0);
        if (layer == 2) { need = BG_NEED_NQKV; bg_on = true; } if (layer == 3) { need = BG_NEED_RIN1; bg_on = true; }
        PH_BEGIN for (int rep_ = 0; rep_ < NREP(1); ++rep_) { if (rep_) xcd_barrier(bar, F.wv); if (EN(1)) { if (layer == 0) p_pre<0>(F, args, layer); else p_pre<1>(F, args, layer); } } PH_END
        bg_on = (layer == 0);
        if (kind == 0) {
            PH_BEGIN for (int rep_ = 0; rep_ < NREP(2); ++rep_) { if (rep_) xcd_barrier(bar, F.wv); if (EN(2)) {
                pg8::StaticSched S; S.init(wso + WS_ACT, WB + WE_RIN + (size_t)j * 6144 * 1024, NTOK, 6144, FP8_INPROJ ? 512 : 1024, FP8_INPROJ ? 512 : 1024, FP8_INPROJ ? 512 : 1024, F.G, cid);
                LAS unsigned* ropel = (LAS unsigned*)(F.lds + pg8::STAGE_BYTES);
                { int t_o = tid_of(F.wv); asm volatile("" : "+v"(t_o)); typedef _Float16 h2 __attribute__((ext_vector_type(2)));
                  for (int i = t_o; i < 64 * 64; i += 512) { const f32x2 v = ((const f32x2*)(wso + WS_ROPE))[i]; const h2 hv = (h2){(_Float16)v.x, (_Float16)v.y}; ropel[i] = __builtin_bit_cast(unsigned, hv); } }
                __syncthreads();
                EpiRetIn E{(bf16*)(wso + WS_RQ), (bf16*)(wso + WS_RK), (bf16*)(wso + WS_RV), (bf16*)(wso + WS_RG), ropel};
                if (FP8_INPROJ) pg8::gemm_phase<EpiRetIn, pg8::StaticSched, true, true>(F.lds, S, E, 1024, 1024, (size_t)128 * 1024, F.wv);
                else pg8::gemm_phase<EpiRetIn, pg8::StaticSched, true>(F.lds, S, E, 2048, 2048, (size_t)128 * 2048, F.wv);
            } } PH_END_BG(CNT_BUSY(68 * 24, cid))
            PH_BEGIN for (int rep_ = 0; rep_ < NREP(3); ++rep_) { if (rep_) xcd_barrier(bar, F.wv); if (EN(3)) p_ret_scan(F, args, j); } PH_END
            need = (j == 0) ? BG_NEED_ROUT0 : BG_NEED_ROUT1; bg_on = true;
            PH_BEGIN for (int rep_ = 0; rep_ < NREP(4); ++rep_) { if (rep_) xcd_barrier(bar, F.wv); if (EN(4)) p_ret_intra(F, args, j, need_ctx ? 34 : 32); } PH_END_BG(CNT_BUSY(16 * (need_ctx ? 34 : 32), F.vcu))
            bg_on = (layer == 0);
            PH_BEGIN for (int rep_ = 0; rep_ < NREP(5); ++rep_) { if (rep_) xcd_barrier(bar, F.wv); if (EN(5)) {
                pg8::StaticSched S; S.init(wso + WS_ROG, WB + WE_ROUT + (size_t)j * 1024 * 2048, NLAT, 1024, FP8_OUTPROJ ? 1024 : 2048, FP8_OUTPROJ ? 1024 : 2048, FP8_OUTPROJ ? 1024 : 2048, F.G, cid);
                EpiResid E{(bf16*)(wso + WS_XALL), wso, layer, 2, FP8_OUTPROJ ? pg8::FP8_WSCALE : 1.f};
                if (FP8_OUTPROJ) pg8::gemm_phase<EpiResid, pg8::StaticSched, true, true>(F.lds, S, E, 2048, 2048, (size_t)128 * 2048, F.wv);
                else pg8::gemm_phase<EpiResid, pg8::StaticSched, true>(F.lds, S, E, 4096, 4096, (size_t)128 * 4096, F.wv);
                if (need_ctx) small_gemm_ctx<FP8_OUTPROJ != 0>(F, (const bf16*)(wso + WS_ROG + (FP8_OUTPROJ ? (size_t)36 * MiB - (size_t)NLAT * 4096 : (size_t)0)), 2048, WB + WE_ROUT + (size_t)j * 1024 * 2048, 2048, 2048, (bf16*)(wso + WS_XALL), modv(wso, layer, 4, 2));
            } } PH_END
        } else if (kind == 1) {
            PH_BEGIN for (int rep_ = 0; rep_ < NREP(6); ++rep_) { if (rep_) xcd_barrier(bar, F.wv); if (EN(6)) {
                { F1nSched S{(const char*)(wso + WS_A1N), (const char*)(wso + WS_ACT), F.G, F.vcu};
                  EpiF1n E{(bf16*)(wso + WS_G2)};
                  pg8::gemm_phase<EpiF1n, F1nSched, true>(F.lds, S, E, 512, 2048, (size_t)1024 * 2048, F.wv); }
                { F1Sched S{(const char*)(wso + WS_A1), (const char*)(wso + WS_ACT), F.G, F.vcu};
                  EpiF1 E{(bf16*)(wso + WS_G2), (bf16*)(wso + WS_G2C)};
                  pg8::gemm_phase<EpiF1, F1Sched, true>(F.lds, S, E, 512, 2048, (size_t)128 * 2048, F.wv); }
            } } PH_END_BG(CNT_BUSY(544, F.vcu))
            need = BG_NEED_FN; bg_on = true;
            PH_BEGIN for (int rep_ = 0; rep_ < NREP(7); ++rep_) { if (rep_) xcd_barrier(bar, F.wv); if (EN(7)) {
                { F2Sched S{(const char*)(wso + WS_AL), (const char*)(wso + WS_G2), F.G, F.vcu};
                  EpiF2 E{(bf16*)(wso + WS_FF)};
                  if (FP8_F2) pg8::gemm_phase<EpiF2, F2Sched, true, true>(F.lds, S, E, 1024, 8192, (size_t)128 * 8192, F.wv);
                  else pg8::gemm_phase<EpiF2, F2Sched, true>(F.lds, S, E, 2048, 16384, (size_t)128 * 16384, F.wv); }
                { F2cSched S{(const char*)(wso + WS_ALC), (const char*)(wso + WS_G2C), F.G, F.vcu};
                  EpiBf16 E{(bf16*)(wso + WS_FF + (FP8_OUT2 ? CTX_SIDE - (size_t)NLAT * 2048 : (size_t)0)), 1024, 1.f};
                  pg8::gemm_phase<EpiBf16, F2cSched, true>(F.lds, S, E, 1024, 1024, (size_t)128 * 1024, F.wv); }
            } } PH_END_BG(F.vcu < 16)
            bg_on = false;
            PH_BEGIN for (int rep_ = 0; rep_ < NREP(8); ++rep_) { if (rep_) xcd_barrier(bar, F.wv); if (EN(8)) {
                pg8::StaticSched S; S.init(wso + WS_FF, WB + WE_FN, NLAT, 1024, FP8_OUT2 ? 512 : 1024, FP8_OUT2 ? 512 : 1024, FP8_OUT2 ? 512 : 1024, F.G, cid);
                EpiResid E{(bf16*)(wso + WS_XALL), wso, layer, 2, FP8_OUT2 ? pg8::FP8_WSCALE : 1.f};
                if (FP8_OUT2) pg8::gemm_phase<EpiResid, pg8::StaticSched, true, true>(F.lds, S, E, 1024, 1024, (size_t)128 * 1024, F.wv);
                else pg8::gemm_phase<EpiResid, pg8::StaticSched, true>(F.lds, S, E, 2048, 2048, (size_t)128 * 2048, F.wv);
                small_gemm_ctx<FP8_OUT2 != 0>(F, (const bf16*)(wso + WS_FF + (FP8_OUT2 ? CTX_SIDE - (size_t)NLAT * 2048 : (size_t)0)), 1024, WB + WE_FN, 1024, 1024, (bf16*)(wso + WS_XALL), modv(wso, layer, 4, 2));
            } } PH_END
        } else {
            PH_BEGIN for (int rep_ = 0; rep_ < NREP(9); ++rep_) { if (rep_) xcd_barrier(bar, F.wv); if (EN(9)) {
                pg8::StaticSched S; S.init(wso + WS_ACT, WB + WE_NQKV, NTOK, 3072, FP8_INPROJ ? 512 : 1024, FP8_INPROJ ? 512 : 1024, FP8_INPROJ ? 512 : 1024, F.G, cid);
                EpiQKV E{(bf16*)(wso + WS_NQ), (bf16*)(wso + WS_NK), (bf16*)(wso + WS_NV), 0.125f * (FP8_INPROJ ? pg8::FP8_WSCALE : 1.f), FP8_INPROJ ? pg8::FP8_WSCALE : 1.f};
                if (FP8_INPROJ) pg8::gemm_phase<EpiQKV, pg8::StaticSched, true, true>(F.lds, S, E, 1024, 1024, (size_t)128 * 1024, F.wv);
                else pg8::gemm_phase<EpiQKV, pg8::StaticSched, true>(F.lds, S, E, 2048, 2048, (size_t)128 * 2048, F.wv);
            } } PH_END_BG(CNT_BUSY(68 * 12, cid))
            need = BG_NEED_NOUT; bg_on = true;
            PH_BEGIN for (int rep_ = 0; rep_ < NREP(10); ++rep_) { if (rep_) xcd_barrier(bar, F.wv); if (EN(10)) p_na_attn(F, args); } PH_END_BG(CNT_BUSY(2048 + 128, F.vcu))
            bg_on = false;
            PH_BEGIN for (int rep_ = 0; rep_ < NREP(11); ++rep_) { if (rep_) xcd_barrier(bar, F.wv); if (EN(11)) {
                pg8::StaticSched S; S.init(wso + WS_NO, WB + WE_NOUT, NLAT, 1024, FP8_OUT2 ? 512 : 1024, FP8_OUT2 ? 512 : 1024, FP8_OUT2 ? 512 : 1024, F.G, cid);
                EpiResid E{(bf16*)(wso + WS_XALL), wso, layer, 2, FP8_OUT2 ? pg8::FP8_WSCALE : 1.f};
                if (FP8_OUT2) pg8::gemm_phase<EpiResid, pg8::StaticSched, true, true>(F.lds, S, E, 1024, 1024, (size_t)128 * 1024, F.wv);
                else pg8::gemm_phase<EpiResid, pg8::StaticSched, true>(F.lds, S, E, 2048, 2048, (size_t)128 * 2048, F.wv);
                small_gemm_ctx<FP8_OUT2 != 0>(F, (const bf16*)(wso + WS_NO + (FP8_OUT2 ? CTX_SIDE - (size_t)NLAT * 2048 : (size_t)0)), 1024, WB + WE_NOUT, 1024, 1024, (bf16*)(wso + WS_XALL), modv(wso, layer, 4, 2));
            } } PH_END
        }
        PH_BEGIN for (int rep_ = 0; rep_ < NREP(12); ++rep_) { if (rep_) xcd_barrier(bar, F.wv); if (EN(12)) p_mid(F, args, layer, mrows); } PH_END
        need = (layer == 0) ? BG_NEED_MOE0 : (layer == 1) ? BG_NEED_MOE1 : (layer == 2) ? BG_NEED_MOE2 : BG_TOTAL; bg_on = true;
        PH_BEGIN for (int rep_ = 0; rep_ < NREP(13); ++rep_) { if (rep_) xcd_barrier(bar, F.wv); if (EN(13)) p_perm(F, mrows); } PH_END
        bg_on = (layer == 0);
        PH_BEGIN for (int rep_ = 0; rep_ < NREP(14); ++rep_) { if (rep_) xcd_barrier(bar, F.wv); if (EN(14)) {
            volatile LAS int* ts = (volatile LAS int*)(F.MISC + 32);
            { int t_o = tid_of(F.wv); asm volatile("" : "+v"(t_o)); if (t_o < 17) ts[t_o] = ((const int*)(wso + WS_MOETAB))[t_o];
              __syncthreads();
              if (t_o < 160) { int e_ = 0;
#pragma unroll
                  for (int k = 1; k < 16; ++k) e_ += (t_o >= ts[k]) ? 1 : 0;
                  ts[40 + t_o] = e_; } }
            __syncthreads();
            MoeSched S{ts, (const char*)(wso + WS_XP), (const char*)(wso + WS_W) + WE_MG * 2 + (size_t)layer * 16 * 1048576, 8, 131072, F.G, F.vcu};
            EpiMoe1 E{(unsigned char*)(wso + WS_H)};
            pg8::gemm_phase<EpiMoe1, MoeSched, true, true>(F.lds, S, E, 1024, 1024, (size_t)(WE_MU - WE_MG) * 2, F.wv);
        } } PH_END_BG(CNT_BUSY(((volatile LAS int*)(F.MISC + 32))[16] * 8, F.vcu))
        PH_BEGIN for (int rep_ = 0; rep_ < NREP(15); ++rep_) { if (rep_) xcd_barrier(bar, F.wv); if (EN(15)) {
            volatile LAS int* ts = (volatile LAS int*)(F.MISC + 32);
            { int t_o = tid_of(F.wv); asm volatile("" : "+v"(t_o)); if (t_o < 17) ts[t_o] = ((const int*)(wso + WS_MOETAB))[t_o];
              __syncthreads();
              if (t_o < 160) { int e_ = 0;
#pragma unroll
                  for (int k = 1; k < 16; ++k) e_ += (t_o >= ts[k]) ? 1 : 0;
                  ts[40 + t_o] = e_; } }
            __syncthreads();
            MoeSched S{ts, (const char*)(wso + WS_H), (const char*)(wso + WS_W) + WE_MD * 2 + (size_t)layer * 16 * 1048576, 4, 262144, F.G, F.vcu};
#if FP8_YB
            EpiFp8N E{(unsigned char*)(wso + WS_YB)};
            pg8::gemm_phase<EpiFp8N, MoeSched, true, true>(F.lds, S, E, 1024, 1024, (size_t)128 * 1024, F.wv);
#else
            EpiBf16N E{(bf16*)(wso + WS_YB), 1024, pg8::FP8_WSCALE};
            pg8::gemm_phase<EpiBf16N, MoeSched, true, true>(F.lds, S, E, 1024, 1024, (size_t)128 * 1024, F.wv);
#endif
        } } PH_END_BG(CNT_BUSY(((volatile LAS int*)(F.MISC + 32))[16] * 4, F.vcu))
    }
    PH_BEGIN p_pre<2>(F, args, 4); PH_END
#undef PH_BEGIN
#undef PH_END
#undef PH_END_BG
#undef CNT_BUSY
}

extern "C" void kernel_launch(void* const* d_in, const int* in_sizes, int n_in, void* d_out, int out_size, void* d_ws, size_t ws_size, hipStream_t stream) {
    static int grid = 0;
    if (grid == 0) {
        if (n_in != 22 || out_size != NLAT * D || ws_size < WS_END) { fprintf(stderr, "kernel_launch: unexpected shapes (n_in %d out %d ws %zu)\n", n_in, out_size, ws_size); grid = -1; return; }
        int dev = 0, cus = 0, per_cu = 0;
        if (hipGetDevice(&dev) != hipSuccess || hipDeviceGetAttribute(&cus, hipDeviceAttributeMultiprocessorCount, dev) != hipSuccess) { grid = -1; return; }
        if (hipFuncSetAttribute((const void*)fwd_kernel, hipFuncAttributeMaxDynamicSharedMemorySize, LDS_BYTES) != hipSuccess) { fprintf(stderr, "kernel_launch: hipFuncSetAttribute failed\n"); grid = -1; return; }
        if (hipOccupancyMaxActiveBlocksPerMultiprocessor(&per_cu, (const void*)fwd_kernel, 512, LDS_BYTES) != hipSuccess || per_cu < 1) fprintf(stderr, "kernel_launch: occupancy query reports %d\n", per_cu);
        (void)hipGetLastError();
        grid = cus;
    }
    if (grid < 0) return;
    (void)hipMemsetAsync((char*)d_ws + WS_CTL, 0, CTL_ZERO_BYTES, stream);
    Args a{};
    for (int i = 0; i < 22; ++i) a.in[i] = (const float*)d_in[i];
    a.out = (float*)d_out; a.ws = (unsigned char*)d_ws;
#if MK_PER_PHASE
    for (int p = 0; p < NPHASES; ++p) { a.ph_lo = p; a.ph_hi = p + 1; hipLaunchKernelGGL(fwd_kernel, dim3(grid), dim3(512), LDS_BYTES, stream, a); }
#else
    a.ph_lo = 0; a.ph_hi = NPHASES; hipLaunchKernelGGL(fwd_kernel, dim3(grid), dim3(512), LDS_BYTES, stream, a);
#endif
}
```

```cpp
#include <hip/hip_runtime.h>
#include <cstdio>
#include <cstdint>
#include <type_traits>

#define LAS __attribute__((address_space(3)))
#define GAS __attribute__((address_space(1)))
typedef unsigned short bf16;
typedef short bf16x8 __attribute__((ext_vector_type(8)));
typedef short s16x4 __attribute__((ext_vector_type(4)));
typedef float f32x4 __attribute__((ext_vector_type(4)));
typedef float f32x2 __attribute__((ext_vector_type(2)));
typedef unsigned u32x4 __attribute__((ext_vector_type(4)));
typedef unsigned u32x2 __attribute__((ext_vector_type(2)));

#ifndef FP8_INPROJ
#define FP8_INPROJ 1
#endif
#ifndef FP8_OUTPROJ
#define FP8_OUTPROJ 1
#endif
#ifndef FP8_RETSTORE
#define FP8_RETSTORE 1
#endif
#ifndef FP8_YB
#define FP8_YB 1
#endif
#ifndef FP8_OUT2
#define FP8_OUT2 1
#endif
constexpr size_t CTX_SIDE = 20u << 20;
#ifndef FP8_F2
#define FP8_F2 1
#endif
#ifndef MK_PER_PHASE
#define MK_PER_PHASE 0
#endif

constexpr int D = 1024, NB = 4, SEQ = 4096, LCTX = 256, NLAT = NB * SEQ, NCTX = NB * LCTX, NTOK = NLAT + NCTX;
constexpr int NLAYER = 4, NMOD = 6, NEXP = 16;
constexpr float EPS = 1e-6f;
constexpr int RH = 4, RDK = 256, RDV = 512, RCH = 128;
constexpr int NAH = 16, NAHD = 64;
constexpr int PMAX = 2 * NTOK + NEXP * 256;

constexpr size_t MiB = 1u << 20;
constexpr size_t WS_CTL = 0, CTL_ZERO_BYTES = 64 * 1024;
constexpr size_t WS_MOD = 1 * MiB;
constexpr size_t WS_ROPE = 2 * MiB;
constexpr size_t WS_A1 = WS_ROPE + 64 * 1024;
constexpr size_t WS_ALC = WS_A1 + 512 * 256 * 2;
constexpr size_t WS_A1N = WS_ALC + 256 * 512 * 2;
constexpr size_t WS_BLKCNT = 3 * MiB;
constexpr size_t WS_MOETAB = WS_BLKCNT + 64 * 1024;
constexpr size_t WS_ROUTE = 4 * MiB;
constexpr size_t WS_DEST = 5 * MiB;
constexpr size_t WS_W = 8 * MiB;
constexpr size_t WE_RIN = 0, WE_ROUT = WE_RIN + 2ull * 6144 * 1024, WE_FN = WE_ROUT + 2ull * 1024 * 2048, WE_NQKV = WE_FN + 1024ull * 1024,
                 WE_NOUT = WE_NQKV + 3072ull * 1024, WE_MG = WE_NOUT + 1024ull * 1024, WE_MU = WE_MG + 64ull * 1024 * 1024, WE_MD = WE_MU + 64ull * 1024 * 1024,
                 WE_END = WE_MD + 64ull * 1024 * 1024;
static_assert(WE_END * 2 <= 426 * MiB, "weights");
constexpr size_t WS_AL = 434 * MiB;
constexpr size_t WS_XALL = 498 * MiB;
constexpr size_t WS_ACT = 566 * MiB;
constexpr size_t WS_S = 600 * MiB;
constexpr size_t WS_RQ = WS_S, WS_RK = WS_S + 34 * MiB, WS_RV = WS_S + 68 * MiB, WS_RG = WS_S + 136 * MiB, WS_ROF = WS_S + 204 * MiB, WS_ROB = WS_S + 272 * MiB;
constexpr size_t WS_G2 = WS_S, WS_G2C = WS_S + 64 * MiB, WS_FF = WS_S + 68 * MiB;
constexpr size_t WS_NQ = WS_S, WS_NK = WS_S + 34 * MiB, WS_NV = WS_S + 68 * MiB, WS_NO = WS_S + 102 * MiB;
constexpr size_t WS_XP = WS_S, WS_H = WS_S + 76 * MiB, WS_YB = WS_S + 152 * MiB;
constexpr size_t WS_ROG = 940 * MiB;
constexpr size_t WS_END = 1008 * MiB;
static_assert((size_t)PMAX * 2048 <= 76 * MiB, "moe rows");

constexpr int LDS_BYTES = 159 * 1024;
constexpr int MISC_OFF = 158 * 1024;

__device__ __forceinline__ unsigned f2bf(float f) { unsigned u = __builtin_bit_cast(unsigned, f); return (u + 0x7fffu + ((u >> 16) & 1u)) >> 16; }
__device__ __forceinline__ unsigned pk2(float lo, float hi) { return f2bf(lo) | (f2bf(hi) << 16); }
__device__ __forceinline__ float bf2f(unsigned short b) { return __builtin_bit_cast(float, ((unsigned)b) << 16); }
__device__ __forceinline__ float bflo(unsigned u) { return __builtin_bit_cast(float, u << 16); }
__device__ __forceinline__ float bfhi(unsigned u) { return __builtin_bit_cast(float, u & 0xffff0000u); }
__device__ __forceinline__ float silu_f(float v) { return v * __builtin_amdgcn_rcpf(1.f + __expf(-v)); }
__device__ __forceinline__ float shx(float v, int o, int lane) { return __builtin_bit_cast(float, __builtin_amdgcn_ds_bpermute((lane ^ o) << 2, __builtin_bit_cast(int, v))); }
__device__ __forceinline__ float wave_sum(float v, int lane) {
#pragma unroll
    for (int o = 1; o < 64; o <<= 1) v += shx(v, o, lane);
    return v;
}
__device__ __forceinline__ int tid_of(int wave_sgpr) { int l; asm volatile("v_mbcnt_lo_u32_b32 %0, -1, 0\n\tv_mbcnt_hi_u32_b32 %0, -1, %0" : "=v"(l)); return wave_sgpr * 64 + l; }
#define LDS_WAIT() asm volatile("s_waitcnt lgkmcnt(0)" ::: "memory")
#define VM_WAIT() asm volatile("s_waitcnt vmcnt(0)" ::: "memory")

#define XB_TMO      128
#define XB_XCNT(j)  (256  + 64 * (j))
#define XB_XSUB(j)  (1280 + 64 * (j))
#define XB_XGEN(j)  (2304 + 64 * (j))
#define XB_TOP      3328
#define XB_TOPGEN   3392
#define XCD_BAR_WORDS 3456
#define XB_SPIN_CAP (1u << 18)
__device__ __forceinline__ unsigned xb_ld(unsigned* p)              { return __hip_atomic_load(p, __ATOMIC_RELAXED, __HIP_MEMORY_SCOPE_AGENT); }
__device__ __forceinline__ unsigned xb_add(unsigned* p, unsigned v) { return __hip_atomic_fetch_add(p, v, __ATOMIC_RELAXED, __HIP_MEMORY_SCOPE_AGENT); }
__device__ __forceinline__ unsigned xb_xcc_id() { return (unsigned)__builtin_amdgcn_s_getreg((3 << 11) | 20) & 0xFu; }
#define XB_SPIN(cond, bar) do { unsigned _sp = 0; while (cond) { __builtin_amdgcn_s_sleep(1); \
    if ((++_sp & 255u) == 0u) { if (xb_ld(&(bar)[XB_TMO])) break; if (_sp > XB_SPIN_CAP) { atomicAdd(&(bar)[XB_TMO], 1u); break; } } } } while (0)
struct XcdBarrier { unsigned* bar; unsigned x; volatile LAS unsigned* st; };
__device__ __forceinline__ XcdBarrier xcd_barrier_post(unsigned* bar, volatile LAS unsigned* st) {
    XcdBarrier b; b.bar = bar; b.x = xb_xcc_id(); b.st = st;
    if (threadIdx.x == 0) (void)xb_add(&bar[XB_XCNT(b.x)], 1u);
    return b;
}
__device__ __forceinline__ void xcd_barrier_complete(unsigned* bar, unsigned x, unsigned& nloc, unsigned& nx) {
    const unsigned G = gridDim.x * gridDim.y * gridDim.z;
    unsigned sum, cnt, mine, sp = 0u;
    for (;;) {
        sum = 0u; cnt = 0u; mine = 0u;
#pragma unroll
        for (unsigned j = 0; j < 16; ++j) { const unsigned c = xb_ld(&bar[XB_XCNT(j)]); sum += c; cnt += (c > 0u) ? 1u : 0u; mine = (j == x) ? c : mine; }
        if (sum == G) break;
        __builtin_amdgcn_s_sleep(1);
        if ((++sp & 255u) == 0u) { if (xb_ld(&bar[XB_TMO])) break; if (sp > XB_SPIN_CAP) { atomicAdd(&bar[XB_TMO], 1u); break; } }
    }
    nloc = mine > 0u ? mine : 1u; nx = cnt > 0u ? cnt : 1u;
}
__device__ __forceinline__ void xcd_barrier(const XcdBarrier& b, const int wave_sgpr) {
    asm volatile("s_waitcnt vmcnt(0)" ::: "memory");
    __syncthreads();
    if (tid_of(wave_sgpr) == 0) {
        unsigned* bar = b.bar;
        __builtin_amdgcn_s_waitcnt(0);
        unsigned nloc = b.st[0], nx = b.st[1];
        if (nloc == 0u) { xcd_barrier_complete(bar, b.x, nloc, nx); b.st[0] = nloc; b.st[1] = nx; }
        const unsigned old = xb_add(&bar[XB_XSUB(b.x)], 1u);
        const unsigned gen = old / nloc;
        if (old + 1u == (gen + 1u) * nloc) {
            __builtin_amdgcn_fence(__ATOMIC_RELEASE, "agent");
            asm volatile("s_waitcnt vmcnt(0)" ::: "memory");
            const unsigned og = xb_add(&bar[XB_TOP], 1u);
            const unsigned tg = og / nx;
            if (og + 1u == (tg + 1u) * nx) {
#pragma unroll
                for (unsigned jx = 0; jx < 16; ++jx) (void)xb_add(&bar[XB_XGEN(jx)], 1u);
                __builtin_amdgcn_fence(__ATOMIC_ACQUIRE, "agent");
                asm volatile("s_waitcnt vmcnt(0)" ::: "memory");
            } else {
                __builtin_amdgcn_fence(__ATOMIC_ACQUIRE, "agent");
                XB_SPIN(xb_ld(&bar[XB_XGEN(b.x)]) == gen, bar);
                asm volatile("s_waitcnt vmcnt(0)" ::: "memory");
            }
        } else {
            __builtin_amdgcn_fence(__ATOMIC_ACQUIRE, "agent");
            XB_SPIN(xb_ld(&bar[XB_XGEN(b.x)]) == gen, bar);
            asm volatile("s_waitcnt vmcnt(0)" ::: "memory");
        }
    }
    __syncthreads();
}

namespace pg8 {
constexpr int BM = 256, BK = 64, HALF = 128, HTB = HALF * BK * 2, STAGE_BYTES = 8 * HTB;
__host__ __device__ __forceinline__ int lds_byte(int r, int c) { const int pos = (c >> 3) ^ ((r >> 1) & 7); return r * 128 + pos * 16 + (c & 7) * 2; }
__host__ __device__ __forceinline__ void stage_rc(int b, int& R, int& C) { R = b >> 7; const int pos = (b >> 4) & 7; C = (pos ^ ((R >> 1) & 7)) * 8 + ((b & 15) >> 1); }
__host__ __device__ __forceinline__ int perm32(int rho) { const int n = rho >> 4, i = rho & 15; return 8 * (i >> 2) + 4 * n + (i & 3); }

struct Unit { const char* A; const char* B0; int pm, pn, aux, nt; };

typedef int i32x8 __attribute__((ext_vector_type(8)));
__device__ __forceinline__ i32x8 cat_i8(const bf16x8& lo, const bf16x8& hi) { const u32x4 a = __builtin_bit_cast(u32x4, lo), b = __builtin_bit_cast(u32x4, hi); return (i32x8){(int)a.x, (int)a.y, (int)a.z, (int)a.w, (int)b.x, (int)b.y, (int)b.z, (int)b.w}; }
constexpr int FP8_SCALE_A = 0x7F7F7F7F, FP8_SCALE_B = 0x7F7F7F7F;
constexpr float FP8_WSCALE = 1.f / 32.f;
template <class E, class = void> struct has_brow : std::false_type {};
template <class E> struct has_brow<E, std::void_t<decltype(E::brow(0))>> : std::true_type {};
template <class E, class = void> struct has_lds_store : std::false_type {};
template <class E> struct has_lds_store<E, std::void_t<decltype(E::LDS_STORE)>> : std::true_type {};
template <class Epi, class Sched, bool ALIGN_EPI, bool FP8 = false>
__device__ __forceinline__ void gemm_phase(LAS unsigned char* lds, const Sched& S, const Epi& E, const int ldaB  , const int ldbB, const size_t hstepB  , const int wave_sgpr) {
    int tid = tid_of(wave_sgpr); asm volatile("" : "+v"(tid));
    const int wid = __builtin_amdgcn_readfirstlane(tid >> 6), lane = tid & 63, wr = wid >> 2, wc = wid & 3, fr = lane & 15, fq = lane >> 4;
    unsigned voffA[2], voffB[2];
#pragma unroll
    for (int i = 0; i < 2; ++i) { int R, C; stage_rc(tid * 16 + i * 8192, R, C); int Rb = Epi::PERM ? ((R & ~31) + perm32(R & 31)) : R;
        if constexpr (has_brow<Epi>::value) Rb = Epi::brow(R);
        voffA[i] = (unsigned)(R * ldaB + C * 2); voffB[i] = (unsigned)(Rb * ldbB + C * 2); }
    const size_t kstep = (size_t)(BK * 2);
    const size_t hstepA = (size_t)HALF * ldaB;
    const unsigned ldsw = (unsigned)wid * 1024u;
    const unsigned ldsbase = (unsigned)(size_t)lds + ldsw;
    const int aoff = lds_byte(wr * 64 + fr, fq * 8), boff = lds_byte(wc * 32 + fr, fq * 8);
#define PG8_SA(b, h) (((b) * 2 + (h)) * HTB)
#define PG8_SB(b, h) ((4 + (b) * 2 + (h)) * HTB)
#define PG8_STAGE(bufoff, gbase, voff) do { _Pragma("unroll") for (int _i = 0; _i < 2; ++_i) { \
        if constexpr (FP8) { unsigned keep_; asm volatile("s_mov_b32 %0, m0\n\ts_mov_b32 m0, %2\n\ts_nop 0\n\tglobal_load_lds_dwordx4 %1, %3\n\ts_mov_b32 m0, %0" : "=&s"(keep_) \
            : "v"((voff)[_i]), "s"(ldsbase + (unsigned)((bufoff) + _i * 8192)), "s"((const char*)(gbase)) : "memory"); } \
        else __builtin_amdgcn_global_load_lds((const unsigned*)((const char*)(gbase) + (voff)[_i]), (LAS unsigned*)(lds + (bufoff) + ldsw + _i * 8192), 16, 0, 0); } } while (0)
#define PG8_LDA(dst, b, h) do { int ao1_ = aoff ^ 64; asm volatile("" : "+v"(ao1_)); _Pragma("unroll") for (int m = 0; m < 4; ++m) { dst[m][0] = *(const LAS bf16x8*)(lds + PG8_SA(b, h) + aoff + m * 2048); dst[m][1] = *(const LAS bf16x8*)(lds + PG8_SA(b, h) + ao1_ + m * 2048); } } while (0)
#define PG8_LDB(dst, b, h) do { int bo1_ = boff ^ 64; asm volatile("" : "+v"(bo1_)); _Pragma("unroll") for (int n = 0; n < 2; ++n) { dst[n][0] = *(const LAS bf16x8*)(lds + PG8_SB(b, h) + boff + n * 2048); dst[n][1] = *(const LAS bf16x8*)(lds + PG8_SB(b, h) + bo1_ + n * 2048); } } while (0)
#define PG8_MMA(ai, bj, At, Bt) do { __builtin_amdgcn_s_setprio(1); _Pragma("unroll") for (int m = 0; m < 4; ++m) _Pragma("unroll") for (int n = 0; n < 2; ++n) { \
        if constexpr (FP8) acc[ai][bj][m][n] = __builtin_amdgcn_mfma_scale_f32_16x16x128_f8f6f4(cat_i8(Bt[n][0], Bt[n][1]), cat_i8(At[m][0], At[m][1]), acc[ai][bj][m][n], 0, 0, 0, FP8_SCALE_B, 0, FP8_SCALE_A); \
        else { _Pragma("unroll") for (int k = 0; k < 2; ++k) acc[ai][bj][m][n] = __builtin_amdgcn_mfma_f32_16x16x32_bf16(Bt[n][k], At[m][k], acc[ai][bj][m][n], 0, 0, 0); } } __builtin_amdgcn_s_setprio(0); } while (0)
#define PG8_WAIT_V(n) asm volatile("s_waitcnt vmcnt(" #n ")" ::: "memory")
#define PG8_WAIT_L(n) asm volatile("s_waitcnt lgkmcnt(" #n ")" ::: "memory")
#define PG8_BAR __builtin_amdgcn_s_barrier()
#define PG8_SCHED __builtin_amdgcn_sched_barrier(0)
    Unit cur, nxt; int ui = 0;
    if (!S.next(0, cur)) return;
    f32x4 acc[2][2][4][2];
#pragma unroll
    for (int a = 0; a < 2; ++a)
#pragma unroll
        for (int b = 0; b < 2; ++b)
#pragma unroll
            for (int m = 0; m < 4; ++m)
#pragma unroll
                for (int n = 0; n < 2; ++n) acc[a][b][m][n] = (f32x4){0.f, 0.f, 0.f, 0.f};
    bf16x8 At[4][2], B0[2][2], B1[2][2];
    const char* cA = cur.A; const char* cB0 = cur.B0;
    PG8_STAGE(PG8_SB(0, 0), cB0, voffB); PG8_STAGE(PG8_SB(0, 1), cB0 + hstepB, voffB); PG8_STAGE(PG8_SA(0, 0), cA, voffA); PG8_STAGE(PG8_SA(0, 1), cA + hstepA, voffA);
    if (wr == 1) PG8_BAR;
    PG8_WAIT_V(2); PG8_BAR;
    PG8_STAGE(PG8_SB(1, 0), cB0 + kstep, voffB); PG8_STAGE(PG8_SA(1, 0), cA + kstep, voffA); PG8_STAGE(PG8_SB(1, 1), cB0 + hstepB + kstep, voffB);
    PG8_WAIT_V(6); PG8_BAR;
    for (;;) {
        const bool has_next = S.next(ui + 1, nxt);
        const char* nA = has_next ? nxt.A : cA; const char* nB0 = has_next ? nxt.B0 : cB0;
        int nt = cur.nt; asm volatile("" : "+s"(nt));
        for (int t = 0; t < nt; t += 2) {
            const bool last = (t == nt - 2);
            const char* a1 = cA + (size_t)(t + 1) * kstep;
            const char* a2 = last ? nA : cA + (size_t)(t + 2) * kstep;
            const char* b20 = last ? nB0 : cB0 + (size_t)(t + 2) * kstep;
            const char* a3 = a2 + kstep; const char* b30 = b20 + kstep;
            PG8_LDB(B0, 0, 0); PG8_LDB(B1, 0, 1); PG8_SCHED; PG8_LDA(At, 0, 0); PG8_STAGE(PG8_SA(1, 1), a1 + hstepA, voffA);
            PG8_WAIT_V(8); PG8_WAIT_L(0); PG8_BAR; PG8_MMA(0, 0, At, B0); PG8_MMA(0, 1, At, B1); PG8_BAR; PG8_SCHED;
            PG8_LDA(At, 0, 1); PG8_STAGE(PG8_SB(0, 0), b20, voffB); PG8_STAGE(PG8_SB(0, 1), b20 + hstepB, voffB); PG8_STAGE(PG8_SA(0, 0), a2, voffA);
            PG8_WAIT_V(8); PG8_WAIT_L(0); PG8_BAR; PG8_MMA(1, 0, At, B0); PG8_MMA(1, 1, At, B1); PG8_BAR; PG8_SCHED;
            PG8_LDB(B0, 1, 0); PG8_LDB(B1, 1, 1); PG8_SCHED; PG8_LDA(At, 1, 0); PG8_STAGE(PG8_SA(0, 1), a2 + hstepA, voffA);
            PG8_WAIT_V(8); PG8_WAIT_L(0); PG8_BAR; PG8_MMA(0, 0, At, B0); PG8_MMA(0, 1, At, B1); PG8_BAR; PG8_SCHED;
            PG8_LDA(At, 1, 1); PG8_STAGE(PG8_SB(1, 0), b30, voffB); PG8_STAGE(PG8_SB(1, 1), b30 + hstepB, voffB); PG8_STAGE(PG8_SA(1, 0), a3, voffA);
            PG8_WAIT_V(8); PG8_WAIT_L(0); PG8_BAR; PG8_MMA(1, 0, At, B0); PG8_MMA(1, 1, At, B1); PG8_BAR; PG8_SCHED;
        }
        if constexpr (ALIGN_EPI) { if (wr == 0) PG8_BAR; }
        { int t_e = tid_of(wave_sgpr); asm volatile("" : "+v"(t_e)); const int fr_e = t_e & 15, fq_e = (t_e >> 4) & 3;
          if constexpr (has_lds_store<Epi>::value) { static_assert(ALIGN_EPI, "LDS-staged epilogues use workgroup barriers"); E.lds_store(acc, cur, wr, wc, fr_e, fq_e, lds + STAGE_BYTES, t_e); }
          else E(acc, cur, wr, wc, fr_e, fq_e); }
        if (!has_next) break;
#pragma unroll
        for (int a = 0; a < 2; ++a)
#pragma unroll
            for (int b = 0; b < 2; ++b)
#pragma unroll
                for (int m = 0; m < 4; ++m)
#pragma unroll
                    for (int n = 0; n < 2; ++n) acc[a][b][m][n] = (f32x4){0.f, 0.f, 0.f, 0.f};
        cur = nxt; cA = nA; cB0 = nB0; ++ui;
        if constexpr (ALIGN_EPI) { if (wr == 1) PG8_BAR; }
    }
    PG8_WAIT_V(0);
    if constexpr (!ALIGN_EPI) { if (wr == 0) PG8_BAR; }
    PG8_BAR;
#undef PG8_SA
#undef PG8_SB
#undef PG8_STAGE
#undef PG8_LDA
#undef PG8_LDB
#undef PG8_MMA
#undef PG8_WAIT_V
#undef PG8_WAIT_L
#undef PG8_BAR
#undef PG8_SCHED
}

constexpr int NXCD = 8, WGM = 8;
struct StaticSched {
    const char* A; const char* Bt; size_t ldaB, ldbB; int nM, nN, nwg, G, c, nt;
    __device__ void init(const void* A_, const void* Bt_, int M, int N, int K, int lda, int ldb, int G_, int c_) { A = (const char*)A_; Bt = (const char*)Bt_; ldaB = (size_t)lda * 2; ldbB = (size_t)ldb * 2; nM = M / BM; nN = N / BM; nwg = nM * nN; G = G_; c = c_; nt = K / BK; }
    __device__ bool next(int i, Unit& u) const {
        const long L = (long)i * G + c; if (L >= nwg) return false;
        int wgid = (int)L; { const int q = nwg / NXCD, r = nwg % NXCD, xcd = wgid % NXCD, off = wgid / NXCD; wgid = (xcd < r ? xcd * (q + 1) : r * (q + 1) + (xcd - r) * q) + off; }
        const int nig = WGM * nN, gid = wgid / nig, fm = gid * WGM, gsz = (nM - fm) < WGM ? (nM - fm) : WGM;
        u.pm = fm + ((wgid % nig) % gsz); u.pn = (wgid % nig) / gsz; u.aux = 0; u.nt = nt;
        u.A = A + (size_t)u.pm * BM * ldaB; u.B0 = Bt + (size_t)u.pn * BM * ldbB; return true;
    }
};
}

struct Args { const float* in[22]; float* out; unsigned char* ws; int ph_lo, ph_hi; };
struct Frame {
    LAS unsigned char* lds; volatile LAS unsigned* MISC;
    int vcu, G, wv;
    unsigned char* ws;
};
enum { I_X = 0, I_C, I_CTX, I_CCTX, I_WMOD, I_BMOD, I_NMIX, I_NFFN, I_NFIN, I_RWIN, I_RDEC, I_RGN, I_RWOUT, I_FNW, I_NAQKV, I_NARPB, I_NAOUT, I_RTW, I_RTB, I_MG, I_MU, I_MD };

__device__ __forceinline__ const float* modv(const unsigned char* ws, int layer, int bidx, int which) { return (const float*)(ws + WS_MOD) + ((size_t)(layer * 5 + bidx) * NMOD + which) * D; }
__device__ __forceinline__ int bidx_of_row(int row) { return row < NLAT ? (row >> 12) : 4; }

#ifndef REP_MASK
#define REP_MASK 0
#endif
#define NREP(b) (1 + ((REP_MASK >> (b)) & 1))
__device__ __forceinline__ int rope_perm(int n) {
    if (n >= 2048) return n;
    const int head = n >> 8, c = n & 255, qd = c >> 6, i = c & 63;
    const int j = (qd == 0) ? i : (qd == 2) ? 64 + i : (qd == 1) ? 128 + i : 192 + i;
    return head * 256 + j;
}
struct TItem { const float* W; bf16* WT; int K, N, item; bool rp; bool f8; };
__device__ __forceinline__ void titem_load(const TItem& t, f32x4 (&v)[16], int lane) {
    const int nblk = t.N / 64, kb = t.item / nblk, nb = t.item % nblk, k0 = 64 * kb, n0 = 64 * nb;
    const float* src = t.W + (size_t)(k0 + (lane >> 4)) * t.N + n0 + (lane & 15) * 4;
#pragma unroll
    for (int r = 0; r < 16; ++r) v[r] = *(const f32x4*)(src + (size_t)(4 * r) * t.N);
}
__device__ __forceinline__ void titem_store(const TItem& t, const f32x4 (&v)[16], LAS float* scr, int lane) {
    const int nblk = t.N / 64, kb = t.item / nblk, nb = t.item % nblk, k0 = 64 * kb, n0 = 64 * nb;
#pragma unroll
    for (int r = 0; r < 16; ++r) { const int kk = 4 * r + (lane >> 4), n4 = (lane & 15) * 4;
        scr[kk * 65 + n4 + 0] = v[r][0]; scr[kk * 65 + n4 + 1] = v[r][1]; scr[kk * 65 + n4 + 2] = v[r][2]; scr[kk * 65 + n4 + 3] = v[r][3]; }
    LDS_WAIT(); asm volatile("" ::: "memory");
    const int c = lane & 7;
#pragma unroll 2
    for (int j = 0; j < 8; ++j) { const int n = 8 * j + (lane >> 3); const LAS float* s = scr + (8 * c) * 65 + n;
        float x[8];
#pragma unroll
        for (int q = 0; q < 8; ++q) x[q] = s[q * 65];
        const int nd = t.rp ? rope_perm(n0 + n) : (n0 + n);
        if (t.f8) { u32x2 o8; int q = __builtin_amdgcn_cvt_pk_fp8_f32(x[0] * 32.f, x[1] * 32.f, 0, false); q = __builtin_amdgcn_cvt_pk_fp8_f32(x[2] * 32.f, x[3] * 32.f, q, true); o8.x = (unsigned)q;
            q = __builtin_amdgcn_cvt_pk_fp8_f32(x[4] * 32.f, x[5] * 32.f, 0, false); q = __builtin_amdgcn_cvt_pk_fp8_f32(x[6] * 32.f, x[7] * 32.f, q, true); o8.y = (unsigned)q;
            *(u32x2*)((unsigned char*)t.WT + (size_t)nd * t.K + k0 + 8 * c) = o8; }
        else { u32x4 o; o.x = pk2(x[0], x[1]); o.y = pk2(x[2], x[3]); o.z = pk2(x[4], x[5]); o.w = pk2(x[6], x[7]); *(u32x4*)(t.WT + (size_t)nd * t.K + k0 + 8 * c) = o; } }
    LDS_WAIT(); asm volatile("" ::: "memory");
}
__device__ __forceinline__ int seg_items(int seg) { return seg < 2 ? 16 * 96 : seg < 4 ? 32 * 16 : seg == 4 ? 256 : seg == 5 ? 16 * 48 : seg == 6 ? 256 : 16 * 256; }
template <int NSEG>
__device__ __forceinline__ TItem titem_decode(const Args& a, bf16* WB, const int (&segs)[NSEG], int it) {
    int seg = segs[0], before = 0, accn = 0; bool found = false;
#pragma unroll
    for (int i = 0; i < NSEG; ++i) { const int n = seg_items(segs[i]); if (!found && it < accn + n) { seg = segs[i]; before = accn; found = true; } accn += n; }
    const int li = it - before;
    TItem t; t.rp = false; t.f8 = false; t.item = li;
    if (seg < 2) { t.W = a.in[I_RWIN] + (size_t)seg * 1024 * 6144; t.K = 1024; t.N = 6144; t.WT = WB + WE_RIN + (size_t)seg * 6144 * 1024; t.rp = true; t.f8 = FP8_INPROJ != 0; }
    else if (seg < 4) { const int j = seg - 2; t.W = a.in[I_RWOUT] + (size_t)j * 2048 * 1024; t.K = 2048; t.N = 1024; t.WT = WB + WE_ROUT + (size_t)j * 1024 * 2048; t.f8 = FP8_OUTPROJ != 0; }
    else if (seg == 4) { t.W = a.in[I_FNW]; t.K = 1024; t.N = 1024; t.WT = WB + WE_FN; t.f8 = FP8_OUT2 != 0; }
    else if (seg == 5) { t.W = a.in[I_NAQKV]; t.K = 1024; t.N = 3072; t.WT = WB + WE_NQKV; t.f8 = FP8_INPROJ != 0; }
    else if (seg == 6) { t.W = a.in[I_NAOUT]; t.K = 1024; t.N = 1024; t.WT = WB + WE_NOUT; t.f8 = FP8_OUT2 != 0; }
    else { const int l = (seg - 7) / 3, which = (seg - 7) % 3, mi = l * 16 + (li >> 8); t.item = li & 255; t.K = 1024; t.N = 1024;
        t.W = a.in[which == 0 ? I_MG : which == 1 ? I_MU : I_MD] + (size_t)mi * 1048576; t.f8 = true;
        t.WT = (bf16*)((unsigned char*)(WB + (which == 0 ? WE_MG : which == 1 ? WE_MU : WE_MD)) + (size_t)mi * 1048576); }
    return t;
}
constexpr int BG_NSEG = 19;
constexpr int BG_NEED_RIN0 = 1536, BG_NEED_ROUT0 = BG_NEED_RIN0 + 512, BG_NEED_MOE0 = BG_NEED_ROUT0 + 3 * 4096, BG_NEED_FN = BG_NEED_MOE0 + 256, BG_NEED_MOE1 = BG_NEED_FN + 3 * 4096,
              BG_NEED_NQKV = BG_NEED_MOE1 + 768, BG_NEED_NOUT = BG_NEED_NQKV + 256, BG_NEED_MOE2 = BG_NEED_NOUT + 3 * 4096, BG_NEED_RIN1 = BG_NEED_MOE2 + 1536, BG_NEED_ROUT1 = BG_NEED_RIN1 + 512,
              BG_TOTAL = BG_NEED_ROUT1 + 3 * 4096;
constexpr int CW_QHEAD = 4096, CW_PHDONE = 8192;
__device__ __forceinline__ TItem bg_decode(const Args& a, bf16* WB, int it) {
    const int segs[BG_NSEG] = {0, 2, 7, 8, 9, 4, 10, 11, 12, 5, 6, 13, 14, 15, 1, 3, 16, 17, 18};
    return titem_decode<BG_NSEG>(a, WB, segs, it);
}
__device__ __forceinline__ void bg_work(const Args& a, unsigned char* wso, LAS unsigned char* lds, volatile LAS unsigned* misc, int wave, int lane, int ph, bool busy, int need) {
    unsigned* ctl = (unsigned*)(wso + WS_CTL);
    bf16* WB = (bf16*)(wso + WS_W);
    LAS float* scr = (LAS float*)lds + wave * (64 * 65);
    for (;;) {
        __syncthreads();
        if (wave == 0 && lane == 0) {
            const unsigned h = __hip_atomic_load(ctl + CW_QHEAD, __ATOMIC_RELAXED, __HIP_MEMORY_SCOPE_AGENT);
            unsigned base = (unsigned)BG_TOTAL;
            bool go = h < (unsigned)BG_TOTAL;
            if (go && h >= (unsigned)need) { if (busy) go = false; else if (__hip_atomic_load(ctl + CW_PHDONE + 64 * ph, __ATOMIC_RELAXED, __HIP_MEMORY_SCOPE_AGENT) != 0u) go = false; }
            if (go) base = __hip_atomic_fetch_add(ctl + CW_QHEAD, 64u, __ATOMIC_RELAXED, __HIP_MEMORY_SCOPE_AGENT);
            misc[64] = base;
        }
        __syncthreads();
        const int base = (int)misc[64];
        if (base >= BG_TOTAL) break;
        f32x4 va[16], vb[16];
        TItem ta = bg_decode(a, WB, min(base + wave, BG_TOTAL - 1)), tb = ta;
        bool oka = base + wave < BG_TOTAL, okb = false;
        if (oka) titem_load(ta, va, lane);
#pragma unroll 1
        for (int i = 0; i < 8; i += 2) {
            const int ib = base + wave + 8 * (i + 1), ia2 = base + wave + 8 * (i + 2);
            okb = ib < BG_TOTAL; if (okb) { tb = bg_decode(a, WB, ib); titem_load(tb, vb, lane); }
            if (oka) titem_store(ta, va, scr, lane);
            oka = (i + 2 < 8) && ia2 < BG_TOTAL; if (oka) { ta = bg_decode(a, WB, ia2); titem_load(ta, va, lane); }
            if (okb) titem_store(tb, vb, scr, lane);
        }
    }
}
__device__ __forceinline__ void bg_signal(unsigned char* wso, int ph) {
    __hip_atomic_fetch_add((unsigned*)(wso + WS_CTL) + CW_PHDONE + 64 * ph, 1u, __ATOMIC_RELAXED, __HIP_MEMORY_SCOPE_AGENT);
}

__device__ __forceinline__ void p_prologue(Frame& F, const Args& a) {
    int tid = tid_of(F.wv); asm volatile("" : "+v"(tid)); const int lane = tid & 63, wave = __builtin_amdgcn_readfirstlane(tid >> 6); (void)lane; (void)wave;
    GAS unsigned char* wsg_ = (GAS unsigned char*)F.ws; asm volatile("" : "+s"(wsg_)); unsigned char* wso = (unsigned char*)wsg_;
    for (int rr_ = 0; rr_ < NREP(16); ++rr_) if ((int)blockIdx.x < NLAYER * 48) {
        LAS float* act = (LAS float*)F.lds;
        LAS float* red = act + 5 * 1024;
        for (int idx = tid; idx < 5 * 1024; idx += 512) { const int r = idx >> 10, k = idx & 1023; const float v = (r < 4) ? a.in[I_C][r * 1024 + k] : a.in[I_CCTX][k]; act[idx] = silu_f(v); }
        __syncthreads();
        {
            const int u = (int)blockIdx.x;
            const int layer = u / 48, n0 = (u % 48) * 128;
            const float* w = a.in[I_WMOD] + (size_t)layer * 1024 * 6144 + n0 + 2 * lane;
            f32x2 s0 = (f32x2){0.f, 0.f}, s1 = s0, s2 = s0, s3 = s0, s4 = s0;
            const int kb = wave * 128;
#pragma unroll 16
            for (int k = 0; k < 128; ++k) { const f32x2 wv = *(const f32x2*)(w + (size_t)(kb + k) * 6144);
                s0 += wv * act[kb + k]; s1 += wv * act[1024 + kb + k]; s2 += wv * act[2048 + kb + k]; s3 += wv * act[3072 + kb + k]; s4 += wv * act[4096 + kb + k]; }
            *(LAS f32x2*)(red + (wave * 5 + 0) * 128 + 2 * lane) = s0; *(LAS f32x2*)(red + (wave * 5 + 1) * 128 + 2 * lane) = s1; *(LAS f32x2*)(red + (wave * 5 + 2) * 128 + 2 * lane) = s2;
            *(LAS f32x2*)(red + (wave * 5 + 3) * 128 + 2 * lane) = s3; *(LAS f32x2*)(red + (wave * 5 + 4) * 128 + 2 * lane) = s4;
            __syncthreads();
            for (int o = tid; o < 5 * 128; o += 512) { const int r = o >> 7, l = o & 127; float sm = 0.f;
#pragma unroll
                for (int w8 = 0; w8 < 8; ++w8) sm += red[(w8 * 5 + r) * 128 + l];
                const int nn = n0 + l; sm += a.in[I_BMOD][layer * 6144 + nn];
                ((float*)(wso + WS_MOD))[((size_t)(layer * 5 + r) * NMOD + nn / 1024) * D + (nn & 1023)] = sm; }
            __syncthreads();
        }
    }
    __syncthreads();
    for (int rr_ = 0; rr_ < NREP(17); ++rr_) {
        bf16* AL = (bf16*)(wso + WS_AL);
        const int nchunk = 8 * 512 * 1024 / 8;
        for (int ch = F.vcu * 512 + tid; ch < nchunk; ch += F.G * 512) {
            const int r = ch >> 16, m = (ch >> 7) & 511, k0 = (ch & 127) * 8;
            const int mul = 8 * m + r;
            float v[8];
#pragma unroll
            for (int e = 0; e < 8; ++e) { const int l = 4 * (k0 >> 3) + (e & 3); const float x = (float)((mul * l) & 4095) * (1.f / 4096.f);
                v[e] = (e < 4) ? __builtin_amdgcn_cosf(x) * (1.f / 64.f) : -__builtin_amdgcn_sinf(x) * (1.f / 64.f); }
            if (FP8_F2) { int t0 = __builtin_amdgcn_cvt_pk_fp8_f32(v[0] * 256.f, v[1] * 256.f, 0, false); t0 = __builtin_amdgcn_cvt_pk_fp8_f32(v[2] * 256.f, v[3] * 256.f, t0, true);
                int t1 = __builtin_amdgcn_cvt_pk_fp8_f32(v[4] * 256.f, v[5] * 256.f, 0, false); t1 = __builtin_amdgcn_cvt_pk_fp8_f32(v[6] * 256.f, v[7] * 256.f, t1, true);
                *(u32x2*)((unsigned char*)AL + (size_t)r * 512 * 1024 + (size_t)m * 1024 + k0) = (u32x2){(unsigned)t0, (unsigned)t1}; }
            else {
            u32x4 o; o.x = pk2(v[0], v[1]); o.y = pk2(v[2], v[3]); o.z = pk2(v[4], v[5]); o.w = pk2(v[6], v[7]);
            *(u32x4*)(AL + (size_t)r * 512 * 1024 + (size_t)m * 1024 + k0) = o; }
        }
        if (F.vcu == 4 % F.G) {
            bf16* A1N = (bf16*)(wso + WS_A1N);
            for (int idx = tid; idx < 512 * 256; idx += 512) { const int row = idx >> 8, c = idx & 255, chh = row >> 8, sgn = (row >> 7) & 1, cp = chh * 128 + (row & 127); const float x = (float)((c * cp) & 255) * (1.f / 256.f);
                const float v = (sgn == 0) ? __builtin_amdgcn_cosf(x) : __builtin_amdgcn_sinf(x); A1N[idx] = (bf16)f2bf(v * (1.f / 16.f)); }
        }
        if (F.vcu == 2 % F.G) {
            bf16* A1 = (bf16*)(wso + WS_A1);
            for (int idx = tid; idx < 512 * 256; idx += 512) { const int row = idx >> 8, c = idx & 255, sgn = row >> 8, cp = row & 255; const float x = (float)((c * cp) & 255) * (1.f / 256.f);
                const float v = (sgn == 0) ? __builtin_amdgcn_cosf(x) : __builtin_amdgcn_sinf(x); A1[idx] = (bf16)f2bf(v * (1.f / 16.f)); }
        }
        if (F.vcu == 3 % F.G) {
            bf16* ALC = (bf16*)(wso + WS_ALC);
            for (int idx = tid; idx < 256 * 512; idx += 512) { const int lp = idx >> 9, k = idx & 511, kk = k & 255; const float x = (float)((lp * kk) & 255) * (1.f / 256.f);
                const float v = (k < 256) ? __builtin_amdgcn_cosf(x) : -__builtin_amdgcn_sinf(x); ALC[idx] = (bf16)f2bf(v * (1.f / 16.f)); }
        }
        if (F.vcu == 1 % F.G) {
            f32x2* rt = (f32x2*)(wso + WS_ROPE);
            for (int idx = tid; idx < 64 * 64; idx += 512) { const int pos = idx >> 6, f = idx & 63; const float inv = powf(10000.f, -(float)f / 64.f); const float ang = (float)pos * inv;
                rt[idx] = (f32x2){cosf(ang), sinf(ang)}; }
        }
        __syncthreads();
    }
    bg_work(a, wso, F.lds, F.MISC, wave, lane, 0, true, BG_NEED_RIN0);
}

struct Row16 { f32x4 v[4]; };
__device__ __forceinline__ Row16 ld_row_f32(const float* p, int lane) { Row16 r;
#pragma unroll
    for (int j = 0; j < 4; ++j) r.v[j] = *(const f32x4*)(p + 256 * j + 4 * lane);
    return r; }
__device__ __forceinline__ void st_row_f32(float* p, int lane, const Row16& r) {
#pragma unroll
    for (int j = 0; j < 4; ++j) *(f32x4*)(p + 256 * j + 4 * lane) = r.v[j]; }
__device__ __forceinline__ Row16 ld_row_bf16(const bf16* p, int lane) { Row16 r;
#pragma unroll
    for (int j = 0; j < 4; ++j) { const u32x2 u = *(const u32x2*)(p + 256 * j + 4 * lane); r.v[j] = (f32x4){bflo(u.x), bfhi(u.x), bflo(u.y), bfhi(u.y)}; }
    return r; }
__device__ __forceinline__ void st_row_bf16(bf16* p, int lane, const Row16& r) {
#pragma unroll
    for (int j = 0; j < 4; ++j) { u32x2 u; u.x = pk2(r.v[j][0], r.v[j][1]); u.y = pk2(r.v[j][2], r.v[j][3]); *(u32x2*)(p + 256 * j + 4 * lane) = u; } }
__device__ __forceinline__ float row_rstd(const Row16& r, int lane) { float s = 0.f;
#pragma unroll
    for (int j = 0; j < 4; ++j) s += (r.v[j][0] * r.v[j][0] + r.v[j][1] * r.v[j][1]) + (r.v[j][2] * r.v[j][2] + r.v[j][3] * r.v[j][3]);
    return rsqrtf(wave_sum(s, lane) * (1.f / D) + EPS); }

#define PRE_NPF 3
__device__ __forceinline__ void st_row_fp8(unsigned char* p, int lane, const Row16& r) {
#pragma unroll
    for (int j = 0; j < 4; ++j) { int t = __builtin_amdgcn_cvt_pk_fp8_f32(r.v[j][0], r.v[j][1], 0, false); t = __builtin_amdgcn_cvt_pk_fp8_f32(r.v[j][2], r.v[j][3], t, true); *(int*)(p + 256 * j + 4 * lane) = t; } }
template <int MODE>
__device__ __forceinline__ void p_pre(Frame& F, const Args& a, int layer) {
    int tid = tid_of(F.wv); asm volatile("" : "+v"(tid)); const int lane = tid & 63, wave = __builtin_amdgcn_readfirstlane(tid >> 6); (void)lane; (void)wave;
    GAS unsigned char* wsg_ = (GAS unsigned char*)F.ws; asm volatile("" : "+s"(wsg_)); unsigned char* wso = (unsigned char*)wsg_;
    int vcu_o = F.vcu; asm volatile("" : "+s"(vcu_o));
    const int gw = vcu_o * 8 + wave, NGW = F.G * 8;
    bf16* XALL = (bf16*)(wso + WS_XALL); bf16* ACT = (bf16*)(wso + WS_ACT);
    const bf16* YB = (const bf16*)(wso + WS_YB); const int* DEST = (const int*)(wso + WS_DEST); const float* ROUTE = (const float*)(wso + WS_ROUTE);
    const int nrows = (MODE == 2) ? NLAT : NTOK;
    const bool fold = (MODE == 1) && (layer == 1);
    const bool f8act = FP8_INPROJ && (MODE == 0 || (MODE == 1 && layer != 1));
    const int nitems = fold ? (NLAT / 4 + NCTX) : nrows;
    const int it0 = (int)((unsigned)(gw * nitems) / (unsigned)NGW), it1 = (int)((unsigned)((gw + 1) * nitems) / (unsigned)NGW);
    const int nseq = (it1 - it0) << (fold ? 2 : 0);
    auto row_of = [&](int p) -> int {
        if (!fold) return it0 + p;
        const int item = it0 + (p >> 2), q = p & 3;
        if (item < NLAT / 4) return (item >> 10) * 4096 + (item & 1023) + ((q & 1) * 2 + (q >> 1)) * 1024;
        return q ? -1 : NLAT + (item - NLAT / 4); };
    const Row16 nw = ld_row_f32((MODE < 2 ? a.in[I_NMIX] + layer * D : a.in[I_NFIN]), lane);
    int dd0 = 0, dd1 = 0, ww0 = 0, ww1 = 0;
    if (MODE > 0) { const int r = row_of(lane); if (lane < nseq && r >= 0) { const u32x2 dv = *(const u32x2*)(DEST + r * 2); const u32x2 wv = *(const u32x2*)(ROUTE + r * 8 + 4); dd0 = (int)dv.x; dd1 = (int)dv.y; ww0 = (int)wv.x; ww1 = (int)wv.y; } }
    struct Slot { f32x4 xf[MODE == 0 ? 4 : 1]; u32x2 x[MODE == 0 ? 1 : 4], y0[MODE == 0 ? 1 : 4], y1[MODE == 0 ? 1 : 4]; };
    auto issue = [&](Slot& S, int p) {
        int pc = p < nseq ? p : nseq - 1; int r = row_of(pc); if (r < 0) { pc &= ~3; r = row_of(pc); }
        if (MODE == 0) { const float* src = r < NLAT ? a.in[I_X] + (size_t)r * D : a.in[I_CTX] + (size_t)(r - NLAT) * D;
#pragma unroll
            for (int j = 0; j < 4; ++j) S.xf[j] = *(const f32x4*)(src + 256 * j + 4 * lane);
        } else {
            const int d0 = __builtin_amdgcn_readlane(dd0, pc), d1 = __builtin_amdgcn_readlane(dd1, pc);
            const bf16* px = XALL + (size_t)r * D; const bf16* p0 = YB + (size_t)d0 * D; const bf16* p1 = YB + (size_t)d1 * D;
#pragma unroll
            for (int j = 0; j < 4; ++j) S.x[j] = *(const u32x2*)(px + 256 * j + 4 * lane);
#pragma unroll
            for (int j = 0; j < 4; ++j) { if (FP8_YB) S.y0[j].x = *(const unsigned*)((const unsigned char*)YB + (size_t)d0 * D + 256 * j + 4 * lane); else S.y0[j] = *(const u32x2*)(p0 + 256 * j + 4 * lane); }
#pragma unroll
            for (int j = 0; j < 4; ++j) { if (FP8_YB) S.y1[j].x = *(const unsigned*)((const unsigned char*)YB + (size_t)d1 * D + 256 * j + 4 * lane); else S.y1[j] = *(const u32x2*)(p1 + 256 * j + 4 * lane); }
        } };
    int cur_bi = -1; Row16 gp, sh, sc, hA, hB;
    auto consume = [&](const Slot& S, int p) {
        const int row = row_of(p);
        if (row < 0) return;
        const int bi = bidx_of_row(row);
        if (bi != cur_bi) { cur_bi = bi;
            if (MODE > 0) gp = ld_row_f32(modv(wso, layer - 1, bi, 5), lane);
            if (MODE < 2) { sh = ld_row_f32(modv(wso, layer, bi, 0), lane); sc = ld_row_f32(modv(wso, layer, bi, 1), lane); } }
        Row16 x;
        if (MODE == 0) {
#pragma unroll
            for (int j = 0; j < 4; ++j) x.v[j] = S.xf[j];
        } else {
            const float ysc = FP8_YB ? pg8::FP8_WSCALE : 1.f;
            const float w0 = __builtin_bit_cast(float, __builtin_amdgcn_readlane(ww0, p)) * ysc, w1 = __builtin_bit_cast(float, __builtin_amdgcn_readlane(ww1, p)) * ysc;
#pragma unroll
            for (int j = 0; j < 4; ++j) {
                const f32x4 xv = {bflo(S.x[j].x), bfhi(S.x[j].x), bflo(S.x[j].y), bfhi(S.x[j].y)};
                f32x4 a0, a1;
                if (FP8_YB) { const f32x2 l0 = __builtin_amdgcn_cvt_pk_f32_fp8((int)S.y0[j].x, false), h0 = __builtin_amdgcn_cvt_pk_f32_fp8((int)S.y0[j].x, true), l1 = __builtin_amdgcn_cvt_pk_f32_fp8((int)S.y1[j].x, false), h1 = __builtin_amdgcn_cvt_pk_f32_fp8((int)S.y1[j].x, true);
                    a0 = (f32x4){l0.x, l0.y, h0.x, h0.y}; a1 = (f32x4){l1.x, l1.y, h1.x, h1.y}; }
                else { a0 = (f32x4){bflo(S.y0[j].x), bfhi(S.y0[j].x), bflo(S.y0[j].y), bfhi(S.y0[j].y)}; a1 = (f32x4){bflo(S.y1[j].x), bfhi(S.y1[j].x), bflo(S.y1[j].y), bfhi(S.y1[j].y)}; }
                x.v[j] = xv + gp.v[j] * (a0 * w0 + a1 * w1); }
        }
        Row16 h;
        const float rs = row_rstd(x, lane);
        if (MODE < 2) {
            st_row_bf16(XALL + (size_t)row * D, lane, x);
#pragma unroll
            for (int j = 0; j < 4; ++j) h.v[j] = (x.v[j] * rs) * nw.v[j] * (sc.v[j] + 1.f) + sh.v[j];
            if (fold && row < NLAT) {
                const int q = p & 3;
                bf16* ab = ACT + (size_t)((row & ~4095) + (row & 1023)) * D;
                if (q == 0) hA = h;
                else if (q == 1) { Row16 o2;
#pragma unroll
                    for (int j = 0; j < 4; ++j) { o2.v[j] = hA.v[j] - h.v[j]; hA.v[j] = hA.v[j] + h.v[j]; }
                    st_row_bf16(ab + (size_t)2048 * D, lane, o2); }
                else if (q == 2) hB = h;
                else { Row16 o0, o1, o3;
#pragma unroll
                    for (int j = 0; j < 4; ++j) { const f32x4 od = hB.v[j] + h.v[j]; o0.v[j] = hA.v[j] + od; o1.v[j] = hA.v[j] - od; o3.v[j] = h.v[j] - hB.v[j]; }
                    st_row_bf16(ab, lane, o0); st_row_bf16(ab + (size_t)1024 * D, lane, o1); st_row_bf16(ab + (size_t)3072 * D, lane, o3); }
            } else if (f8act) st_row_fp8((unsigned char*)ACT + (size_t)row * D, lane, h);
            else st_row_bf16(ACT + (size_t)row * D, lane, h);
        } else {
#pragma unroll
            for (int j = 0; j < 4; ++j) h.v[j] = (x.v[j] * rs) * nw.v[j];
            st_row_f32(a.out + (size_t)row * D, lane, h);
        } };
    Slot ring[PRE_NPF];
#pragma unroll
    for (int u = 0; u < PRE_NPF; ++u) issue(ring[u], u);
    for (int pb = 0; pb < nseq; pb += PRE_NPF) {
#pragma unroll
        for (int u = 0; u < PRE_NPF; ++u) { const int p = pb + u; if (p < nseq) consume(ring[u], p); issue(ring[u], p + PRE_NPF); }
    }
}

#define MID_RS 2064
__device__ __forceinline__ void p_mid(Frame& F, const Args& a, int layer, int nrows) {
    int tid = tid_of(F.wv); asm volatile("" : "+v"(tid)); const int lane = tid & 63, wave = __builtin_amdgcn_readfirstlane(tid >> 6); (void)lane; (void)wave;
    GAS unsigned char* wsg_ = (GAS unsigned char*)F.ws; asm volatile("" : "+s"(wsg_)); unsigned char* wso = (unsigned char*)wsg_;
    int vcu_o = F.vcu; asm volatile("" : "+s"(vcu_o));
    const int gw = vcu_o * 8 + wave, NGW = F.G * 8;
    const bf16* XALL = (const bf16*)(wso + WS_XALL); unsigned char* ACT8 = wso + WS_ACT;
    LAS unsigned char* wh = F.lds; LAS unsigned char* wl = F.lds + 16 * MID_RS;
    LAS int* cnt = (LAS int*)(F.lds + 66048);
    LAS float* stage = (LAS float*)(F.lds + 66560) + wave * 256;
    LAS float* ps = (LAS float*)(F.lds + 75776) + wave * 2048;
    const int ngroups = nrows >> 4;
    const int g0 = (int)((unsigned)(gw * ngroups) / (unsigned)NGW), g1 = (int)((unsigned)((gw + 1) * ngroups) / (unsigned)NGW);
    const int n = lane & 15, kg = lane >> 4;
    for (int c = tid; c < 4096; c += 512) { const f32x4 v = *(const f32x4*)(a.in[I_RTW] + 4 * c); const int k = c >> 2, e4 = (c & 3) * 4;
#pragma unroll
        for (int i = 0; i < 4; ++i) { const unsigned hb = f2bf(v[i]); const float rem = v[i] - __builtin_bit_cast(float, hb << 16);
            *(LAS unsigned short*)(wh + (e4 + i) * MID_RS + 2 * k) = (unsigned short)hb; *(LAS unsigned short*)(wl + (e4 + i) * MID_RS + 2 * k) = (unsigned short)f2bf(rem); } }
    if (tid < 16) cnt[tid] = 0;
    __syncthreads();
    float rbias[16];
#pragma unroll
    for (int e = 0; e < 16; ++e) rbias[e] = a.in[I_RTB][e];
    int cur_bi = -1;
    for (int g = g0; g < g1; ++g) {
        const int row = 16 * g + n;
        u32x4 ring[8];
        const bf16* px = XALL + (size_t)row * D + 8 * kg;
#pragma unroll
        for (int c = 0; c < 8; ++c) ring[c] = *(const u32x4*)(px + 32 * c);
        const int bi = bidx_of_row(16 * g);
        if (bi != cur_bi) { cur_bi = bi;
            const float* nwp = a.in[I_NFFN] + layer * D; const float* shp = modv(wso, layer, bi, 3); const float* scp = modv(wso, layer, bi, 4);
#pragma unroll
            for (int i = 0; i < 4; ++i) { const int o = 4 * (lane + 64 * i); const f32x4 nwv = *(const f32x4*)(nwp + o), scv = *(const f32x4*)(scp + o), shv = *(const f32x4*)(shp + o);
                *(LAS f32x4*)(ps + o) = nwv * (scv + 1.f); *(LAS f32x4*)(ps + 1024 + o) = shv; } }
        float ss = 0.f;
#pragma unroll
        for (int c = 0; c < 32; ++c) { const u32x4 xv = ring[c & 7];
            ring[c & 7] = *(const u32x4*)(px + 32 * ((c + 8) & 31));
#pragma unroll
            for (int i = 0; i < 4; ++i) { const float v0 = bflo(xv[i]), v1 = bfhi(xv[i]); ss += v0 * v0 + v1 * v1; } }
        ss += shx(ss, 16, lane); ss += shx(ss, 32, lane);
        const float rs = rsqrtf(ss * (1.f / D) + EPS);
        f32x4 acc = (f32x4){0.f, 0.f, 0.f, 0.f};
        unsigned char* arow = ACT8 + (size_t)row * D + 8 * kg;
        const LAS unsigned char* whp = wh + n * MID_RS + 16 * kg; const LAS unsigned char* wlp = wl + n * MID_RS + 16 * kg;
        const LAS float* psp = ps + 8 * kg;
#pragma unroll
        for (int c = 0; c < 32; ++c) {
            const f32x4 P0 = *(const LAS f32x4*)(psp + 32 * c), P1 = *(const LAS f32x4*)(psp + 32 * c + 4), S0 = *(const LAS f32x4*)(psp + 1024 + 32 * c), S1 = *(const LAS f32x4*)(psp + 1024 + 32 * c + 4);
            const u32x4 xv = ring[c & 7];
            if (c + 8 < 32) ring[c & 7] = *(const u32x4*)(px + 32 * (c + 8));
            const f32x4 x0 = {bflo(xv[0]), bfhi(xv[0]), bflo(xv[1]), bfhi(xv[1])}, x1 = {bflo(xv[2]), bfhi(xv[2]), bflo(xv[3]), bfhi(xv[3])};
            const f32x4 f0 = (x0 * rs) * P0 + S0, f1 = (x1 * rs) * P1 + S1;
            { int t0 = __builtin_amdgcn_cvt_pk_fp8_f32(f0[0], f0[1], 0, false); t0 = __builtin_amdgcn_cvt_pk_fp8_f32(f0[2], f0[3], t0, true);
              int t1 = __builtin_amdgcn_cvt_pk_fp8_f32(f1[0], f1[1], 0, false); t1 = __builtin_amdgcn_cvt_pk_fp8_f32(f1[2], f1[3], t1, true);
              *(u32x2*)(arow + 32 * c) = (u32x2){(unsigned)t0, (unsigned)t1}; }
            u32x4 hb, lb;
            hb[0] = pk2(f0[0], f0[1]); hb[1] = pk2(f0[2], f0[3]); hb[2] = pk2(f1[0], f1[1]); hb[3] = pk2(f1[2], f1[3]);
            lb[0] = pk2(f0[0] - bflo(hb[0]), f0[1] - bfhi(hb[0])); lb[1] = pk2(f0[2] - bflo(hb[1]), f0[3] - bfhi(hb[1]));
            lb[2] = pk2(f1[0] - bflo(hb[2]), f1[1] - bfhi(hb[2])); lb[3] = pk2(f1[2] - bflo(hb[3]), f1[3] - bfhi(hb[3]));
            const bf16x8 bh = __builtin_bit_cast(bf16x8, hb), bl = __builtin_bit_cast(bf16x8, lb);
            const bf16x8 ah = *(const LAS bf16x8*)(whp + 64 * c), al = *(const LAS bf16x8*)(wlp + 64 * c);
            acc = __builtin_amdgcn_mfma_f32_16x16x32_bf16(ah, bh, acc, 0, 0, 0); acc = __builtin_amdgcn_mfma_f32_16x16x32_bf16(ah, bl, acc, 0, 0, 0); acc = __builtin_amdgcn_mfma_f32_16x16x32_bf16(al, bh, acc, 0, 0, 0);
            __builtin_amdgcn_sched_barrier(0);
        }
        *(LAS f32x4*)(stage + n * 16 + 4 * kg) = acc;
        {
            const bool act = lane < 16;
            const int rl = lane & 15;
            float sel[16], sco[16];
#pragma unroll
            for (int e4 = 0; e4 < 4; ++e4) { const f32x4 v = *(const LAS f32x4*)(stage + rl * 16 + 4 * e4);
#pragma unroll
                for (int i = 0; i < 4; ++i) { const int e = 4 * e4 + i; sco[e] = __builtin_amdgcn_rcpf(1.f + __expf(-v[i])); sel[e] = sco[e] + rbias[e]; } }
            int gbest = 0; float gbs = -1e30f;
#pragma unroll
            for (int gq = 0; gq < 4; ++gq) { float m1 = -1e30f, m2 = -1e30f;
#pragma unroll
                for (int l = 0; l < 4; ++l) { const float v = sel[4 * gq + l]; if (v > m1) { m2 = m1; m1 = v; } else if (v > m2) m2 = v; }
                const float gs = m1 + m2; if (gs > gbs) { gbs = gs; gbest = gq; } }
            float gsel[4], gsco[4];
#pragma unroll
            for (int l = 0; l < 4; ++l) { gsel[l] = sel[0 * 4 + l]; gsco[l] = sco[0 * 4 + l]; }
#pragma unroll
            for (int gq = 1; gq < 4; ++gq) if (gbest == gq) {
#pragma unroll
                for (int l = 0; l < 4; ++l) { gsel[l] = sel[gq * 4 + l]; gsco[l] = sco[gq * 4 + l]; } }
            int l0 = 0; float b0 = gsel[0];
#pragma unroll
            for (int l = 1; l < 4; ++l) if (gsel[l] > b0) { b0 = gsel[l]; l0 = l; }
            int l1 = -1; float b1 = -1e30f;
#pragma unroll
            for (int l = 0; l < 4; ++l) if (l != l0 && gsel[l] > b1) { b1 = gsel[l]; l1 = l; }
            float s0 = gsco[0], s1 = gsco[0];
#pragma unroll
            for (int l = 1; l < 4; ++l) { if (l0 == l) s0 = gsco[l]; if (l1 == l) s1 = gsco[l]; }
            const int e0 = gbest * 4 + l0, e1 = gbest * 4 + l1;
            const float inv = 1.f / (s0 + s1);
            if (act) {
                const int r0 = atomicAdd((int*)&cnt[e0], 1), r1 = atomicAdd((int*)&cnt[e1], 1);
                int* R = (int*)(wso + WS_ROUTE) + (size_t)(16 * g + lane) * 8;
                *(u32x4*)R = (u32x4){(unsigned)e0, (unsigned)e1, (unsigned)r0, (unsigned)r1}; *(f32x2*)(R + 4) = (f32x2){s0 * inv, s1 * inv};
            }
        }
    }
    __syncthreads();
    if (tid < 16) ((int*)(wso + WS_BLKCNT))[blockIdx.x * 16 + tid] = cnt[tid];
    __syncthreads();
}

__device__ __forceinline__ void p_perm(Frame& F, int nrows) {
    int tid = tid_of(F.wv); asm volatile("" : "+v"(tid)); const int lane = tid & 63, wave = __builtin_amdgcn_readfirstlane(tid >> 6); (void)lane; (void)wave;
    GAS unsigned char* wsg_ = (GAS unsigned char*)F.ws; asm volatile("" : "+s"(wsg_)); unsigned char* wso = (unsigned char*)wsg_;
    int vcu_o = F.vcu; asm volatile("" : "+s"(vcu_o));
    const int gw = vcu_o * 8 + wave, NGW = F.G * 8;
    LAS int* tab = (LAS int*)F.lds;
    LAS int* base = tab + 256 * 16;
    LAS int* part = base + 64;
    const int* BC = (const int*)(wso + WS_BLKCNT);
    const unsigned char* ACT = (const unsigned char*)(wso + WS_ACT); unsigned char* XP = (unsigned char*)(wso + WS_XP); int* DEST = (int*)(wso + WS_DEST);
    const int ngroups = nrows >> 4;
    const int r0w = 16 * (int)((unsigned)(gw * ngroups) / (unsigned)NGW), r1w = 16 * (int)((unsigned)((gw + 1) * ngroups) / (unsigned)NGW);
    const int nmine = r1w - r0w;
    constexpr int PERM_MAXR = 16;
    u32x4 rt = {0u, 0u, 0u, 0u};
    if (lane < nmine) rt = *(const u32x4*)((const int*)(wso + WS_ROUTE) + (size_t)(r0w + lane) * 8);
    u32x4 rowv[PERM_MAXR];
#pragma unroll
    for (int i = 0; i < PERM_MAXR; ++i) { const int row = min(r0w + i, r1w - 1); rowv[i] = *(const u32x4*)(ACT + (size_t)row * D + 16 * lane); }
    for (int idx = tid; idx < F.G * 16; idx += 512) tab[idx] = BC[idx];
    __syncthreads();
    {
        const int e = tid & 15, pt = tid >> 4; const int per = (F.G + 31) >> 5; const int b0 = pt * per, b1 = min(b0 + per, F.G);
        int t = 0, m = 0;
        for (int b = b0; b < b1; ++b) { const int v = tab[b * 16 + e]; m += (b < (int)blockIdx.x) ? v : 0; t += v; }
        part[(pt * 16 + e) * 2] = t; part[(pt * 16 + e) * 2 + 1] = m;
    }
    __syncthreads();
    if (tid < 16) {
        int t = 0, m = 0;
#pragma unroll 4
        for (int pt = 0; pt < 32; ++pt) { t += part[(pt * 16 + tid) * 2]; m += part[(pt * 16 + tid) * 2 + 1]; }
        const int padded = (t + 255) & ~255;
        int incl = padded;
#pragma unroll
        for (int o = 1; o < 16; o <<= 1) { const int up = __builtin_amdgcn_ds_bpermute(((lane - o) & 63) << 2, incl); if (tid >= o) incl += up; }
        const int ps = incl - padded;
        base[tid] = ps + m;
        if (blockIdx.x == 0) { ((int*)(wso + WS_MOETAB))[tid] = ps >> 8; if (tid == 15) ((int*)(wso + WS_MOETAB))[16] = incl >> 8; }
    }
    __syncthreads();
    const int e0 = (int)rt.x, e1 = (int)rt.y;
    const int d0 = base[e0 & 15] + (int)rt.z, d1 = base[e1 & 15] + (int)rt.w;
    if (lane < nmine) *(u32x2*)(DEST + (size_t)(r0w + lane) * 2) = (u32x2){(unsigned)d0, (unsigned)d1};
#pragma unroll
    for (int i = 0; i < PERM_MAXR; ++i) if (i < nmine) {
        const int q0 = __builtin_amdgcn_readlane(d0, i), q1 = __builtin_amdgcn_readlane(d1, i);
        *(u32x4*)(XP + (size_t)q0 * D + 16 * lane) = rowv[i]; *(u32x4*)(XP + (size_t)q1 * D + 16 * lane) = rowv[i];
    }
}

using pg8::Unit;
__device__ __forceinline__ unsigned cvt_pk_bf16(float lo, float hi) { unsigned r; asm volatile("v_cvt_pk_bf16_f32 %0, %1, %2" : "=v"(r) : "v"(lo), "v"(hi)); return r; }
__device__ __forceinline__ u32x4 pack8(const f32x4& v0, const f32x4& v1) { u32x4 o; o.x = cvt_pk_bf16(v0[0], v0[1]); o.y = cvt_pk_bf16(v0[2], v0[3]); o.z = cvt_pk_bf16(v1[0], v1[1]); o.w = cvt_pk_bf16(v1[2], v1[3]); return o; }

struct EpiResid {
    static constexpr bool PERM = false;
    bf16* X; const unsigned char* ws; int layer, which; float scale = 1.f;
    __device__ __forceinline__ void operator()(const f32x4 (&acc)[2][2][4][2], const Unit& u, int wr, int wc, int fr, int fq) const {
        const int row0 = u.pm * 256 + wr * 64 + fr, col0 = u.pn * 256 + wc * 32 + 4 * fq;
        const float* g = modv(ws, layer, bidx_of_row(u.pm * 256), which);
        f32x4 gv[2][2];
#pragma unroll
        for (int bj = 0; bj < 2; ++bj)
#pragma unroll
            for (int n = 0; n < 2; ++n) gv[bj][n] = *(const f32x4*)(g + col0 + bj * 128 + n * 16) * scale;
#pragma unroll
        for (int ai = 0; ai < 2; ++ai)
#pragma unroll
            for (int m = 0; m < 4; ++m) { bf16* rowp = X + (size_t)(row0 + ai * 128 + m * 16) * D + col0;
                u32x2 xv[2][2];
#pragma unroll
                for (int bj = 0; bj < 2; ++bj)
#pragma unroll
                    for (int n = 0; n < 2; ++n) xv[bj][n] = *(const u32x2*)(rowp + bj * 128 + n * 16);
#pragma unroll
                for (int bj = 0; bj < 2; ++bj)
#pragma unroll
                    for (int n = 0; n < 2; ++n) { const f32x4 y = gv[bj][n] * acc[ai][bj][m][n]; const u32x2 x = xv[bj][n]; u32x2 o;
                        o.x = cvt_pk_bf16(bflo(x.x) + y[0], bfhi(x.x) + y[1]); o.y = cvt_pk_bf16(bflo(x.y) + y[2], bfhi(x.y) + y[3]); *(u32x2*)(rowp + bj * 128 + n * 16) = o; } }
    }
};
struct EpiBf16 {
    static constexpr bool PERM = true;
    bf16* O; int ldc; float scale;
    __device__ __forceinline__ void operator()(const f32x4 (&acc)[2][2][4][2], const Unit& u, int wr, int wc, int fr, int fq) const {
        const int row0 = u.aux + u.pm * 256 + wr * 64 + fr, col0 = u.pn * 256 + wc * 32 + 8 * fq;
#pragma unroll
        for (int ai = 0; ai < 2; ++ai)
#pragma unroll
            for (int m = 0; m < 4; ++m) { bf16* rowp = O + (size_t)(row0 + ai * 128 + m * 16) * ldc + col0;
#pragma unroll
                for (int bj = 0; bj < 2; ++bj) *(u32x4*)(rowp + bj * 128) = pack8(acc[ai][bj][m][0] * scale, acc[ai][bj][m][1] * scale); }
    }
};
struct EpiQKV {
    static constexpr bool PERM = true;
    bf16* Q; bf16* K; bf16* V; float qscale, kvscale;
    __device__ __forceinline__ void operator()(const f32x4 (&acc)[2][2][4][2], const Unit& u, int wr, int wc, int fr, int fq) const {
        const int which = u.pn >> 2; bf16* base = Q + (size_t)which * ((WS_NK - WS_NQ) / 2); const float sc = which == 0 ? qscale : kvscale;
        const int row0 = u.pm * 256 + wr * 64 + fr, col0 = (u.pn & 3) * 256 + wc * 32 + 8 * fq;
#pragma unroll
        for (int ai = 0; ai < 2; ++ai)
#pragma unroll
            for (int m = 0; m < 4; ++m) { bf16* rowp = base + (size_t)(row0 + ai * 128 + m * 16) * D + col0;
#pragma unroll
                for (int bj = 0; bj < 2; ++bj) *(u32x4*)(rowp + bj * 128) = pack8(acc[ai][bj][m][0] * sc, acc[ai][bj][m][1] * sc); }
    }
};
struct EpiRetIn {
    static constexpr bool PERM = true;
    bf16* Q; bf16* K; bf16* V; bf16* Gt; const LAS unsigned* rope;
    __device__ __forceinline__ void operator()(const f32x4 (&acc)[2][2][4][2], const Unit& u, int wr, int wc, int fr, int fq) const {
        const int row0 = u.pm * 256 + wr * 64 + fr;
        if (u.pn < 8) {
            const int head = u.pn & 3; const bool isK = u.pn >= 4; bf16* base = isK ? K : Q; const float sc = (isK ? 0.0625f : 1.f) * (FP8_INPROJ ? pg8::FP8_WSCALE : 1.f);
            const int jt = wc * 32 + 8 * fq;
            const int nat_a = jt < 64 ? jt : 64 + jt;
            const int f0 = jt & 63;
#pragma unroll
            for (int ai = 0; ai < 2; ++ai)
#pragma unroll
                for (int m = 0; m < 4; ++m) {
                    const int row = row0 + ai * 128 + m * 16;
                    f32x4 a0 = acc[ai][0][m][0], a1 = acc[ai][0][m][1], b0 = acc[ai][1][m][0], b1 = acc[ai][1][m][1];
                    if (u.pm * 256 < NLAT) {
                        const int t = row & 4095; const int pos = jt < 64 ? (t >> 6) : (t & 63);
                        const LAS unsigned* cs = rope + pos * 64 + f0;
#pragma unroll
                        for (int e = 0; e < 4; ++e) { typedef _Float16 h2 __attribute__((ext_vector_type(2))); const h2 p0 = __builtin_bit_cast(h2, cs[e]), p1 = __builtin_bit_cast(h2, cs[4 + e]);
                            const f32x2 c0 = (f32x2){(float)p0[0], (float)p0[1]}, c1 = (f32x2){(float)p1[0], (float)p1[1]};
                            const float x0 = a0[e], y0 = b0[e], x1 = a1[e], y1 = b1[e];
                            a0[e] = x0 * c0.x - y0 * c0.y; b0[e] = x0 * c0.y + y0 * c0.x; a1[e] = x1 * c1.x - y1 * c1.y; b1[e] = x1 * c1.y + y1 * c1.x; }
                    }
                    bf16* rowp = base + (size_t)row * D + head * 256 + nat_a;
                    *(u32x4*)(rowp) = pack8(a0 * sc, a1 * sc); *(u32x4*)(rowp + 64) = pack8(b0 * sc, b1 * sc);
                }
        } else {
            bf16* base = u.pn < 16 ? V : Gt; const int col0 = ((u.pn - 8) & 7) * 256 + wc * 32 + 8 * fq;
#pragma unroll
            for (int ai = 0; ai < 2; ++ai)
#pragma unroll
                for (int m = 0; m < 4; ++m) { bf16* rowp = base + (size_t)(row0 + ai * 128 + m * 16) * 2048 + col0;
#pragma unroll
                    for (int bj = 0; bj < 2; ++bj) { const float ws_ = FP8_INPROJ ? pg8::FP8_WSCALE : 1.f; const f32x4 v0 = acc[ai][bj][m][0] * ws_, v1 = acc[ai][bj][m][1] * ws_;
                        if (FP8_RETSTORE && u.pn >= 16) {
                            int t0 = __builtin_amdgcn_cvt_pk_fp8_f32(v0[0], v0[1], 0, false); t0 = __builtin_amdgcn_cvt_pk_fp8_f32(v0[2], v0[3], t0, true);
                            int t1 = __builtin_amdgcn_cvt_pk_fp8_f32(v1[0], v1[1], 0, false); t1 = __builtin_amdgcn_cvt_pk_fp8_f32(v1[2], v1[3], t1, true);
                            *(u32x2*)((unsigned char*)Gt + (size_t)(row0 + ai * 128 + m * 16) * 2048 + col0 + bj * 128) = (u32x2){(unsigned)t0, (unsigned)t1};
                        } else *(u32x4*)(rowp + bj * 128) = pack8(v0, v1); } }
        }
    }
};
struct EpiF1 {
    static constexpr bool PERM = true;
    bf16* G2; bf16* G2c;
    __device__ __forceinline__ void operator()(const f32x4 (&acc)[2][2][4][2], const Unit& u, int wr, int wc, int fr, int fq) const {
        const int g = u.aux, s = u.pm; const int tok0 = u.pn * 256;
        char* base; unsigned ldrB; int lcol;
        if (tok0 < NLAT) { const int b = tok0 >> 12, par = (tok0 >> 11) & 1; base = (char*)(G2 + (size_t)(b * 1024 + g * 256) * 8192 + par * 4096 + s * 2048); ldrB = 16384u; lcol = tok0 & 2047; }
        else { const int b = (tok0 - NLAT) >> 8; base = (char*)(G2c + (size_t)(b * 1024 + g * 256) * 512 + s * 256); ldrB = 1024u; lcol = 0; }
        const unsigned off0 = (unsigned)(wr * 64 + fr) * ldrB + (unsigned)(lcol + wc * 32 + 8 * fq) * 2u;
#pragma unroll
        for (int ai = 0; ai < 2; ++ai)
#pragma unroll
            for (int m = 0; m < 4; ++m) { const unsigned off = off0 + (unsigned)(ai * 128 + m * 16) * ldrB;
#pragma unroll
                for (int bj = 0; bj < 2; ++bj) *(u32x4*)(base + off + bj * 256) = pack8(acc[ai][bj][m][0], acc[ai][bj][m][1]); }
    }
};
struct EpiF1n {
    static constexpr bool PERM = false;
    __host__ __device__ static constexpr int brow(int R) { return ((R >> 4) & 1) * 512 + (R >> 5) * 16 + (R & 15); }
    bf16* G2;
    static constexpr int EB = FP8_F2 ? 1 : 2;
    __device__ __forceinline__ static void st8(char* p, const f32x4& uq, const f32x4& vq) {
        if (FP8_F2) { int t0 = __builtin_amdgcn_cvt_pk_fp8_f32(uq[0], uq[1], 0, false); t0 = __builtin_amdgcn_cvt_pk_fp8_f32(uq[2], uq[3], t0, true);
            int t1 = __builtin_amdgcn_cvt_pk_fp8_f32(vq[0], vq[1], 0, false); t1 = __builtin_amdgcn_cvt_pk_fp8_f32(vq[2], vq[3], t1, true); *(u32x2*)p = (u32x2){(unsigned)t0, (unsigned)t1}; }
        else { u32x4 o; o.x = cvt_pk_bf16(uq[0], uq[1]); o.y = cvt_pk_bf16(uq[2], uq[3]); o.z = cvt_pk_bf16(vq[0], vq[1]); o.w = cvt_pk_bf16(vq[2], vq[3]); *(u32x4*)p = o; } }
    __device__ __forceinline__ void operator()(const f32x4 (&acc)[2][2][4][2], const Unit& u, int wr, int wc, int fr, int fq) const {
        const int g = u.aux >> 1, grp = u.aux & 1, b = u.pn >> 3, lt = u.pn & 7;
        char* base = (char*)G2 + ((size_t)(b * 1024 + g * 256 + u.pm * 128) * 8192 + lt * 128) * EB;
        const unsigned off0 = ((unsigned)(wr * 64 + fr) * 8192u + (unsigned)(wc * 32 + 8 * fq)) * (unsigned)EB;
        constexpr float cs = 0.70710678118654752f;
#define F1_ST(R_, U_, V_) st8(base + off + (R_) * 1024 * EB, (U_), (V_))
#pragma unroll
        for (int m = 0; m < 4; ++m) { const unsigned off = off0 + (unsigned)(m * 16) * 8192u * (unsigned)EB;
            const f32x4 C0 = acc[0][0][m][0], C1 = acc[0][0][m][1], C2 = acc[0][1][m][0], C3 = acc[0][1][m][1];
            const f32x4 S0 = acc[1][0][m][0], S1 = acc[1][0][m][1], S2 = acc[1][1][m][0], S3 = acc[1][1][m][1];
            if (grp == 0) {
                F1_ST(0, C0 + C1, S0 + S1); F1_ST(4, C0 - C1, S0 - S1);
                F1_ST(2, C2 - S3, S2 + C3); F1_ST(6, C2 + S3, S2 - C3);
            } else {
                const f32x4 tc = (C1 + C3) * cs, ts = (S1 + S3) * cs, dc = (C3 - C1) * cs, ds = (S3 - S1) * cs;
                const f32x4 Ec = C0 + tc, Es = S0 + ts, Fc = C2 + dc, Fs = S2 + ds, Gc = C0 - tc, Gs = S0 - ts, Hc = C2 - dc, Hs = S2 - ds;
                F1_ST(1, Ec + Fs, Es - Fc); F1_ST(7, Ec - Fs, Es + Fc);
                F1_ST(5, Gc + Hs, Gs - Hc); F1_ST(3, Gc - Hs, Gs + Hc);
            }
        }
#undef F1_ST
    }
};
struct EpiMoe1 {
    static constexpr bool PERM = false;
    unsigned char* H;
    __device__ __forceinline__ void operator()(const f32x4 (&acc)[2][2][4][2], const Unit& u, int wr, int wc, int fr, int fq) const {
        const int row0 = u.pm * 256 + wr * 64 + fr, col0 = u.pn * 128 + wc * 32 + 4 * fq;
#pragma unroll
        for (int ai = 0; ai < 2; ++ai)
#pragma unroll
            for (int m = 0; m < 4; ++m) {
#pragma unroll
                for (int n = 0; n < 2; ++n) { f32x4 h;
#pragma unroll
                    for (int e = 0; e < 4; ++e) h[e] = silu_f(acc[ai][0][m][n][e] * pg8::FP8_WSCALE) * (acc[ai][1][m][n][e] * pg8::FP8_WSCALE);
                    int t = __builtin_amdgcn_cvt_pk_fp8_f32(h[0], h[1], 0, false); t = __builtin_amdgcn_cvt_pk_fp8_f32(h[2], h[3], t, true);
                    *(int*)(H + (size_t)(row0 + ai * 128 + m * 16) * D + col0 + 16 * n) = t; } }
    }
};
struct EpiFp8N {
    static constexpr bool PERM = false;
    static constexpr bool LDS_STORE = true;
    static constexpr int RS = 272;
    unsigned char* O;
    __device__ __forceinline__ void lds_store(const f32x4 (&acc)[2][2][4][2], const Unit& u, int wr, int wc, int fr, int fq, LAS unsigned char* buf, int tid) const {
#pragma unroll
        for (int p = 0; p < 4; ++p) {
            if (wr == (p & 1)) {
#pragma unroll
                for (int m = 0; m < 4; ++m)
#pragma unroll
                    for (int bj = 0; bj < 2; ++bj)
#pragma unroll
                        for (int n = 0; n < 2; ++n) { const f32x4 v = acc[p >> 1][bj][m][n]; int t = __builtin_amdgcn_cvt_pk_fp8_f32(v[0], v[1], 0, false); t = __builtin_amdgcn_cvt_pk_fp8_f32(v[2], v[3], t, true);
                            *(LAS int*)(buf + (m * 16 + fr) * RS + bj * 128 + wc * 32 + n * 16 + 4 * fq) = t; }
            }
            asm volatile("s_waitcnt lgkmcnt(0)" ::: "memory"); __builtin_amdgcn_s_barrier(); asm volatile("" ::: "memory");
#pragma unroll
            for (int k = 0; k < 2; ++k) { const int row = (tid >> 4) + 32 * k, ch = tid & 15;
                const u32x4 v = *(const LAS u32x4*)(buf + row * RS + ch * 16);
                *(u32x4*)(O + (size_t)(u.pm * 256 + 64 * p + row) * D + u.pn * 256 + ch * 16) = v; }
            asm volatile("s_waitcnt lgkmcnt(0)" ::: "memory"); __builtin_amdgcn_s_barrier(); asm volatile("" ::: "memory");
        }
    }
    __device__ __forceinline__ void operator()(const f32x4 (&acc)[2][2][4][2], const Unit& u, int wr, int wc, int fr, int fq) const {
        const int row0 = u.pm * 256 + wr * 64 + fr, col0 = u.pn * 256 + wc * 32 + 4 * fq;
#pragma unroll
        for (int ai = 0; ai < 2; ++ai)
#pragma unroll
            for (int m = 0; m < 4; ++m) { unsigned char* rowp = O + (size_t)(row0 + ai * 128 + m * 16) * D + col0;
#pragma unroll
                for (int bj = 0; bj < 2; ++bj)
#pragma unroll
                    for (int n = 0; n < 2; ++n) { const f32x4 v = acc[ai][bj][m][n]; int t = __builtin_amdgcn_cvt_pk_fp8_f32(v[0], v[1], 0, false); t = __builtin_amdgcn_cvt_pk_fp8_f32(v[2], v[3], t, true); *(int*)(rowp + bj * 128 + n * 16) = t; } }
    }
};
struct EpiBf16N {
    static constexpr bool PERM = false;
    bf16* O; int ldc; float scale;
    __device__ __forceinline__ void operator()(const f32x4 (&acc)[2][2][4][2], const Unit& u, int wr, int wc, int fr, int fq) const {
        const int row0 = u.aux + u.pm * 256 + wr * 64 + fr, col0 = u.pn * 256 + wc * 32 + 4 * fq;
#pragma unroll
        for (int ai = 0; ai < 2; ++ai)
#pragma unroll
            for (int m = 0; m < 4; ++m) { bf16* rowp = O + (size_t)(row0 + ai * 128 + m * 16) * ldc + col0;
#pragma unroll
                for (int bj = 0; bj < 2; ++bj)
#pragma unroll
                    for (int n = 0; n < 2; ++n) { const f32x4 v = acc[ai][bj][m][n] * scale; u32x2 o; o.x = cvt_pk_bf16(v[0], v[1]); o.y = cvt_pk_bf16(v[2], v[3]); *(u32x2*)(rowp + bj * 128 + n * 16) = o; } }
    }
};

struct F1nSched {
    static constexpr bool HOOKS = false;
    const char* A1N; const char* ACT; int G, c;
    __device__ bool next(int i, Unit& u) const { const int L = i * G + c; if (L >= 512) return false;
        const int b = L >> 7, g = (L >> 5) & 3, chh = (L >> 4) & 1, lt = (L >> 1) & 7, grp = L & 1; u.pm = chh; u.pn = b * 8 + lt; u.aux = 2 * g + grp; u.nt = 4;
        u.A = A1N + (size_t)chh * 256 * 512; u.B0 = ACT + (size_t)(b * 4096 + grp * 2048 + lt * 64) * 2048 + g * 512; return true; }
};
struct F1Sched {
    static constexpr bool HOOKS = false;
    const char* A1; const char* ACT; int G, c;
    __device__ bool next(int i, Unit& u) const { const int L = i * G + c; if (L >= 4 * 2 * 4) return false;
        const int g = L >> 3, rem = L & 7; u.pm = rem & 1; u.pn = 64 + (rem >> 1); u.aux = g; u.nt = 4;
        u.A = A1 + (size_t)u.pm * 256 * 512; u.B0 = ACT + (size_t)u.pn * 256 * 2048 + g * 512; return true; }
};
struct F2Sched {
    static constexpr bool HOOKS = false;
    const char* AL; const char* G2; int G, c;
    __device__ bool next(int i, Unit& u) const { const int L = i * G + c; if (L >= 256) return false;
        constexpr int EB = FP8_F2 ? 1 : 2;
        const int b = L >> 6, rem = L & 63, r = rem >> 3; u.pm = (rem >> 2) & 1; u.pn = rem & 3; u.aux = b * 4096 + r; u.nt = FP8_F2 ? 8 : 16;
        u.A = AL + ((size_t)r * 512 * 1024 + (size_t)u.pm * 256 * 1024) * EB; u.B0 = G2 + (((size_t)b * 1024 + u.pn * 256) * 8192 + (size_t)r * 1024) * EB; return true; }
};
struct EpiF2 {
    static constexpr bool PERM = true;
    bf16* O;
    __device__ __forceinline__ void operator()(const f32x4 (&acc_)[2][2][4][2], const Unit& u, int wr, int wc, int fr, int fq) const {
        f32x4 acc[2][2][4][2];
#pragma unroll
        for (int i0 = 0; i0 < 2; ++i0)
#pragma unroll
            for (int i1 = 0; i1 < 2; ++i1)
#pragma unroll
                for (int i2 = 0; i2 < 4; ++i2)
#pragma unroll
                    for (int i3 = 0; i3 < 2; ++i3) acc[i0][i1][i2][i3] = acc_[i0][i1][i2][i3] * (FP8_F2 ? (1.f / 256.f) : 1.f);
        const int r = u.aux & 7, rb = u.aux & ~7; const int r0 = u.pm * 256 + wr * 64 + fr, col0 = u.pn * 256 + wc * 32 + 8 * fq;
#pragma unroll
        for (int ai = 0; ai < 2; ++ai)
#pragma unroll
            for (int m = 0; m < 4; ++m) { bf16* rowp = O + (size_t)(rb + 8 * (r0 + ai * 128 + m * 16) + r) * D + col0;
#pragma unroll
                for (int bj = 0; bj < 2; ++bj) {
                    if (FP8_OUT2) { const f32x4 v0 = acc[ai][bj][m][0], v1 = acc[ai][bj][m][1];
                        int t0 = __builtin_amdgcn_cvt_pk_fp8_f32(v0[0], v0[1], 0, false); t0 = __builtin_amdgcn_cvt_pk_fp8_f32(v0[2], v0[3], t0, true);
                        int t1 = __builtin_amdgcn_cvt_pk_fp8_f32(v1[0], v1[1], 0, false); t1 = __builtin_amdgcn_cvt_pk_fp8_f32(v1[2], v1[3], t1, true);
                        *(u32x2*)((unsigned char*)O + (size_t)(rb + 8 * (r0 + ai * 128 + m * 16) + r) * D + col0 + bj * 128) = (u32x2){(unsigned)t0, (unsigned)t1}; }
                    else *(u32x4*)(rowp + bj * 128) = pack8(acc[ai][bj][m][0], acc[ai][bj][m][1]); } }
    }
};
struct F2cSched {
    const char* ALC; const char* G2C; int G, c;
    __device__ bool next(int i, Unit& u) const { const int L = i * G + c; if (L >= 16) return false;
        const int b = L >> 2; u.pm = 0; u.pn = L & 3; u.aux = NLAT + b * 256; u.nt = 8;
        u.A = ALC; u.B0 = G2C + ((size_t)b * 1024 + u.pn * 256) * 1024; return true; }
};
struct MoeSched {
    const volatile LAS int* tstart; const char* A; const char* W0; int nct, cstep, G, c;
    __device__ bool next(int i, Unit& u) const { const int L = i * G + c; const int sh = (nct == 8) ? 3 : 2; const int rt = L >> sh, ct = L & (nct - 1); if (rt >= tstart[16]) return false;
        int e = tstart[40 + rt];
        e = __builtin_amdgcn_readfirstlane(e);
        u.pm = rt; u.pn = ct; u.aux = 0; u.nt = 8; u.A = A + (size_t)rt * 256 * 1024;
        u.B0 = W0 + (size_t)e * 1048576 + (size_t)ct * cstep; return true; }
};

__device__ __forceinline__ f32x4 mfma16(const bf16x8& a, const bf16x8& b, const f32x4& c) { return __builtin_amdgcn_mfma_f32_16x16x32_bf16(a, b, c, 0, 0, 0); }
__device__ __forceinline__ s16x4 lds_tr(const LAS unsigned char* p) { return __builtin_amdgcn_ds_read_tr16_b64_v4i16((s16x4 LAS*)p); }
__device__ __forceinline__ bf16x8 cat8(const s16x4& a, const s16x4& b) { return (bf16x8){a[0], a[1], a[2], a[3], b[0], b[1], b[2], b[3]}; }
__device__ __forceinline__ bf16x8 pack_acc8(const f32x4& a, const f32x4& b) { const u32x4 u = pack8(a, b); return __builtin_bit_cast(bf16x8, u); }
__device__ __forceinline__ float logsig(float x) { const float e = __expf(-x);
    return -e * (1.f + e * (-0.5f + e * (0.333333343f + e * (-0.25f + e * (0.2f + e * (-0.166666672f + e * (0.142857149f + e * -0.125f))))))); }

constexpr int SG_RS = 144;
template <bool BF8>
__device__ __forceinline__ void small_gemm_ctx(Frame& F, const bf16* A, int lda, const bf16* Bt, int ldb, int K, bf16* X, const float* gate) {
    int tid = tid_of(F.wv); asm volatile("" : "+v"(tid)); const int lane = tid & 63, wave = __builtin_amdgcn_readfirstlane(tid >> 6);
    LAS unsigned char* lds = F.lds;
    for (int t = F.vcu; t < 256; t += F.G) {
        const int tm = t >> 4, tn = t & 15;
        const int pr = tid >> 3, pc = tid & 7;
        const bf16* ag = A + (size_t)(NLAT + 64 * tm + pr) * lda + pc * 8;
        const bf16* bg = Bt + (size_t)(64 * tn + pr) * ldb + pc * 8;
        const unsigned char* bg8 = (const unsigned char*)Bt + (size_t)(64 * tn + pr) * ldb + pc * 8;
        auto ldb_piece = [&](int kt) -> u32x4 {
            if constexpr (BF8) { const u32x2 w = *(const u32x2*)(bg8 + kt * 64); u32x4 o;
                const f32x2 a0 = __builtin_amdgcn_cvt_pk_f32_fp8((int)w.x, false), a1 = __builtin_amdgcn_cvt_pk_f32_fp8((int)w.x, true), a2 = __builtin_amdgcn_cvt_pk_f32_fp8((int)w.y, false), a3 = __builtin_amdgcn_cvt_pk_f32_fp8((int)w.y, true);
                o.x = cvt_pk_bf16(a0.x, a0.y); o.y = cvt_pk_bf16(a1.x, a1.y); o.z = cvt_pk_bf16(a2.x, a2.y); o.w = cvt_pk_bf16(a3.x, a3.y); return o; }
            else return *(const u32x4*)(bg + kt * 64); };
        const int wm = wave >> 1, wn = wave & 1, l15 = lane & 15, quad = lane >> 4;
        f32x4 acc[2] = {(f32x4){0.f, 0.f, 0.f, 0.f}, (f32x4){0.f, 0.f, 0.f, 0.f}};
        const int nk = K / 64;
        u32x4 ra[8], rb[8];
#pragma unroll
        for (int i = 0; i < 8; ++i) { ra[i] = *(const u32x4*)(ag + i * 64); rb[i] = ldb_piece(i); }
        __syncthreads();
        for (int kt0 = 0; kt0 < nk; kt0 += 8) {
#pragma unroll
            for (int i = 0; i < 8; ++i) {
                const int kt = kt0 + i;
                LAS unsigned char* sa = lds + (i & 1) * (2 * 64 * SG_RS); LAS unsigned char* sb = sa + 64 * SG_RS;
                *(LAS u32x4*)(sa + pr * SG_RS + pc * 16) = ra[i]; *(LAS u32x4*)(sb + pr * SG_RS + pc * 16) = rb[i];
                if (kt + 8 < nk) { ra[i] = *(const u32x4*)(ag + (kt + 8) * 64); rb[i] = ldb_piece(kt + 8); }
                __syncthreads();
#pragma unroll
                for (int ks = 0; ks < 2; ++ks) {
                    const bf16x8 af = *(const LAS bf16x8*)(sa + (16 * wm + l15) * SG_RS + (32 * ks + 8 * quad) * 2);
#pragma unroll
                    for (int n = 0; n < 2; ++n) { const bf16x8 bf = *(const LAS bf16x8*)(sb + (32 * wn + 16 * n + l15) * SG_RS + (32 * ks + 8 * quad) * 2);
                        acc[n] = mfma16(bf, af, acc[n]); }
                }
            }
        }
        bf16* xr = X + (size_t)(NLAT + 64 * tm + 16 * wm + l15) * D + 64 * tn + 32 * wn + 4 * quad;
        const float* gp = gate + 64 * tn + 32 * wn + 4 * quad;
#pragma unroll
        for (int n = 0; n < 2; ++n) { const f32x4 gv = *(const f32x4*)(gp + 16 * n) * (BF8 ? pg8::FP8_WSCALE : 1.f); const u32x2 xv = *(const u32x2*)(xr + 16 * n); const f32x4 y = gv * acc[n]; u32x2 o;
            o.x = cvt_pk_bf16(bflo(xv.x) + y[0], bfhi(xv.x) + y[1]); o.y = cvt_pk_bf16(bflo(xv.y) + y[2], bfhi(xv.y) + y[3]); *(u32x2*)(xr + 16 * n) = o; }
    }
    __syncthreads();
}

constexpr int SC_QS = 528, SC_KS = 576, SC_VS = 144, SC_QT = 0, SC_KT = 128 * 528, SC_VT = SC_KT + 128 * 576;
static_assert(SC_VT + 128 * SC_VS <= MISC_OFF, "scan LDS map");
__device__ __forceinline__ int scan_rowbase(int dir, int b, int n) {
    if (dir == 0) return (n < 2) ? NLAT + b * 256 + n * 128 : b * 4096 + (n - 2) * 128;
    return (n < 2) ? NLAT + b * 256 + (1 - n) * 128 : b * 4096 + (33 - n) * 128;
}
__device__ __forceinline__ void p_ret_scan(Frame& F, const Args& a, int j) {
    int tid = tid_of(F.wv); asm volatile("" : "+v"(tid)); const int lane = tid & 63, wave = __builtin_amdgcn_readfirstlane(tid >> 6);
    GAS unsigned char* wsg_ = (GAS unsigned char*)F.ws; asm volatile("" : "+s"(wsg_)); unsigned char* wso = (unsigned char*)wsg_;
    const bf16* Q = (const bf16*)(wso + WS_RQ); const bf16* K = (const bf16*)(wso + WS_RK); const bf16* V = (const bf16*)(wso + WS_RV);
    LAS unsigned char* lds = F.lds;
    for (int u = F.vcu; u < 256; u += F.G) {
        const int dir = u & 1, slice = (u >> 1) & 7, bh = u >> 4, b = bh >> 2, h = bh & 3;
        __syncthreads();
        if (wave >= 4) {
            const int lt = tid - 256;
            const int qr = lt >> 5, qc = lt & 31, vr = lt >> 3, vc = lt & 7; const bool kswz = (qr & 4) != 0;
            const bf16* Qg = Q + (size_t)qr * 1024 + h * 256 + qc * 8;
            const bf16* Kg = K + (size_t)qr * 1024 + h * 256 + qc * 8;
            const bf16* Vg = V + (size_t)vr * 2048 + h * 512 + slice * 64 + vc * 8;
            LAS unsigned char* qd = lds + SC_QT + qr * SC_QS + qc * 16;
            LAS unsigned char* kd = lds + SC_KT + qr * SC_KS + qc * 16;
            LAS unsigned char* vd = lds + SC_VT + vr * SC_VS + vc * 16;
            u32x4 rq[16], rk[16], rv[4];
            { const size_t rb = (size_t)scan_rowbase(dir, b, 0), rb1 = (size_t)scan_rowbase(dir, b, 1);
#pragma unroll
              for (int i = 0; i < 16; ++i) { rq[i] = *(const u32x4*)(Qg + (rb + 8 * i) * 1024); rk[i] = *(const u32x4*)(Kg + (rb + 8 * i) * 1024); }
#pragma unroll
              for (int i = 0; i < 4; ++i) rv[i] = *(const u32x4*)(Vg + (rb + 32 * i) * 2048);
#pragma unroll
              for (int i = 0; i < 16; ++i) *(LAS u32x4*)(qd + i * 8 * SC_QS) = rq[i];
#pragma unroll
              for (int i = 0; i < 16; ++i) rq[i] = *(const u32x4*)(Qg + (rb1 + 8 * i) * 1024); }
            __syncthreads();
            for (int n = 0; n < 34; ++n) {
#pragma unroll
                for (int i = 0; i < 16; ++i) *(LAS u32x4*)(kd + i * 8 * SC_KS) = kswz ? (u32x4){rk[i].z, rk[i].w, rk[i].x, rk[i].y} : rk[i];
#pragma unroll
                for (int i = 0; i < 4; ++i) *(LAS u32x4*)(vd + i * 32 * SC_VS) = rv[i];
                { const size_t rbn = (size_t)scan_rowbase(dir, b, n < 33 ? n + 1 : n);
#pragma unroll
                  for (int i = 0; i < 16; ++i) rk[i] = *(const u32x4*)(Kg + (rbn + 8 * i) * 1024);
#pragma unroll
                  for (int i = 0; i < 4; ++i) rv[i] = *(const u32x4*)(Vg + (rbn + 32 * i) * 2048); }
                __syncthreads();
#pragma unroll
                for (int i = 0; i < 16; ++i) *(LAS u32x4*)(qd + i * 8 * SC_QS) = rq[i];
                { const size_t rbn2 = (size_t)scan_rowbase(dir, b, n < 32 ? n + 2 : n);
#pragma unroll
                  for (int i = 0; i < 16; ++i) rq[i] = *(const u32x4*)(Qg + (rbn2 + 8 * i) * 1024); }
                __syncthreads();
            }
        } else {
            const int w = wave, l15 = lane & 15, quad = lane >> 4, tq = l15 >> 2, tp = l15 & 3;
            bf16* O = (bf16*)(wso + (dir ? WS_ROB : WS_ROF));
            const float lg = logsig(a.in[I_RDEC][(j * 2 + dir) * 4 + h]);
            const float lg2 = lg * 1.44269504f;
            const float cdec = exp2f(128.f * lg2);
            f32x4 S[16];
#pragma unroll
            for (int m = 0; m < 16; ++m) S[m] = (f32x4){0.f, 0.f, 0.f, 0.f};
            __syncthreads();
            for (int n = 0; n < 34; ++n) {
                const size_t rb = (size_t)scan_rowbase(dir, b, n);
                int lane_s = lane; asm volatile("" : "+v"(lane_s)); const int l15s = lane_s & 15, quads = lane_s >> 4;
                {
                    bf16x8 Sf[8];
#pragma unroll
                    for (int s = 0; s < 8; ++s) Sf[s] = pack_acc8(S[2 * s], S[2 * s + 1]);
                    bf16x8 qf[3][8];
                    const LAS unsigned char* qbase = lds + SC_QT + l15 * SC_QS + quad * 16;
#pragma unroll
                    for (int s = 0; s < 8; ++s) { qf[0][s] = *(const LAS bf16x8*)(qbase + s * 64); qf[1][s] = *(const LAS bf16x8*)(qbase + 16 * SC_QS + s * 64); }
#pragma unroll
                    for (int tt = 0; tt < 8; ++tt) {
                        if (tt + 2 < 8) {
#pragma unroll
                            for (int s = 0; s < 8; ++s) qf[(tt + 2) % 3][s] = *(const LAS bf16x8*)(qbase + (16 * (tt + 2)) * SC_QS + s * 64);
                        }
                        __builtin_amdgcn_sched_barrier(0);
                        f32x4 acc0 = (f32x4){0.f, 0.f, 0.f, 0.f}, acc1 = acc0;
#pragma unroll
                        for (int s = 0; s < 8; s += 2) { acc0 = mfma16(Sf[s], qf[tt % 3][s], acc0); acc1 = mfma16(Sf[s + 1], qf[tt % 3][s + 1], acc1); }
                        const int i0 = 16 * tt + l15; const int j0 = 16 * tt + l15s;
                        const float qd0 = __builtin_amdgcn_exp2f(lg2 * (dir == 0 ? (float)(j0 + 1) : (float)(128 - j0)));
#if FP8_RETSTORE
                        { int t8 = __builtin_amdgcn_cvt_pk_fp8_f32((acc0[0] + acc1[0]) * qd0, (acc0[1] + acc1[1]) * qd0, 0, false); t8 = __builtin_amdgcn_cvt_pk_fp8_f32((acc0[2] + acc1[2]) * qd0, (acc0[3] + acc1[3]) * qd0, t8, true);
                          *(int*)((unsigned char*)O + ((rb + i0) * 2048 + h * 512 + slice * 64 + 16 * w + 4 * quad)) = t8; }
#else
                        u32x2 o0; o0.x = cvt_pk_bf16((acc0[0] + acc1[0]) * qd0, (acc0[1] + acc1[1]) * qd0); o0.y = cvt_pk_bf16((acc0[2] + acc1[2]) * qd0, (acc0[3] + acc1[3]) * qd0);
                        *(u32x2*)(O + (rb + i0) * 2048 + h * 512 + slice * 64 + 16 * w + 4 * quad) = o0;
#endif
                        __builtin_amdgcn_sched_barrier(0);
                    }
                }
                __syncthreads();
#pragma unroll
                for (int m = 0; m < 16; ++m) S[m] = S[m] * cdec;
                {
                    const int ksw = (quad & 1) << 3;
                    const LAS unsigned char* kb0 = lds + SC_KT + (4 * quad + tq) * SC_KS + 16 * tp;
                    const LAS unsigned char* vb0 = lds + SC_VT + (4 * quad + tq) * SC_VS + (16 * w + 4 * tp) * 2;
                    s16x4 kf[3][16], vf[4][2];
#pragma unroll
                    for (int s = 0; s < 4; ++s) { vf[s][0] = lds_tr(vb0 + 32 * s * SC_VS); vf[s][1] = lds_tr(vb0 + (32 * s + 16) * SC_VS); }
#define SC_LDK(dst, g) do { const LAS unsigned char* kb_ = kb0 + 32 * ((g) >> 1) * SC_KS + 256 * ((g) & 1); _Pragma("unroll") for (int q_ = 0; q_ < 4; ++q_) { \
        dst[4 * q_ + 0] = lds_tr(kb_ + q_ * 64 + ksw); dst[4 * q_ + 1] = lds_tr(kb_ + q_ * 64 + ksw + 16 * SC_KS); dst[4 * q_ + 2] = lds_tr(kb_ + q_ * 64 + (8 ^ ksw)); dst[4 * q_ + 3] = lds_tr(kb_ + q_ * 64 + (8 ^ ksw) + 16 * SC_KS); } } while (0)
                    SC_LDK(kf[0], 0); SC_LDK(kf[1], 1);
                    bf16x8 Bv = (bf16x8){0, 0, 0, 0, 0, 0, 0, 0};
#pragma unroll
                    for (int g = 0; g < 8; ++g) {
                        if (g + 2 < 8) SC_LDK(kf[(g + 2) % 3], g + 2);
                        __builtin_amdgcn_sched_barrier(0);
                        if ((g & 1) == 0) {
                            const int s = g >> 1; float vs[8];
#pragma unroll
                            for (int e = 0; e < 4; ++e) { const int t0 = 32 * s + 4 * quads + e, t1 = t0 + 16;
                                const float k0 = __builtin_amdgcn_exp2f(lg2 * (dir == 0 ? (float)(127 - t0) : (float)t0)), k1 = __builtin_amdgcn_exp2f(lg2 * (dir == 0 ? (float)(127 - t1) : (float)t1));
                                vs[e] = bf2f((unsigned short)vf[s][0][e]) * k0; vs[4 + e] = bf2f((unsigned short)vf[s][1][e]) * k1; }
                            u32x4 vb; vb.x = cvt_pk_bf16(vs[0], vs[1]); vb.y = cvt_pk_bf16(vs[2], vs[3]); vb.z = cvt_pk_bf16(vs[4], vs[5]); vb.w = cvt_pk_bf16(vs[6], vs[7]);
                            Bv = __builtin_bit_cast(bf16x8, vb);
                        }
#pragma unroll
                        for (int q = 0; q < 4; ++q) { const int sp = 4 * (g & 1) + q;
                            S[2 * sp] = mfma16(cat8(kf[g % 3][4 * q + 0], kf[g % 3][4 * q + 1]), Bv, S[2 * sp]); S[2 * sp + 1] = mfma16(cat8(kf[g % 3][4 * q + 2], kf[g % 3][4 * q + 3]), Bv, S[2 * sp + 1]); }
                        __builtin_amdgcn_sched_barrier(0);
                    }
#undef SC_LDK
                }
                __syncthreads();
            }
        }
    }
    __syncthreads();
}

constexpr int IN_KS = 544, IN_VQ = 128 * 288, IN_VS = 288;
__device__ __forceinline__ int intra_rowbase(int nchunks, int u) {
    const int bh = u / nchunks, cn = u % nchunks, b = bh >> 2;
    if (nchunks == 34) return (cn < 2) ? NLAT + b * 256 + cn * 128 : b * 4096 + (cn - 2) * 128;
    return b * 4096 + cn * 128;
}
#if FP8_RETSTORE
typedef u32x2 RPiece;
__device__ __forceinline__ void rp_unpack(const RPiece& p, float (&v)[8]) { const f32x2 a0 = __builtin_amdgcn_cvt_pk_f32_fp8((int)p.x, false), a1 = __builtin_amdgcn_cvt_pk_f32_fp8((int)p.x, true), a2 = __builtin_amdgcn_cvt_pk_f32_fp8((int)p.y, false), a3 = __builtin_amdgcn_cvt_pk_f32_fp8((int)p.y, true);
    v[0] = a0.x; v[1] = a0.y; v[2] = a1.x; v[3] = a1.y; v[4] = a2.x; v[5] = a2.y; v[6] = a3.x; v[7] = a3.y; }
#define RP_OFF(bytes_bf16) ((bytes_bf16) >> 1)
#else
typedef u32x4 RPiece;
__device__ __forceinline__ void rp_unpack(const RPiece& p, float (&v)[8]) { v[0] = bflo(p.x); v[1] = bfhi(p.x); v[2] = bflo(p.y); v[3] = bfhi(p.y); v[4] = bflo(p.z); v[5] = bfhi(p.z); v[6] = bflo(p.w); v[7] = bfhi(p.w); }
#define RP_OFF(bytes_bf16) (bytes_bf16)
#endif
__device__ __forceinline__ void p_ret_intra(Frame& F, const Args& a, int j, int nchunks) {
    int tid0 = tid_of(F.wv); asm volatile("" : "+v"(tid0)); const int wave = __builtin_amdgcn_readfirstlane(tid0 >> 6);
    GAS unsigned char* wsg_ = (GAS unsigned char*)F.ws; asm volatile("" : "+s"(wsg_)); unsigned char* wso = (unsigned char*)wsg_;
    const bf16* Q = (const bf16*)(wso + WS_RQ); const bf16* K = (const bf16*)(wso + WS_RK); const bf16* V = (const bf16*)(wso + WS_RV);
    const bf16* OF = (const bf16*)(wso + WS_ROF); const bf16* OB = (const bf16*)(wso + WS_ROB); const bf16* Gt = (const bf16*)(wso + WS_RG); bf16* OG = (bf16*)(wso + WS_ROG);
    const int w = wave;
    int vcu = F.vcu; asm volatile("" : "+s"(vcu));
    LAS unsigned char* lds = F.lds;
    const int nunits = 16 * nchunks;
    u32x4 rk[8];
    if (vcu < nunits) { const int rb0 = intra_rowbase(nchunks, vcu), h0 = (vcu / nchunks) & 3;
#pragma unroll
        for (int i = 0; i < 8; ++i) rk[i] = *(const u32x4*)(K + (size_t)(rb0 + (tid0 >> 5) + 16 * i) * 1024 + h0 * 256 + (tid0 & 31) * 8); }
    for (int u = vcu; u < nunits; u += F.G) {
        int tid_o = tid_of(F.wv); asm volatile("" : "+v"(tid_o));
        const int tid = tid_o, lane_o = tid_o & 63;
        const int l15 = lane_o & 15, quad = lane_o >> 4, tq = l15 >> 2, tp = l15 & 3;
        const int h = (u / nchunks) & 3;
        const int rowbase = intra_rowbase(nchunks, u);
        const float lgf = logsig(a.in[I_RDEC][(j * 2 + 0) * 4 + h]) * 1.44269504f, lgb = logsig(a.in[I_RDEC][(j * 2 + 1) * 4 + h]) * 1.44269504f;
        __syncthreads();
#pragma unroll
        for (int i = 0; i < 8; ++i) *(LAS u32x4*)(lds + ((tid >> 5) + 16 * i) * IN_KS + (tid & 31) * 16) = rk[i];
        bf16x8 Bq[8];
#pragma unroll
        for (int s = 0; s < 8; ++s) Bq[s] = *(const bf16x8*)(Q + (size_t)(rowbase + 16 * w + l15) * 1024 + h * 256 + 32 * s + 8 * quad);
        u32x4 rv[16];
#pragma unroll
        for (int i = 0; i < 16; ++i) rv[i] = *(const u32x4*)(V + (size_t)(rowbase + (tid >> 6) + 8 * i) * 2048 + h * 512 + (tid & 63) * 8);
        __syncthreads();
        bf16x8 Pf[4];
        {
            f32x4 sc[8];
#pragma unroll
            for (int kt = 0; kt < 8; ++kt) { sc[kt] = (f32x4){0.f, 0.f, 0.f, 0.f};
#pragma unroll
                for (int s = 0; s < 8; ++s) { const bf16x8 A = *(const LAS bf16x8*)(lds + (16 * kt + l15) * IN_KS + (32 * s + 8 * quad) * 2); sc[kt] = mfma16(A, Bq[s], sc[kt]); } }
            const int qi = 16 * w + l15;
#pragma unroll
            for (int kt = 0; kt < 8; ++kt)
#pragma unroll
                for (int e = 0; e < 4; ++e) { const int kj = 16 * kt + 4 * quad + e; const int d = qi - kj;
                    const float mk = (d == 0) ? 2.f : exp2f((d > 0 ? lgf : lgb) * fabsf((float)d)); sc[kt][e] *= mk; }
#pragma unroll
            for (int s2 = 0; s2 < 4; ++s2) Pf[s2] = pack_acc8(sc[2 * s2], sc[2 * s2 + 1]);
        }
        __syncthreads();
#pragma unroll
        for (int i = 0; i < 16; ++i) { const int row = (tid >> 6) + 8 * i, c16 = tid & 63;
            *(LAS u32x4*)(lds + (c16 >> 4) * IN_VQ + row * IN_VS + (c16 & 15) * 16) = rv[i]; }
        const unsigned ro = ((unsigned)(rowbase + 16 * w + l15) * 2048u + (unsigned)(h * 512 + 8 * quad)) * 2u;
#define ROW16(base, el) (*(const RPiece*)((const char*)(base) + (RP_OFF(ro + (unsigned)(el) * 2u) + (unsigned)dep)))
        RPiece pf[6], pb[6];
#pragma unroll
        for (int kp = 0; kp < 4; ++kp) { pf[kp] = *(const RPiece*)((const char*)OF + RP_OFF(ro + 64u * kp)); pb[kp] = *(const RPiece*)((const char*)OB + RP_OFF(ro + 64u * kp)); }
        __syncthreads();
        __builtin_amdgcn_sched_barrier(0);
        f32x4 o[32];
#pragma unroll
        for (int mt = 0; mt < 32; ++mt) {
            o[mt] = (f32x4){0.f, 0.f, 0.f, 0.f};
            const int kp = mt >> 1;
            const LAS unsigned char* vb = lds + (kp >> 2) * IN_VQ + (32 * (kp & 3) + 8 * tp + 4 * (mt & 1)) * 2;
#pragma unroll
            for (int s2 = 0; s2 < 4; ++s2) { const int r0 = 32 * s2 + 4 * quad + tq;
                const s16x4 v0 = lds_tr(vb + r0 * IN_VS), v1 = lds_tr(vb + (r0 + 16) * IN_VS);
                o[mt] = mfma16(cat8(v0, v1), Pf[s2], o[mt]); }
            if ((mt & 1) == 1) __builtin_amdgcn_sched_barrier(0);
        }
        int dep = 0; asm volatile("" : "+v"(dep), "+v"(o[31][3]));
        float sum = 0.f;
#pragma unroll
        for (int bt = 0; bt < 3; ++bt) {
            const int p0 = bt == 0 ? 0 : (bt == 1 ? 4 : 10), np = bt == 0 ? 4 : 6;
            if (bt > 0) {
                asm volatile("" : "+v"(dep), "+v"(sum));
#pragma unroll
                for (int kp = 0; kp < 6; ++kp) { pf[kp] = ROW16(OF, 32 * (p0 + kp)); pb[kp] = ROW16(OB, 32 * (p0 + kp)); }
            }
#pragma unroll
            for (int kp = 0; kp < 6; ++kp) { if (kp >= np) continue; const int m0 = 2 * (p0 + kp), m1 = m0 + 1; float f[8], bk[8]; rp_unpack(pf[kp], f); rp_unpack(pb[kp], bk);
                o[m0][0] += f[0] + bk[0]; o[m0][1] += f[1] + bk[1]; o[m0][2] += f[2] + bk[2]; o[m0][3] += f[3] + bk[3];
                o[m1][0] += f[4] + bk[4]; o[m1][1] += f[5] + bk[5]; o[m1][2] += f[6] + bk[6]; o[m1][3] += f[7] + bk[7];
                sum += ((o[m0][0] + o[m0][1]) + (o[m0][2] + o[m0][3])) + ((o[m1][0] + o[m1][1]) + (o[m1][2] + o[m1][3])); }
        }
        asm volatile("" : "+v"(dep), "+v"(sum));
        RPiece gg[8];
#pragma unroll
        for (int kp = 0; kp < 8; ++kp) gg[kp] = ROW16(Gt, 32 * kp);
        sum += shx(sum, 16, lane_o); sum += shx(sum, 32, lane_o);
        const float mu = sum * (1.f / 512.f);
        float sq = 0.f;
#pragma unroll
        for (int mt = 0; mt < 32; ++mt) { o[mt] = o[mt] - mu; sq += (o[mt][0] * o[mt][0] + o[mt][1] * o[mt][1]) + (o[mt][2] * o[mt][2] + o[mt][3] * o[mt][3]); }
        sq += shx(sq, 16, lane_o); sq += shx(sq, 32, lane_o);
        const float rstd = rsqrtf(sq * (1.f / 512.f) + EPS);
        const float* gn = a.in[I_RGN] + j * 2048 + h * 512 + 8 * quad;
#pragma unroll
        for (int hb = 0; hb < 2; ++hb) {
            if (hb == 1) {
#pragma unroll
                for (int kp = 0; kp < 8; ++kp) gg[kp] = ROW16(Gt, 32 * (8 + kp));
                { const int un = (u + F.G < nunits) ? u + F.G : u; const int rbn = intra_rowbase(nchunks, un), hn = (un / nchunks) & 3;
#pragma unroll
                    for (int i = 0; i < 8; ++i) rk[i] = *(const u32x4*)(K + (size_t)(rbn + (tid >> 5) + 16 * i) * 1024 + hn * 256 + (tid & 31) * 8 + dep); }
            }
#pragma unroll
            for (int kp = 0; kp < 8; ++kp) { const int m0 = 2 * (8 * hb + kp), m1 = m0 + 1; float gf[8]; rp_unpack(gg[kp], gf);
                const f32x4 w0 = *(const f32x4*)(gn + 32 * (8 * hb + kp)), w1 = *(const f32x4*)(gn + 32 * (8 * hb + kp) + 4);
                u32x4 r;
                if (FP8_OUTPROJ && rowbase < NLAT) {
                    const float v0 = o[m0][0] * rstd * w0[0] * silu_f(gf[0]), v1 = o[m0][1] * rstd * w0[1] * silu_f(gf[1]), v2 = o[m0][2] * rstd * w0[2] * silu_f(gf[2]), v3 = o[m0][3] * rstd * w0[3] * silu_f(gf[3]);
                    const float v4 = o[m1][0] * rstd * w1[0] * silu_f(gf[4]), v5 = o[m1][1] * rstd * w1[1] * silu_f(gf[5]), v6 = o[m1][2] * rstd * w1[2] * silu_f(gf[6]), v7 = o[m1][3] * rstd * w1[3] * silu_f(gf[7]);
                    int t0 = __builtin_amdgcn_cvt_pk_fp8_f32(v0, v1, 0, false); t0 = __builtin_amdgcn_cvt_pk_fp8_f32(v2, v3, t0, true);
                    int t1 = __builtin_amdgcn_cvt_pk_fp8_f32(v4, v5, 0, false); t1 = __builtin_amdgcn_cvt_pk_fp8_f32(v6, v7, t1, true);
                    *(u32x2*)((char*)OG + ((ro >> 1) + 32u * (8 * hb + kp))) = (u32x2){(unsigned)t0, (unsigned)t1}; r.w = (unsigned)t1;
                } else {
                r.x = cvt_pk_bf16(o[m0][0] * rstd * w0[0] * silu_f(gf[0]), o[m0][1] * rstd * w0[1] * silu_f(gf[1]));
                r.y = cvt_pk_bf16(o[m0][2] * rstd * w0[2] * silu_f(gf[2]), o[m0][3] * rstd * w0[3] * silu_f(gf[3]));
                r.z = cvt_pk_bf16(o[m1][0] * rstd * w1[0] * silu_f(gf[4]), o[m1][1] * rstd * w1[1] * silu_f(gf[5]));
                r.w = cvt_pk_bf16(o[m1][2] * rstd * w1[2] * silu_f(gf[6]), o[m1][3] * rstd * w1[3] * silu_f(gf[7]));
                *(u32x4*)((char*)OG + (FP8_OUTPROJ ? (size_t)36 * MiB - (size_t)NLAT * 4096 : (size_t)0) + (ro + 64u * (8 * hb + kp))) = r; }
                if (kp == 7) asm volatile("" : "+v"(dep), "+v"(r.w)); }
        }
    }
#undef ROW16
    __syncthreads();
}

constexpr int NA_VS = 144, NA_CTX = 576 * 144, NA_RPB = 832 * 144;
struct NaUnit { int b, h, r0, rsu, band; size_t ctxrow; };
__device__ __forceinline__ NaUnit na_unit(int u) {
    NaUnit n;
    if (u < 2048) { n.b = u >> 9; const int rem = u & 511; n.h = rem & 15; n.r0 = 2 * (rem >> 4); n.rsu = min(max(n.r0 - 4, 0), 56); n.band = 1; }
    else { const int uc = u - 2048; n.b = uc >> 5; n.h = (uc >> 1) & 15; n.r0 = (uc & 1) * 128; n.rsu = 0; n.band = 0; }
    n.ctxrow = (size_t)(NLAT + n.b * 256);
    return n;
}
__device__ __forceinline__ void na_load_img(const bf16* T, const NaUnit& n, int tid, u32x4 (&r)[13]) {
    const int c8 = tid & 7, k0 = tid >> 3;
    if (n.band) {
#pragma unroll
        for (int i = 0; i < 9; ++i) { const int kb = k0 + 64 * i; const int tok = min((n.rsu + i) * 64 + k0, 4095);
            r[i] = *(const u32x4*)(T + (size_t)(n.b * 4096 + tok) * 1024 + n.h * 64 + c8 * 8); (void)kb; }
    }
#pragma unroll
    for (int i = 0; i < 4; ++i) r[9 + i] = *(const u32x4*)(T + (n.ctxrow + k0 + 64 * i) * 1024 + n.h * 64 + c8 * 8);
}
__device__ __forceinline__ void na_store_img(LAS unsigned char* lds, const NaUnit& n, int tid, const u32x4 (&r)[13]) {
    const int c8 = tid & 7, k0 = tid >> 3;
    if (n.band) {
#pragma unroll
        for (int i = 0; i < 9; ++i) *(LAS u32x4*)(lds + (k0 + 64 * i) * NA_VS + c8 * 16) = r[i];
    }
#pragma unroll
    for (int i = 0; i < 4; ++i) *(LAS u32x4*)(lds + NA_CTX + (k0 + 64 * i) * NA_VS + c8 * 16) = r[9 + i];
}
__device__ __forceinline__ void p_na_attn(Frame& F, const Args& a) {
    int tid0 = tid_of(F.wv); asm volatile("" : "+v"(tid0)); const int wave = __builtin_amdgcn_readfirstlane(tid0 >> 6);
    GAS unsigned char* wsg_ = (GAS unsigned char*)F.ws; asm volatile("" : "+s"(wsg_)); unsigned char* wso = (unsigned char*)wsg_;
    const bf16* Q = (const bf16*)(wso + WS_NQ); const bf16* K = (const bf16*)(wso + WS_NK); const bf16* V = (const bf16*)(wso + WS_NV); bf16* O = (bf16*)(wso + WS_NO);
    const int w = wave;
    int vcu = F.vcu; asm volatile("" : "+s"(vcu));
    LAS unsigned char* lds = F.lds;
    constexpr int NU = 2048 + 128;
    u32x4 rimg[13];
    bf16x8 Bq0n = (bf16x8){0, 0, 0, 0, 0, 0, 0, 0}, Bq1n = Bq0n;
    auto qrow_of = [&](const NaUnit& n, int lane_o) -> size_t { const int l15 = lane_o & 15; const bool band = n.band != 0;
        const int r = band ? n.r0 + (w >> 2) : 0, jb = w & 3;
        return band ? (size_t)(n.b * 4096 + r * 64 + 16 * jb + l15) * 1024 + n.h * 64 : (n.ctxrow + n.r0 + 16 * w + l15) * 1024 + n.h * 64; };
    if (vcu < NU) { const NaUnit n0 = na_unit(vcu); na_load_img(K, n0, tid0, rimg);
        const size_t q0 = qrow_of(n0, tid0 & 63); Bq0n = *(const bf16x8*)(Q + q0 + 8 * ((tid0 & 63) >> 4)); Bq1n = *(const bf16x8*)(Q + q0 + 32 + 8 * ((tid0 & 63) >> 4)); }
    int hcur = -1;
    for (int u = vcu; u < NU; u += F.G) {
        int tid_o = tid_of(F.wv); asm volatile("" : "+v"(tid_o));
        const int tid = tid_o, lane_o = tid_o & 63;
        const int l15 = lane_o & 15, quad = lane_o >> 4, tq = l15 >> 2, tp = l15 & 3;
        const NaUnit n = na_unit(u);
        const bool band = n.band != 0;
        const int r = band ? n.r0 + (w >> 2) : 0, jb = w & 3, rs = min(max(r - 4, 0), 56);
        const int cb = band ? min(max(16 * jb - 8, 0), 32) : 0;
        const size_t qrow = qrow_of(n, lane_o);
        const bf16x8 Bq0 = Bq0n, Bq1 = Bq1n;
        __syncthreads();
        na_store_img(lds, n, tid, rimg);
        if (band && n.h != hcur) { hcur = n.h; if (tid < 465) ((LAS float*)(lds + NA_RPB))[tid] = a.in[I_NARPB][n.h * 465 + tid]; }
        na_load_img(V, n, tid, rimg);
        __syncthreads();
        constexpr float LOG2E = 1.44269504f;
        bf16x8 Pf[16];
        float m1 = -1e30f, sum1 = 0.f, m2 = -1e30f, sum2 = 0.f;
        if (band) {
            f32x4 sc[16];
#pragma unroll
            for (int t = 0; t < 16; ++t) { const int kk = 16 * t + l15, krow = kk >> 5, kc = kk & 31;
                const LAS unsigned char* kp = lds + ((rs - n.rsu + krow) * 64 + cb + kc) * NA_VS + quad * 16;
                const bf16x8 k0 = *(const LAS bf16x8*)kp, k1 = *(const LAS bf16x8*)(kp + 64);
                f32x4 acc = (f32x4){0.f, 0.f, 0.f, 0.f}; acc = mfma16(k0, Bq0, acc); acc = mfma16(k1, Bq1, acc); sc[t] = acc; }
            const LAS float* rpb = (const LAS float*)(lds + NA_RPB);
            const int qcol = 16 * jb + l15, cstart = min(max(qcol - 8, 0), 48);
            const int rel0 = cb + 4 * quad - qcol;
            const int drb = (rs - r + 7) * 31 + 15;
#pragma unroll
            for (int t = 0; t < 16; ++t)
#pragma unroll
                for (int e = 0; e < 4; ++e) { const int rel = rel0 + (t & 1) * 16 + e;
                    const int kcol = rel + qcol; const bool valid = (kcol >= cstart) && (kcol < cstart + 16);
                    const int idx = drb + (t >> 1) * 31 + min(max(rel, -15), 15);
                    const float v = valid ? sc[t][e] + rpb[idx] : -1e30f; sc[t][e] = v; m1 = fmaxf(m1, v); }
            m1 = fmaxf(m1, shx(m1, 16, lane_o)); m1 = fmaxf(m1, shx(m1, 32, lane_o));
            const float m1l = m1 * LOG2E;
#pragma unroll
            for (int s2 = 0; s2 < 8; ++s2) { f32x4 p0, p1;
#pragma unroll
                for (int e = 0; e < 4; ++e) { p0[e] = __builtin_amdgcn_exp2f(sc[2 * s2][e] * LOG2E - m1l); p1[e] = __builtin_amdgcn_exp2f(sc[2 * s2 + 1][e] * LOG2E - m1l); }
                sum1 += (p0[0] + p0[1]) + (p0[2] + p0[3]) + (p1[0] + p1[1]) + (p1[2] + p1[3]);
                Pf[s2] = pack_acc8(p0, p1); }
        } else {
#pragma unroll
            for (int s2 = 0; s2 < 8; ++s2) Pf[s2] = (bf16x8){0, 0, 0, 0, 0, 0, 0, 0};
        }
        {
            f32x4 sc[16];
#pragma unroll
            for (int t = 0; t < 16; ++t) { const LAS unsigned char* kp = lds + NA_CTX + (16 * t + l15) * NA_VS + quad * 16;
                const bf16x8 k0 = *(const LAS bf16x8*)kp, k1 = *(const LAS bf16x8*)(kp + 64);
                f32x4 acc = (f32x4){0.f, 0.f, 0.f, 0.f}; acc = mfma16(k0, Bq0, acc); acc = mfma16(k1, Bq1, acc); sc[t] = acc; }
#pragma unroll
            for (int t = 0; t < 16; ++t)
#pragma unroll
                for (int e = 0; e < 4; ++e) m2 = fmaxf(m2, sc[t][e]);
            m2 = fmaxf(m2, shx(m2, 16, lane_o)); m2 = fmaxf(m2, shx(m2, 32, lane_o));
            const float m2l = m2 * LOG2E;
#pragma unroll
            for (int s2 = 0; s2 < 8; ++s2) { f32x4 p0, p1;
#pragma unroll
                for (int e = 0; e < 4; ++e) { p0[e] = __builtin_amdgcn_exp2f(sc[2 * s2][e] * LOG2E - m2l); p1[e] = __builtin_amdgcn_exp2f(sc[2 * s2 + 1][e] * LOG2E - m2l); }
                sum2 += (p0[0] + p0[1]) + (p0[2] + p0[3]) + (p1[0] + p1[1]) + (p1[2] + p1[3]);
                Pf[8 + s2] = pack_acc8(p0, p1); }
        }
        sum1 += shx(sum1, 16, lane_o); sum1 += shx(sum1, 32, lane_o);
        sum2 += shx(sum2, 16, lane_o); sum2 += shx(sum2, 32, lane_o);
        const float mm = fmaxf(m1, m2);
        const float a1 = __builtin_amdgcn_exp2f((m1 - mm) * LOG2E), a2 = __builtin_amdgcn_exp2f((m2 - mm) * LOG2E);
        const float inv = 1.f / (sum1 * a1 + sum2 * a2);
        const float f1 = a1 * inv, f2 = a2 * inv;
        __syncthreads();
        na_store_img(lds, n, tid, rimg);
        { const int un = (u + F.G < NU) ? u + F.G : u; const NaUnit nn = na_unit(un); na_load_img(K, nn, tid, rimg);
          const size_t qn = qrow_of(nn, lane_o); Bq0n = *(const bf16x8*)(Q + qn + 8 * quad); Bq1n = *(const bf16x8*)(Q + qn + 32 + 8 * quad); }
        __syncthreads();
        f32x4 o[4], oc[4];
#pragma unroll
        for (int dt = 0; dt < 4; ++dt) { o[dt] = (f32x4){0.f, 0.f, 0.f, 0.f}; oc[dt] = (f32x4){0.f, 0.f, 0.f, 0.f}; }
        if (band) {
#pragma unroll
            for (int s2 = 0; s2 < 8; ++s2) {
                const LAS unsigned char* vp = lds + ((rs - n.rsu + s2) * 64 + cb + 4 * quad + tq) * NA_VS + 8 * tp;
#pragma unroll
                for (int dt = 0; dt < 4; ++dt) { const s16x4 v0 = lds_tr(vp + dt * 32), v1 = lds_tr(vp + 16 * NA_VS + dt * 32); o[dt] = mfma16(cat8(v0, v1), Pf[s2], o[dt]); } }
        }
#pragma unroll
        for (int s2 = 0; s2 < 8; ++s2) {
            const LAS unsigned char* vp = lds + NA_CTX + (32 * s2 + 4 * quad + tq) * NA_VS + 8 * tp;
#pragma unroll
            for (int dt = 0; dt < 4; ++dt) { const s16x4 v0 = lds_tr(vp + dt * 32), v1 = lds_tr(vp + 16 * NA_VS + dt * 32); oc[dt] = mfma16(cat8(v0, v1), Pf[8 + s2], oc[dt]); } }
#pragma unroll
        for (int dt = 0; dt < 4; ++dt) { const float y0 = o[dt][0] * f1 + oc[dt][0] * f2, y1 = o[dt][1] * f1 + oc[dt][1] * f2, y2 = o[dt][2] * f1 + oc[dt][2] * f2, y3 = o[dt][3] * f1 + oc[dt][3] * f2;
            if (FP8_OUT2 && band) { int t8 = __builtin_amdgcn_cvt_pk_fp8_f32(y0, y1, 0, false); t8 = __builtin_amdgcn_cvt_pk_fp8_f32(y2, y3, t8, true);
                *(int*)((unsigned char*)O + qrow + 16 * dt + 4 * quad) = t8; }
            else { u32x2 ov; ov.x = cvt_pk_bf16(y0, y1); ov.y = cvt_pk_bf16(y2, y3);
                *(u32x2*)((unsigned char*)O + (FP8_OUT2 ? CTX_SIDE - (size_t)NLAT * 2048 : (size_t)0) + 2 * (qrow + 16 * dt + 4 * quad)) = ov; } }
    }
    __syncthreads();
}

constexpr int NPHASES = 1 + 9 + 8 + 8 + 9 + 1;
#ifndef EN_MASK
#define EN_MASK 0xFFFF
#endif
#define EN(b) ((EN_MASK >> (b)) & 1)

__global__ void __launch_bounds__(512, 2) fwd_kernel(Args args) {
    extern __shared__ __attribute__((aligned(16))) unsigned char lds_raw[];
    Frame F;
    F.lds = (LAS unsigned char*)lds_raw;
    F.MISC = (volatile LAS unsigned*)(F.lds + MISC_OFF);
    const int tid = threadIdx.x;
    F.wv = __builtin_amdgcn_readfirstlane(tid >> 6);
    F.G = gridDim.x; { const int bx = blockIdx.x; F.vcu = (F.G % 8 == 0) ? (bx % 8) * (F.G / 8) + bx / 8 : bx; }
    F.ws = args.ws;
    if (tid < 256) F.MISC[tid] = 0u;
    __syncthreads();
    const int lo = args.ph_lo, hi = args.ph_hi;
    XcdBarrier bar; bar.bar = (unsigned*)(F.ws + WS_CTL); bar.x = 0; bar.st = F.MISC + 8;
    if (hi - lo > 1) bar = xcd_barrier_post((unsigned*)(F.ws + WS_CTL), F.MISC + 8);
    int ph = 0, need = BG_NEED_RIN0; bool bg_on = true;
#define PH_BEGIN if (ph >= lo && ph < hi) { GAS unsigned char* wsg_ = (GAS unsigned char*)F.ws; asm volatile("" : "+s"(wsg_)); unsigned char* wso = (unsigned char*)wsg_; bf16* WB = (bf16*)(wso + WS_W); (void)WB;
#define PH_END_BG(busy_expr) if (bg_on) { __syncthreads(); int t_ = tid_of(F.wv); asm volatile("" : "+v"(t_)); const bool bz_ = (busy_expr); if (bz_ && t_ == 0) bg_signal(wso, ph); \
        bg_work(args, wso, F.lds, F.MISC, __builtin_amdgcn_readfirstlane(t_ >> 6), t_ & 63, ph, bz_, need); } if (ph + 1 < hi) xcd_barrier(bar, F.wv); } ++ph;
#define PH_END PH_END_BG(true)
#define CNT_BUSY(nunits, c) ((((nunits) - (c) + F.G - 1) / F.G) == (((nunits) + F.G - 1) / F.G) && (c) < (nunits))
    const int cid = (int)blockIdx.x;

    PH_BEGIN for (int rep_ = 0; rep_ < NREP(0); ++rep_) { if (rep_) xcd_barrier(bar, F.wv); if (EN(0)) p_prologue(F, args); } PH_END

    for (int layer = 0; layer < NLAYER; ++layer) {
        const int kind = layer % 3, j = layer / 3;
        const bool need_ctx = layer < NLAYER - 1;
        const int mrows = need_ctx ? NTOK : NLAT;
        bg_on = (layer == 0);
        if (layer == 2) { need = BG_NEED_NQKV; bg_on = true; } if (layer == 3) { need = BG_NEED_RIN1; bg_on = true; }
        PH_BEGIN for (int rep_ = 0; rep_ < NREP(1); ++rep_) { if (rep_) xcd_barrier(bar, F.wv); if (EN(1)) { if (layer == 0) p_pre<0>(F, args, layer); else p_pre<1>(F, args, layer); } } PH_END
        bg_on = (layer == 0);
        if (kind == 0) {
            PH_BEGIN for (int rep_ = 0; rep_ < NREP(2); ++rep_) { if (rep_) xcd_barrier(bar, F.wv); if (EN(2)) {
                pg8::StaticSched S; S.init(wso + WS_ACT, WB + WE_RIN + (size_t)j * 6144 * 1024, NTOK, 6144, FP8_INPROJ ? 512 : 1024, FP8_INPROJ ? 512 : 1024, FP8_INPROJ ? 512 : 1024, F.G, cid);
                LAS unsigned* ropel = (LAS unsigned*)(F.lds + pg8::STAGE_BYTES);
                { int t_o = tid_of(F.wv); asm volatile("" : "+v"(t_o)); typedef _Float16 h2 __attribute__((ext_vector_type(2)));
                  for (int i = t_o; i < 64 * 64; i += 512) { const f32x2 v = ((const f32x2*)(wso + WS_ROPE))[i]; const h2 hv = (h2){(_Float16)v.x, (_Float16)v.y}; ropel[i] = __builtin_bit_cast(unsigned, hv); } }
                __syncthreads();
                EpiRetIn E{(bf16*)(wso + WS_RQ), (bf16*)(wso + WS_RK), (bf16*)(wso + WS_RV), (bf16*)(wso + WS_RG), ropel};
                if (FP8_INPROJ) pg8::gemm_phase<EpiRetIn, pg8::StaticSched, true, true>(F.lds, S, E, 1024, 1024, (size_t)128 * 1024, F.wv);
                else pg8::gemm_phase<EpiRetIn, pg8::StaticSched, true>(F.lds, S, E, 2048, 2048, (size_t)128 * 2048, F.wv);
            } } PH_END_BG(CNT_BUSY(68 * 24, cid))
            PH_BEGIN for (int rep_ = 0; rep_ < NREP(3); ++rep_) { if (rep_) xcd_barrier(bar, F.wv); if (EN(3)) p_ret_scan(F, args, j); } PH_END
            need = (j == 0) ? BG_NEED_ROUT0 : BG_NEED_ROUT1; bg_on = true;
            PH_BEGIN for (int rep_ = 0; rep_ < NREP(4); ++rep_) { if (rep_) xcd_barrier(bar, F.wv); if (EN(4)) p_ret_intra(F, args, j, need_ctx ? 34 : 32); } PH_END_BG(CNT_BUSY(16 * (need_ctx ? 34 : 32), F.vcu))
            bg_on = (layer == 0);
            PH_BEGIN for (int rep_ = 0; rep_ < NREP(5); ++rep_) { if (rep_) xcd_barrier(bar, F.wv); if (EN(5)) {
                pg8::StaticSched S; S.init(wso + WS_ROG, WB + WE_ROUT + (size_t)j * 1024 * 2048, NLAT, 1024, FP8_OUTPROJ ? 1024 : 2048, FP8_OUTPROJ ? 1024 : 2048, FP8_OUTPROJ ? 1024 : 2048, F.G, cid);
                EpiResid E{(bf16*)(wso + WS_XALL), wso, layer, 2, FP8_OUTPROJ ? pg8::FP8_WSCALE : 1.f};
                if (FP8_OUTPROJ) pg8::gemm_phase<EpiResid, pg8::StaticSched, true, true>(F.lds, S, E, 2048, 2048, (size_t)128 * 2048, F.wv);
                else pg8::gemm_phase<EpiResid, pg8::StaticSched, true>(F.lds, S, E, 4096, 4096, (size_t)128 * 4096, F.wv);
                if (need_ctx) small_gemm_ctx<FP8_OUTPROJ != 0>(F, (const bf16*)(wso + WS_ROG + (FP8_OUTPROJ ? (size_t)36 * MiB - (size_t)NLAT * 4096 : (size_t)0)), 2048, WB + WE_ROUT + (size_t)j * 1024 * 2048, 2048, 2048, (bf16*)(wso + WS_XALL), modv(wso, layer, 4, 2));
            } } PH_END
        } else if (kind == 1) {
            PH_BEGIN for (int rep_ = 0; rep_ < NREP(6); ++rep_) { if (rep_) xcd_barrier(bar, F.wv); if (EN(6)) {
                { F1nSched S{(const char*)(wso + WS_A1N), (const char*)(wso + WS_ACT), F.G, F.vcu};
                  EpiF1n E{(bf16*)(wso + WS_G2)};
                  pg8::gemm_phase<EpiF1n, F1nSched, true>(F.lds, S, E, 512, 2048, (size_t)1024 * 2048, F.wv); }
                { F1Sched S{(const char*)(wso + WS_A1), (const char*)(wso + WS_ACT), F.G, F.vcu};
                  EpiF1 E{(bf16*)(wso + WS_G2), (bf16*)(wso + WS_G2C)};
                  pg8::gemm_phase<EpiF1, F1Sched, true>(F.lds, S, E, 512, 2048, (size_t)128 * 2048, F.wv); }
            } } PH_END_BG(CNT_BUSY(544, F.vcu))
            need = BG_NEED_FN; bg_on = true;
            PH_BEGIN for (int rep_ = 0; rep_ < NREP(7); ++rep_) { if (rep_) xcd_barrier(bar, F.wv); if (EN(7)) {
                { F2Sched S{(const char*)(wso + WS_AL), (const char*)(wso + WS_G2), F.G, F.vcu};
                  EpiF2 E{(bf16*)(wso + WS_FF)};
                  if (FP8_F2) pg8::gemm_phase<EpiF2, F2Sched, true, true>(F.lds, S, E, 1024, 8192, (size_t)128 * 8192, F.wv);
                  else pg8::gemm_phase<EpiF2, F2Sched, true>(F.lds, S, E, 2048, 16384, (size_t)128 * 16384, F.wv); }
                { F2cSched S{(const char*)(wso + WS_ALC), (const char*)(wso + WS_G2C), F.G, F.vcu};
                  EpiBf16 E{(bf16*)(wso + WS_FF + (FP8_OUT2 ? CTX_SIDE - (size_t)NLAT * 2048 : (size_t)0)), 1024, 1.f};
                  pg8::gemm_phase<EpiBf16, F2cSched, true>(F.lds, S, E, 1024, 1024, (size_t)128 * 1024, F.wv); }
            } } PH_END_BG(F.vcu < 16)
            bg_on = false;
            PH_BEGIN for (int rep_ = 0; rep_ < NREP(8); ++rep_) { if (rep_) xcd_barrier(bar, F.wv); if (EN(8)) {
                pg8::StaticSched S; S.init(wso + WS_FF, WB + WE_FN, NLAT, 1024, FP8_OUT2 ? 512 : 1024, FP8_OUT2 ? 512 : 1024, FP8_OUT2 ? 512 : 1024, F.G, cid);
                EpiResid E{(bf16*)(wso + WS_XALL), wso, layer, 2, FP8_OUT2 ? pg8::FP8_WSCALE : 1.f};
                if (FP8_OUT2) pg8::gemm_phase<EpiResid, pg8::StaticSched, true, true>(F.lds, S, E, 1024, 1024, (size_t)128 * 1024, F.wv);
                else pg8::gemm_phase<EpiResid, pg8::StaticSched, true>(F.lds, S, E, 2048, 2048, (size_t)128 * 2048, F.wv);
                small_gemm_ctx<FP8_OUT2 != 0>(F, (const bf16*)(wso + WS_FF + (FP8_OUT2 ? CTX_SIDE - (size_t)NLAT * 2048 : (size_t)0)), 1024, WB + WE_FN, 1024, 1024, (bf16*)(wso + WS_XALL), modv(wso, layer, 4, 2));
            } } PH_END
        } else {
            PH_BEGIN for (int rep_ = 0; rep_ < NREP(9); ++rep_) { if (rep_) xcd_barrier(bar, F.wv); if (EN(9)) {
                pg8::StaticSched S; S.init(wso + WS_ACT, WB + WE_NQKV, NTOK, 3072, FP8_INPROJ ? 512 : 1024, FP8_INPROJ ? 512 : 1024, FP8_INPROJ ? 512 : 1024, F.G, cid);
                EpiQKV E{(bf16*)(wso + WS_NQ), (bf16*)(wso + WS_NK), (bf16*)(wso + WS_NV), 0.125f * (FP8_INPROJ ? pg8::FP8_WSCALE : 1.f), FP8_INPROJ ? pg8::FP8_WSCALE : 1.f};
                if (FP8_INPROJ) pg8::gemm_phase<EpiQKV, pg8::StaticSched, true, true>(F.lds, S, E, 1024, 1024, (size_t)128 * 1024, F.wv);
                else pg8::gemm_phase<EpiQKV, pg8::StaticSched, true>(F.lds, S, E, 2048, 2048, (size_t)128 * 2048, F.wv);
            } } PH_END_BG(CNT_BUSY(68 * 12, cid))
            need = BG_NEED_NOUT; bg_on = true;
            PH_BEGIN for (int rep_ = 0; rep_ < NREP(10); ++rep_) { if (rep_) xcd_barrier(bar, F.wv); if (EN(10)) p_na_attn(F, args); } PH_END_BG(CNT_BUSY(2048 + 128, F.vcu))
            bg_on = false;
            PH_BEGIN for (int rep_ = 0; rep_ < NREP(11); ++rep_) { if (rep_) xcd_barrier(bar, F.wv); if (EN(11)) {
                pg8::StaticSched S; S.init(wso + WS_NO, WB + WE_NOUT, NLAT, 1024, FP8_OUT2 ? 512 : 1024, FP8_OUT2 ? 512 : 1024, FP8_OUT2 ? 512 : 1024, F.G, cid);
                EpiResid E{(bf16*)(wso + WS_XALL), wso, layer, 2, FP8_OUT2 ? pg8::FP8_WSCALE : 1.f};
                if (FP8_OUT2) pg8::gemm_phase<EpiResid, pg8::StaticSched, true, true>(F.lds, S, E, 1024, 1024, (size_t)128 * 1024, F.wv);
                else pg8::gemm_phase<EpiResid, pg8::StaticSched, true>(F.lds, S, E, 2048, 2048, (size_t)128 * 2048, F.wv);
                small_gemm_ctx<FP8_OUT2 != 0>(F, (const bf16*)(wso + WS_NO + (FP8_OUT2 ? CTX_SIDE - (size_t)NLAT * 2048 : (size_t)0)), 1024, WB + WE_NOUT, 1024, 1024, (bf16*)(wso + WS_XALL), modv(wso, layer, 4, 2));
            } } PH_END
        }
        PH_BEGIN for (int rep_ = 0; rep_ < NREP(12); ++rep_) { if (rep_) xcd_barrier(bar, F.wv); if (EN(12)) p_mid(F, args, layer, mrows); } PH_END
        need = (layer == 0) ? BG_NEED_MOE0 : (layer == 1) ? BG_NEED_MOE1 : (layer == 2) ? BG_NEED_MOE2 : BG_TOTAL; bg_on = true;
        PH_BEGIN for (int rep_ = 0; rep_ < NREP(13); ++rep_) { if (rep_) xcd_barrier(bar, F.wv); if (EN(13)) p_perm(F, mrows); } PH_END
        bg_on = (layer == 0);
        PH_BEGIN for (int rep_ = 0; rep_ < NREP(14); ++rep_) { if (rep_) xcd_barrier(bar, F.wv); if (EN(14)) {
            volatile LAS int* ts = (volatile LAS int*)(F.MISC + 32);
            { int t_o = tid_of(F.wv); asm volatile("" : "+v"(t_o)); if (t_o < 17) ts[t_o] = ((const int*)(wso + WS_MOETAB))[t_o];
              __syncthreads();
              if (t_o < 160) { int e_ = 0;
#pragma unroll
                  for (int k = 1; k < 16; ++k) e_ += (t_o >= ts[k]) ? 1 : 0;
                  ts[40 + t_o] = e_; } }
            __syncthreads();
            MoeSched S{ts, (const char*)(wso + WS_XP), (const char*)(wso + WS_W) + WE_MG * 2 + (size_t)layer * 16 * 1048576, 8, 131072, F.G, F.vcu};
            EpiMoe1 E{(unsigned char*)(wso + WS_H)};
            pg8::gemm_phase<EpiMoe1, MoeSched, true, true>(F.lds, S, E, 1024, 1024, (size_t)(WE_MU - WE_MG) * 2, F.wv);
        } } PH_END_BG(CNT_BUSY(((volatile LAS int*)(F.MISC + 32))[16] * 8, F.vcu))
        PH_BEGIN for (int rep_ = 0; rep_ < NREP(15); ++rep_) { if (rep_) xcd_barrier(bar, F.wv); if (EN(15)) {
            volatile LAS int* ts = (volatile LAS int*)(F.MISC + 32);
            { int t_o = tid_of(F.wv); asm volatile("" : "+v"(t_o)); if (t_o < 17) ts[t_o] = ((const int*)(wso + WS_MOETAB))[t_o];
              __syncthreads();
              if (t_o < 160) { int e_ = 0;
#pragma unroll
                  for (int k = 1; k < 16; ++k) e_ += (t_o >= ts[k]) ? 1 : 0;
                  ts[40 + t_o] = e_; } }
            __syncthreads();
            MoeSched S{ts, (const char*)(wso + WS_H), (const char*)(wso + WS_W) + WE_MD * 2 + (size_t)layer * 16 * 1048576, 4, 262144, F.G, F.vcu};
#if FP8_YB
            EpiFp8N E{(unsigned char*)(wso + WS_YB)};
            pg8::gemm_phase<EpiFp8N, MoeSched, true, true>(F.lds, S, E, 1024, 1024, (size_t)128 * 1024, F.wv);
#else
            EpiBf16N E{(bf16*)(wso + WS_YB), 1024, pg8::FP8_WSCALE};
            pg8::gemm_phase<EpiBf16N, MoeSched, true, true>(F.lds, S, E, 1024, 1024, (size_t)128 * 1024, F.wv);
#endif
        } } PH_END_BG(CNT_BUSY(((volatile LAS int*)(F.MISC + 32))[16] * 4, F.vcu))
    }
    PH_BEGIN p_pre<2>(F, args, 4); PH_END
#undef PH_BEGIN
#undef PH_END
#undef PH_END_BG
#undef CNT_BUSY
}

extern "C" void kernel_launch(void* const* d_in, const int* in_sizes, int n_in, void* d_out, int out_size, void* d_ws, size_t ws_size, hipStream_t stream) {
    static int grid = 0;
    if (grid == 0) {
        if (n_in != 22 || out_size != NLAT * D || ws_size < WS_END) { fprintf(stderr, "kernel_launch: unexpected shapes (n_in %d out %d ws %zu)\n", n_in, out_size, ws_size); grid = -1; return; }
        int dev = 0, cus = 0, per_cu = 0;
        if (hipGetDevice(&dev) != hipSuccess || hipDeviceGetAttribute(&cus, hipDeviceAttributeMultiprocessorCount, dev) != hipSuccess) { grid = -1; return; }
        if (hipFuncSetAttribute((const void*)fwd_kernel, hipFuncAttributeMaxDynamicSharedMemorySize, LDS_BYTES) != hipSuccess) { fprintf(stderr, "kernel_launch: hipFuncSetAttribute failed\n"); grid = -1; return; }
        if (hipOccupancyMaxActiveBlocksPerMultiprocessor(&per_cu, (const void*)fwd_kernel, 512, LDS_BYTES) != hipSuccess || per_cu < 1) fprintf(stderr, "kernel_launch: occupancy query reports %d\n", per_cu);
        (void)hipGetLastError();
        grid = cus;
    }
    if (grid < 0) return;
    (void)hipMemsetAsync((char*)d_ws + WS_CTL, 0, CTL_ZERO_BYTES, stream);
    Args a{};
    for (int i = 0; i < 22; ++i) a.in[i] = (const float*)d_in[i];
    a.out = (float*)d_out; a.ws = (unsigned char*)d_ws;
#if MK_PER_PHASE
    for (int p = 0; p < NPHASES; ++p) { a.ph_lo = p; a.ph_hi = p + 1; hipLaunchKernelGGL(fwd_kernel, dim3(grid), dim3(512), LDS_BYTES, stream, a); }
#else
    a.ph_lo = 0; a.ph_hi = NPHASES; hipLaunchKernelGGL(fwd_kernel, dim3(grid), dim3(512), LDS_BYTES, stream, a);
#endif
}
```
